# Optimizing an MI355X kernel written in HIP

```python
import math
import jax, jax.numpy as jnp
from jax import lax
import numpy as np

D_MODEL = 1024
BATCH = 8
SEQ = 4096
DEPTH = 2

GRID_W = 64
Q_BLOCK = 128
EPS = 1e-6
ROPE_THETA = 10000.0

A_HEADS = 8
A_Q_LORA = 256
A_KV_LORA = 128
A_NOPE = 64
A_ROPE = 32
A_V = 64
B_HEADS = 8
B_KV_HEADS = 2
B_HEAD_DIM = 64
C_HEADS = 16
C_KV_HEADS = 4
C_HEAD_DIM = 64
C_WINDOW = 128
REL_BUCKETS = 32
REL_MAX_DIST = 128
N_GROUPS = 4
EXPERTS_PER_GROUP = 4
N_EXPERTS = N_GROUPS * EXPERTS_PER_GROUP
TOP_K_IN_GROUP = 2
D_EXPERT = 512

AB_PARTS = (A_Q_LORA, A_KV_LORA, A_ROPE, B_HEADS * B_HEAD_DIM,
            B_KV_HEADS * B_HEAD_DIM, B_KV_HEADS * B_HEAD_DIM)
AB_IN = sum(AB_PARTS)
AB_SPLITS = tuple(int(v) for v in np.cumsum(AB_PARTS)[:-1])
AB_OUT = A_HEADS * A_V + B_HEADS * B_HEAD_DIM
C_PARTS = (C_HEADS * C_HEAD_DIM, C_KV_HEADS * C_HEAD_DIM, C_KV_HEADS * C_HEAD_DIM)
C_IN = sum(C_PARTS)
C_SPLITS = tuple(int(v) for v in np.cumsum(C_PARTS)[:-1])
C_OUT = C_HEADS * C_HEAD_DIM
N_EVEN = (DEPTH + 1) // 2
N_ODD = DEPTH // 2

kernel_name = "hybrid_mla_axialgqa_swa_hmoe_encoder"


def rms_norm(x, gain):
    xf = x.astype(jnp.float32)
    y = xf * lax.rsqrt(jnp.mean(xf * xf, axis=-1, keepdims=True) + EPS)
    return (y * gain.astype(jnp.float32)).astype(x.dtype)


def rope_cos_sin(pos, dim):
    inv = ROPE_THETA ** (-jnp.arange(0, dim, 2, dtype=jnp.float32) / dim)
    ang = pos.astype(jnp.float32)[:, None] * inv[None, :]
    return jnp.cos(ang), jnp.sin(ang)


def apply_rope(x, cos, sin):
    x1, x2 = jnp.split(x, 2, axis=-1)
    cos = cos.astype(x.dtype)
    sin = sin.astype(x.dtype)
    return jnp.concatenate([x1 * cos - x2 * sin, x2 * cos + x1 * sin], axis=-1)


def to_blocks(t):
    b, s = t.shape[:2]
    t = t.reshape((b, s // Q_BLOCK, Q_BLOCK) + t.shape[2:])
    return jnp.moveaxis(t, 1, 0)


def from_blocks(t):
    t = jnp.moveaxis(t, 0, 1)
    return t.reshape((t.shape[0], t.shape[1] * t.shape[2]) + t.shape[3:])


def mla_mix(q_lat, kv_lat, k_rope, q_a_gain, w_q_up, kv_a_gain, w_kv_up,
            qn_gain, kn_gain, qr_gain, kr_gain):
    b, s, _ = q_lat.shape
    cos, sin = rope_cos_sin(jnp.arange(s), A_ROPE)
    q = (rms_norm(q_lat, q_a_gain) @ w_q_up).reshape(b, s, A_HEADS, A_NOPE + A_ROPE)
    kv = (rms_norm(kv_lat, kv_a_gain) @ w_kv_up).reshape(b, s, A_HEADS, A_NOPE + A_V)
    q_nope = rms_norm(q[..., :A_NOPE], qn_gain)
    q_rot = apply_rope(rms_norm(q[..., A_NOPE:], qr_gain), cos[:, None], sin[:, None])
    k_nope = rms_norm(kv[..., :A_NOPE], kn_gain)
    v = kv[..., A_NOPE:]
    k_rot = apply_rope(rms_norm(k_rope, kr_gain), cos, sin)
    scale = (A_NOPE + A_ROPE) ** -0.5

    def block(args):
        qn, qr = args
        sc = (jnp.einsum('bqhd,bkhd->bhqk', qn, k_nope)
              + jnp.einsum('bqhr,bkr->bhqk', qr, k_rot))
        p = jax.nn.softmax(sc.astype(jnp.float32) * scale, axis=-1).astype(v.dtype)
        return jnp.einsum('bhqk,bkhd->bqhd', p, v)

    o = lax.map(block, (to_blocks(q_nope), to_blocks(q_rot)))
    return from_blocks(o).reshape(b, s, A_HEADS * A_V)


def axial_gqa_mix(q, k, v, q_gain, k_gain):
    b, s = q.shape[:2]
    rows = s // GRID_W
    row_pos = jnp.repeat(jnp.arange(rows), GRID_W)
    col_pos = jnp.tile(jnp.arange(GRID_W), rows)
    half = B_HEAD_DIM // 2
    cos_r, sin_r = rope_cos_sin(row_pos, half)
    cos_c, sin_c = rope_cos_sin(col_pos, half)

    def axial(t):
        return jnp.concatenate(
            [apply_rope(t[..., :half], cos_r[:, None], sin_r[:, None]),
             apply_rope(t[..., half:], cos_c[:, None], sin_c[:, None])], axis=-1)

    grp = B_HEADS // B_KV_HEADS
    qn = axial(rms_norm(q, q_gain)).reshape(b, s, B_KV_HEADS, grp, B_HEAD_DIM)
    kn = axial(rms_norm(k, k_gain))
    scale = B_HEAD_DIM ** -0.5

    def block(qb):
        sc = jnp.einsum('bqhgd,bkhd->bhgqk', qb, kn)
        p = jax.nn.softmax(sc.astype(jnp.float32) * scale, axis=-1).astype(v.dtype)
        return jnp.einsum('bhgqk,bkhd->bqhgd', p, v)

    o = lax.map(block, to_blocks(qn))
    return from_blocks(o).reshape(b, s, B_HEADS * B_HEAD_DIM)


def t5_bucket(rel):
    nb = REL_BUCKETS // 2
    max_exact = nb // 2
    ret = jnp.where(rel > 0, nb, 0)
    n = jnp.abs(rel)
    nf = jnp.maximum(n, 1).astype(jnp.float32)
    large = max_exact + (jnp.log(nf / max_exact) / math.log(REL_MAX_DIST / max_exact)
                         * (nb - max_exact)).astype(jnp.int32)
    large = jnp.minimum(large, nb - 1)
    return ret + jnp.where(n < max_exact, n, large)


def window_gqa_mix(q, k, v, q_gain, k_gain, sink, rel_table):
    b, s = q.shape[:2]
    grp = C_HEADS // C_KV_HEADS
    span = Q_BLOCK + 2 * C_WINDOW
    qn = rms_norm(q, q_gain).reshape(b, s, C_KV_HEADS, grp, C_HEAD_DIM)
    kn = rms_norm(k, k_gain)
    pad = ((0, 0), (C_WINDOW, C_WINDOW), (0, 0), (0, 0))
    kp = jnp.pad(kn, pad)
    vp = jnp.pad(v, pad)
    qi = jnp.arange(Q_BLOCK)[:, None]
    kj = jnp.arange(span)[None, :]
    rel = kj - C_WINDOW - qi
    in_band = jnp.abs(rel) <= C_WINDOW
    bias = rel_table[t5_bucket(rel)]
    bias = jnp.transpose(bias, (2, 0, 1)).reshape(C_KV_HEADS, grp, Q_BLOCK, span).astype(jnp.float32)
    sink_f = sink.astype(jnp.float32).reshape(C_KV_HEADS, grp, 1, 1)
    scale = C_HEAD_DIM ** -0.5

    def block(args):
        i, qb = args
        start = i * Q_BLOCK
        kb = lax.dynamic_slice_in_dim(kp, start, span, axis=1)
        vb = lax.dynamic_slice_in_dim(vp, start, span, axis=1)
        key_pos = start - C_WINDOW + kj
        mask = in_band & (key_pos >= 0) & (key_pos < s)
        sc = jnp.einsum('bqhgd,bkhd->bhgqk', qb, kb).astype(jnp.float32) * scale + bias
        sc = jnp.where(mask, sc, -jnp.inf)
        sink_col = jnp.broadcast_to(sink_f, sc.shape[:-1] + (1,))
        p = jax.nn.softmax(jnp.concatenate([sc, sink_col], axis=-1), axis=-1)[..., :span]
        return jnp.einsum('bhgqk,bkhd->bqhgd', p.astype(vb.dtype), vb)

    o = lax.map(block, (jnp.arange(s // Q_BLOCK), to_blocks(qn)))
    return from_blocks(o).reshape(b, s, C_HEADS * C_HEAD_DIM)


def hier_moe(h, w_group, b_group, w_router, b_router, w_gate, w_up, w_down):
    b, s, d = h.shape
    xt = h.reshape(b * s, d)
    g_prob = jax.nn.softmax((xt @ w_group).astype(jnp.float32) + b_group.astype(jnp.float32), axis=-1)
    g_p, g_idx = lax.top_k(g_prob, 1)
    e_logits = ((xt @ w_router).astype(jnp.float32) + b_router.astype(jnp.float32)
                ).reshape(-1, N_GROUPS, EXPERTS_PER_GROUP)
    e_logits = jnp.take_along_axis(e_logits, g_idx[:, :, None], axis=1)[:, 0]
    e_prob = jax.nn.softmax(e_logits, axis=-1)
    e_p, e_loc = lax.top_k(e_prob, TOP_K_IN_GROUP)
    wts = g_p * e_p / jnp.sum(e_p, axis=-1, keepdims=True)
    e_idx = g_idx * EXPERTS_PER_GROUP + e_loc
    gates = jnp.sum(jax.nn.one_hot(e_idx, N_EXPERTS, dtype=jnp.float32) * wts[..., None], axis=1)
    gates = gates.astype(xt.dtype)
    out = jnp.zeros_like(xt)
    for e in range(N_EXPERTS):
        hid = jax.nn.silu(xt @ w_gate[e]) * (xt @ w_up[e])
        out = out + gates[:, e:e + 1] * (hid @ w_down[e])
    return out.reshape(b, s, d)


def setup_inputs(seed: int = 0) -> dict:
    key = jax.random.key(seed)
    ks = iter(jax.random.split(key, 40))

    def dense(shape, fan_in):
        return jax.random.normal(next(ks), shape, jnp.float32) * (fan_in ** -0.5)

    def gain(shape):
        return 1.0 + 0.02 * jax.random.normal(next(ks), shape, jnp.float32)

    def small(shape, scale):
        return scale * jax.random.normal(next(ks), shape, jnp.float32)

    return {
        "x": jax.random.normal(next(ks), (BATCH, SEQ, D_MODEL), jnp.float32),
        "mix_norm": gain((DEPTH, D_MODEL)),
        "ffn_norm": gain((DEPTH, D_MODEL)),
        "w_in_ab": dense((N_EVEN, D_MODEL, AB_IN), D_MODEL),
        "mla_q_a_norm": gain((N_EVEN, A_Q_LORA)),
        "mla_w_q_up": dense((N_EVEN, A_Q_LORA, A_HEADS * (A_NOPE + A_ROPE)), A_Q_LORA),
        "mla_kv_a_norm": gain((N_EVEN, A_KV_LORA)),
        "mla_w_kv_up": dense((N_EVEN, A_KV_LORA, A_HEADS * (A_NOPE + A_V)), A_KV_LORA),
        "mla_qn_gain": gain((N_EVEN, A_NOPE)),
        "mla_kn_gain": gain((N_EVEN, A_NOPE)),
        "mla_qr_gain": gain((N_EVEN, A_ROPE)),
        "mla_kr_gain": gain((N_EVEN, A_ROPE)),
        "gqa_q_gain": gain((N_EVEN, B_HEAD_DIM)),
        "gqa_k_gain": gain((N_EVEN, B_HEAD_DIM)),
        "w_out_ab": dense((N_EVEN, AB_OUT, D_MODEL), AB_OUT),
        "w_in_c": dense((N_ODD, D_MODEL, C_IN), D_MODEL),
        "win_q_gain": gain((N_ODD, C_HEAD_DIM)),
        "win_k_gain": gain((N_ODD, C_HEAD_DIM)),
        "win_sink": small((N_ODD, C_HEADS), 0.5),
        "w_out_c": dense((N_ODD, C_OUT, D_MODEL), C_OUT),
        "rel_bias": small((REL_BUCKETS, C_HEADS), 0.5),
        "moe_w_group": dense((DEPTH, D_MODEL, N_GROUPS), D_MODEL),
        "moe_b_group": small((DEPTH, N_GROUPS), 0.01),
        "moe_w_router": dense((DEPTH, D_MODEL, N_EXPERTS), D_MODEL),
        "moe_b_router": small((DEPTH, N_EXPERTS), 0.01),
        "moe_w_gate": dense((DEPTH, N_EXPERTS, D_MODEL, D_EXPERT), D_MODEL),
        "moe_w_up": dense((DEPTH, N_EXPERTS, D_MODEL, D_EXPERT), D_MODEL),
        "moe_w_down": dense((DEPTH, N_EXPERTS, D_EXPERT, D_MODEL), D_EXPERT),
    }


def reference(x, mix_norm, ffn_norm, w_in_ab, mla_q_a_norm, mla_w_q_up, mla_kv_a_norm,
              mla_w_kv_up, mla_qn_gain, mla_kn_gain, mla_qr_gain, mla_kr_gain,
              gqa_q_gain, gqa_k_gain, w_out_ab, w_in_c, win_q_gain, win_k_gain,
              win_sink, w_out_c, rel_bias, moe_w_group, moe_b_group, moe_w_router,
              moe_b_router, moe_w_gate, moe_w_up, moe_w_down):
    b, s, _ = x.shape
    for layer in range(DEPTH):
        i = layer // 2
        h = rms_norm(x, mix_norm[layer])
        if layer % 2 == 0:
            proj = h @ w_in_ab[i]
            q_lat, kv_lat, k_rope, bq, bk, bv = jnp.split(proj, AB_SPLITS, axis=-1)
            out_a = mla_mix(q_lat, kv_lat, k_rope, mla_q_a_norm[i], mla_w_q_up[i],
                            mla_kv_a_norm[i], mla_w_kv_up[i], mla_qn_gain[i],
                            mla_kn_gain[i], mla_qr_gain[i], mla_kr_gain[i])
            out_b = axial_gqa_mix(bq.reshape(b, s, B_HEADS, B_HEAD_DIM),
                                  bk.reshape(b, s, B_KV_HEADS, B_HEAD_DIM),
                                  bv.reshape(b, s, B_KV_HEADS, B_HEAD_DIM),
                                  gqa_q_gain[i], gqa_k_gain[i])
            x = x + jnp.concatenate([out_a, out_b], axis=-1) @ w_out_ab[i]
        else:
            proj = h @ w_in_c[i]
            cq, ck, cv = jnp.split(proj, C_SPLITS, axis=-1)
            out_c = window_gqa_mix(cq.reshape(b, s, C_HEADS, C_HEAD_DIM),
                                   ck.reshape(b, s, C_KV_HEADS, C_HEAD_DIM),
                                   cv.reshape(b, s, C_KV_HEADS, C_HEAD_DIM),
                                   win_q_gain[i], win_k_gain[i], win_sink[i], rel_bias)
            x = x + out_c @ w_out_c[i]
        x = x + hier_moe(rms_norm(x, ffn_norm[layer]), moe_w_group[layer], moe_b_group[layer],
                         moe_w_router[layer], moe_b_router[layer], moe_w_gate[layer],
                         moe_w_up[layer], moe_w_down[layer])
    return x
```

```cpp
#define MK_ONE_LAUNCH 1
#define MK_GEMM 1
#define MK_ATTN 1
#include <hip/hip_runtime.h>
#include <cstdio>
#include <cstdint>

#ifndef MK_ONE_LAUNCH
#define MK_ONE_LAUNCH 1
#endif
#ifndef MK_GEMM
#define MK_GEMM 1
#endif
#ifndef MK_ATTN
#define MK_ATTN 1
#endif

#define GAS __attribute__((address_space(1)))
#define LAS __attribute__((address_space(3)))
typedef unsigned short bf16;
typedef short bf16x8 __attribute__((ext_vector_type(8)));
typedef short s16x4 __attribute__((ext_vector_type(4)));
typedef float f32x2 __attribute__((ext_vector_type(2)));
typedef float f32x4 __attribute__((ext_vector_type(4)));
typedef float f32x16 __attribute__((ext_vector_type(16)));
typedef unsigned u32x2 __attribute__((ext_vector_type(2)));
typedef unsigned u32x4 __attribute__((ext_vector_type(4)));

constexpr int NBATCH = 8, SEQ = 4096, NT = NBATCH * SEQ, DM = 1024;
constexpr float EPS = 1e-6f;
constexpr float LOG2E = 1.4426950408889634f;
constexpr int PROJ_LD = 1280;
constexpr int UP_LD = 1792, UP_K = 384;
constexpr int PC_LD = 1536;
constexpr int PC_QLAT = 0, PC_KVLAT = 256, PC_BQ = 384, PC_BK = 896, PC_BV = 1024, PC_KROPE = 1152;
constexpr int NEXP = 16, DEXP = 512;
constexpr int MOE_ROWS = 2 * NT + NEXP * 256;

constexpr size_t MiB = 1u << 20;
constexpr size_t WS_CTL = 0, CTL_ZERO_BYTES = 64 * 1024;
constexpr size_t WS_TAB = 1 * MiB;
constexpr size_t WS_ROUTE = 2 * MiB;
constexpr size_t WS_WAB = 4 * MiB, WS_WUP = 7 * MiB, WS_WOAB = 9 * MiB, WS_WC = 11 * MiB, WS_WOC = 14 * MiB;
constexpr size_t WS_WGU = 16 * MiB;
constexpr size_t WS_WD = 80 * MiB;
constexpr size_t WS_H = 112 * MiB;
constexpr size_t WS_R = 176 * MiB;
constexpr size_t WS_PROJ = WS_R;
constexpr size_t WS_UPO = WS_R + 80 * MiB;
constexpr size_t WS_PROJC = WS_R;
constexpr size_t WS_HS = WS_R;
constexpr size_t WS_ACT = WS_R + 136 * MiB;
constexpr size_t WS_END = WS_R + 204 * MiB;
static_assert((size_t)MOE_ROWS * 1024 * 2 <= 136 * MiB && (size_t)MOE_ROWS * 512 * 2 <= 68 * MiB, "moe buffers");
constexpr int CW_CNT = 64;
constexpr int CW_BAR = 4096;
constexpr int TB_BIAS = 0;
constexpr int TB_CONST = 8192;
constexpr int TB_INV = 8192 + 64;

constexpr int RING_BYTES = 131072;
constexpr int MISC_OFF = RING_BYTES;
constexpr int LDS_BYTES = 147456;

__device__ __forceinline__ float bf2f(unsigned b) { return __uint_as_float(b << 16); }
__device__ __forceinline__ unsigned f2bf(float f) { unsigned u = __float_as_uint(f); return (u + 0x7fffu + ((u >> 16) & 1u)) >> 16; }
__device__ __forceinline__ unsigned pk2(float lo, float hi) { unsigned r; asm volatile("v_cvt_pk_bf16_f32 %0, %1, %2" : "=v"(r) : "v"(lo), "v"(hi)); return r; }
__device__ __forceinline__ float wave_sum(float v) {
#pragma unroll
    for (int o = 1; o < 64; o <<= 1) v += __shfl_xor(v, o);
    return v;
}
__device__ __forceinline__ float wave_max(float v) {
#pragma unroll
    for (int o = 1; o < 64; o <<= 1) v = fmaxf(v, __shfl_xor(v, o));
    return v;
}
#define LDS_WAIT() asm volatile("s_waitcnt lgkmcnt(0)" ::: "memory")

#define XB_TMO      128
#define XB_XCNT(j)  (256  + 64 * (j))
#define XB_XSUB(j)  (1280 + 64 * (j))
#define XB_XGEN(j)  (2304 + 64 * (j))
#define XB_TOP      3328
#define XB_TOPGEN   3392
#define XCD_BAR_WORDS 3456
#define XB_SPIN_CAP (1u << 18)
__device__ __forceinline__ unsigned xb_ld(unsigned* p)              { return __hip_atomic_load(p, __ATOMIC_RELAXED, __HIP_MEMORY_SCOPE_AGENT); }
__device__ __forceinline__ unsigned xb_add(unsigned* p, unsigned v) { return __hip_atomic_fetch_add(p, v, __ATOMIC_RELAXED, __HIP_MEMORY_SCOPE_AGENT); }
__device__ __forceinline__ unsigned xb_xcc_id() { return (unsigned)__builtin_amdgcn_s_getreg((3 << 11) | 20) & 0xFu; }
#define XB_SPIN(cond, bar) do { unsigned _sp = 0; while (cond) { __builtin_amdgcn_s_sleep(1); \
    if ((++_sp & 255u) == 0u) { if (xb_ld(&(bar)[XB_TMO])) break; if (_sp > XB_SPIN_CAP) { atomicAdd(&(bar)[XB_TMO], 1u); break; } } } } while (0)
struct XcdBarrier { unsigned* bar; unsigned x; volatile LAS unsigned* st; };
__device__ __forceinline__ XcdBarrier xcd_barrier_post(unsigned* bar, volatile LAS unsigned* st) {
    XcdBarrier b; b.bar = bar; b.x = xb_xcc_id(); b.st = st;
    if (threadIdx.x == 0) (void)xb_add(&bar[XB_XCNT(b.x)], 1u);
    return b;
}
__device__ __forceinline__ void xcd_barrier_complete(unsigned* bar, unsigned x, unsigned& nloc, unsigned& nx) {
    const unsigned G = gridDim.x * gridDim.y * gridDim.z;
    unsigned sum, cnt, mine, sp = 0u;
    for (;;) {
        sum = 0u; cnt = 0u; mine = 0u;
#pragma unroll
        for (unsigned j = 0; j < 16; ++j) { const unsigned c = xb_ld(&bar[XB_XCNT(j)]); sum += c; cnt += (c > 0u) ? 1u : 0u; mine = (j == x) ? c : mine; }
        if (sum == G) break;
        __builtin_amdgcn_s_sleep(1);
        if ((++sp & 255u) == 0u) { if (xb_ld(&bar[XB_TMO])) break; if (sp > XB_SPIN_CAP) { atomicAdd(&bar[XB_TMO], 1u); break; } }
    }
    nloc = mine > 0u ? mine : 1u; nx = cnt > 0u ? cnt : 1u;
}
__device__ __forceinline__ void xcd_barrier(const XcdBarrier& b) {
    asm volatile("s_waitcnt vmcnt(0)" ::: "memory");
    __syncthreads();
    if (threadIdx.x == 0) {
        unsigned* bar = b.bar;
        __builtin_amdgcn_s_waitcnt(0);
        unsigned nloc = b.st[0], nx = b.st[1];
        if (nloc == 0u) { xcd_barrier_complete(bar, b.x, nloc, nx); b.st[0] = nloc; b.st[1] = nx; }
        const unsigned old = xb_add(&bar[XB_XSUB(b.x)], 1u);
        const unsigned gen = old / nloc;
        if (old + 1u == (gen + 1u) * nloc) {
            __builtin_amdgcn_fence(__ATOMIC_RELEASE, "agent");
            asm volatile("s_waitcnt vmcnt(0)" ::: "memory");
            const unsigned og = xb_add(&bar[XB_TOP], 1u);
            const unsigned tg = og / nx;
            if (og + 1u == (tg + 1u) * nx) xb_add(&bar[XB_TOPGEN], 1u);
            else XB_SPIN(xb_ld(&bar[XB_TOPGEN]) == tg, bar);
            __builtin_amdgcn_fence(__ATOMIC_ACQUIRE, "agent");
            xb_add(&bar[XB_XGEN(b.x)], 1u);
            asm volatile("s_waitcnt vmcnt(0)" ::: "memory");
        } else {
            XB_SPIN(xb_ld(&bar[XB_XGEN(b.x)]) == gen, bar);
            __builtin_amdgcn_fence(__ATOMIC_ACQUIRE, "agent");
            asm volatile("s_waitcnt vmcnt(0)" ::: "memory");
        }
    }
    __syncthreads();
}
namespace pg8 {
#define PG8_LAS __attribute__((address_space(3)))
typedef unsigned short bf16_t;
constexpr int BM = 256, BK = 64, HALF = 128, HTB = HALF * BK * 2, STAGE_BYTES = 8 * HTB, NXCD = 8, WGM = 8;

__host__ __device__ __forceinline__ int lds_byte(int r, int c) { const int st = (r >> 4) * 2 + (c >> 5), rr = r & 15, cc = c & 31, ob = rr * 64 + cc * 2; return st * 1024 + (ob ^ (((ob >> 9) & 1) << 5)); }
__host__ __device__ __forceinline__ void stage_rc(int b, int& R, int& C) { const int st = b / 1024, sb = b % 1024, swz = sb ^ (((sb >> 9) & 1) << 5); R = (st >> 1) * 16 + swz / 64; C = (st & 1) * 32 + (swz % 64) / 2; }
__host__ __device__ __forceinline__ int perm32(int rho) { const int n = rho >> 4, i = rho & 15; return 8 * (i >> 2) + 4 * n + (i & 3); }

struct Unit { int pm, pn; long aoff, boff; };
struct Gemm { const bf16_t* A; const bf16_t* Bt; int lda, ldb, K; };

struct StaticOrder {
    int nM, nN, nwg, G, c, lda, ldb;
    __device__ void init(int M, int N, int lda_, int ldb_, int G_, int c_) { nM = M / BM; nN = N / BM; nwg = nM * nN; G = G_; c = c_; lda = lda_; ldb = ldb_; }
    __device__ bool next(int i, Unit& u) const {
        const long L = (long)i * G + c; if (L >= nwg) return false;
        int wgid = (int)L; { const int q = nwg / NXCD, r = nwg % NXCD, xcd = wgid % NXCD, off = wgid / NXCD; wgid = (xcd < r ? xcd * (q + 1) : r * (q + 1) + (xcd - r) * q) + off; }
        const int nig = WGM * nN, gid = wgid / nig, fm = gid * WGM, gsz = (nM - fm) < WGM ? (nM - fm) : WGM;
        u.pm = fm + ((wgid % nig) % gsz); u.pn = (wgid % nig) / gsz;
        u.aoff = (long)u.pm * BM * lda; u.boff = (long)u.pn * BM * ldb; return true;
    }
};
struct MoeOrder {
    const PG8_LAS unsigned char* tile_e; int ntile, nN, G, vc, lda, ldb; long estride;
    __device__ bool next(int i, Unit& u) const {
        const long L = (long)i * G + vc; if (L >= (long)ntile * nN) return false;
        u.pm = (int)(L / nN); u.pn = (int)(L % nN);
        const int e = tile_e[u.pm];
        u.aoff = (long)u.pm * BM * lda; u.boff = (long)e * estride + (long)u.pn * BM * ldb; return true;
    }
};

struct EpiStoreBf16 {
    static constexpr bool PERM = true;
    bf16_t* O; int ldc;
    __device__ __forceinline__ void operator()(const f32x4 (&acc)[2][2][4][2], const Unit& u, int wr, int wc, int fr, int fq) const {
        const int row0 = u.pm * BM + wr * 64 + fr; const int col0 = u.pn * BM + wc * 32 + 8 * fq;
#pragma unroll
        for (int ai = 0; ai < 2; ++ai)
#pragma unroll
            for (int m = 0; m < 4; ++m) { bf16_t* rowp = O + (size_t)(row0 + ai * HALF + m * 16) * ldc + col0;
#pragma unroll
                for (int bj = 0; bj < 2; ++bj) { const f32x4 v0 = acc[ai][bj][m][0], v1 = acc[ai][bj][m][1];
                    u32x4 w; w.x = pk2(v0[0], v0[1]); w.y = pk2(v0[2], v0[3]); w.z = pk2(v1[0], v1[1]); w.w = pk2(v1[2], v1[3]);
                    *(u32x4*)(rowp + bj * HALF) = w; } }
    }
};
struct EpiResF32 {
    static constexpr bool PERM = false;
    const float* base; float* out; int ldc;
    __device__ __forceinline__ void operator()(const f32x4 (&acc)[2][2][4][2], const Unit& u, int wr, int wc, int fr, int fq) const {
        const int row0 = u.pm * BM + wr * 64 + fr; const int col0 = u.pn * BM + wc * 32 + 4 * fq;
#pragma unroll
        for (int ai = 0; ai < 2; ++ai)
#pragma unroll
            for (int m = 0; m < 4; ++m) { const size_t off = (size_t)(row0 + ai * HALF + m * 16) * ldc + col0;
#pragma unroll
                for (int bj = 0; bj < 2; ++bj)
#pragma unroll
                    for (int n = 0; n < 2; ++n) { const f32x4 b = *(const f32x4*)(base + off + bj * HALF + n * 16); *(f32x4*)(out + off + bj * HALF + n * 16) = b + acc[ai][bj][m][n]; } }
    }
};
struct EpiSwiGLU {
    static constexpr bool PERM = true;
    bf16_t* O; int ldc;
    __device__ __forceinline__ void operator()(const f32x4 (&acc)[2][2][4][2], const Unit& u, int wr, int wc, int fr, int fq) const {
        const int row0 = u.pm * BM + wr * 64 + fr; const int col0 = u.pn * HALF + wc * 32 + 8 * fq;
#pragma unroll
        for (int ai = 0; ai < 2; ++ai)
#pragma unroll
            for (int m = 0; m < 4; ++m) { bf16_t* rowp = O + (size_t)(row0 + ai * HALF + m * 16) * ldc + col0;
                float a[8];
#pragma unroll
                for (int n = 0; n < 2; ++n)
#pragma unroll
                    for (int i = 0; i < 4; ++i) { const float g = acc[ai][0][m][n][i], up = acc[ai][1][m][n][i];
                        const float s = g * __builtin_amdgcn_rcpf(1.0f + __builtin_amdgcn_exp2f(-g * 1.4426950408889634f)); a[n * 4 + i] = s * up; }
                u32x4 w; w.x = pk2(a[0], a[1]); w.y = pk2(a[2], a[3]); w.z = pk2(a[4], a[5]); w.w = pk2(a[6], a[7]);
                *(u32x4*)rowp = w; }
    }
};

template <class Epi, class Sched, bool ALIGN_EPI>
__device__ __forceinline__ void gemm_phase(PG8_LAS unsigned char* lds, const Gemm g, const Sched& S, const Epi& E) {
    const int tid = threadIdx.x, wid = __builtin_amdgcn_readfirstlane(tid >> 6), lane = tid & 63, wr = wid >> 2, wc = wid & 3, fr = lane & 15, fq = lane >> 4;
    const int K = g.K, nt = K / BK;
    unsigned voffA[2], voffB[2];
#pragma unroll
    for (int i = 0; i < 2; ++i) { int R, C; stage_rc(tid * 16 + i * 8192, R, C); const int Rb = Epi::PERM ? ((R & ~31) + perm32(R & 31)) : R;
        voffA[i] = (unsigned)(R * g.lda + C) * 2u; voffB[i] = (unsigned)(Rb * g.ldb + C) * 2u; }
    const size_t kstep = (size_t)(BK * 2);
    const size_t hstepA = (size_t)HALF * g.lda * 2, hstepB = (size_t)HALF * g.ldb * 2;
    const unsigned ldsw = (unsigned)wid * 1024u;
    const int aoff = lds_byte(wr * 64 + fr, fq * 8), boff = lds_byte(wc * 32 + fr, fq * 8);
#define PG8_SA(b, h) (((b) * 2 + (h)) * HTB)
#define PG8_SB(b, h) ((4 + (b) * 2 + (h)) * HTB)
#define PG8_STAGE(bufoff, gbase, voff) do { _Pragma("unroll") for (int _i = 0; _i < 2; ++_i) \
        __builtin_amdgcn_global_load_lds((const unsigned*)((const char*)(gbase) + (voff)[_i]), (PG8_LAS unsigned*)(lds + (bufoff) + ldsw + _i * 8192), 16, 0, 0); } while (0)
#define PG8_LDA(dst, b, h) do { _Pragma("unroll") for (int m = 0; m < 4; ++m) _Pragma("unroll") for (int k = 0; k < 2; ++k) dst[m][k] = *(const PG8_LAS bf16x8*)(lds + PG8_SA(b, h) + aoff + m * 2048 + k * 1024); } while (0)
#define PG8_LDB(dst, b, h) do { _Pragma("unroll") for (int n = 0; n < 2; ++n) _Pragma("unroll") for (int k = 0; k < 2; ++k) dst[n][k] = *(const PG8_LAS bf16x8*)(lds + PG8_SB(b, h) + boff + n * 2048 + k * 1024); } while (0)
#define PG8_MMA(ai, bj, At, Bt) do { __builtin_amdgcn_s_setprio(1); _Pragma("unroll") for (int m = 0; m < 4; ++m) _Pragma("unroll") for (int n = 0; n < 2; ++n) _Pragma("unroll") for (int k = 0; k < 2; ++k) \
        acc[ai][bj][m][n] = __builtin_amdgcn_mfma_f32_16x16x32_bf16(Bt[n][k], At[m][k], acc[ai][bj][m][n], 0, 0, 0); __builtin_amdgcn_s_setprio(0); } while (0)
#define PG8_WAIT_V(n) asm volatile("s_waitcnt vmcnt(" #n ")" ::: "memory")
#define PG8_WAIT_L(n) asm volatile("s_waitcnt lgkmcnt(" #n ")" ::: "memory")
#define PG8_BAR __builtin_amdgcn_s_barrier()
#define PG8_SCHED __builtin_amdgcn_sched_barrier(0)
    Unit cur, nxt; int ui = 0;
    if (!S.next(0, cur)) return;
    f32x4 acc[2][2][4][2];
#pragma unroll
    for (int a = 0; a < 2; ++a)
#pragma unroll
        for (int b = 0; b < 2; ++b)
#pragma unroll
            for (int m = 0; m < 4; ++m)
#pragma unroll
                for (int n = 0; n < 2; ++n) acc[a][b][m][n] = (f32x4){0.f, 0.f, 0.f, 0.f};
    bf16x8 At[4][2], B0[2][2], B1[2][2];
    const char* cA = (const char*)g.A + (size_t)cur.aoff * 2; const char* cB = (const char*)g.Bt + (size_t)cur.boff * 2;
    PG8_STAGE(PG8_SB(0, 0), cB, voffB); PG8_STAGE(PG8_SB(0, 1), cB + hstepB, voffB); PG8_STAGE(PG8_SA(0, 0), cA, voffA); PG8_STAGE(PG8_SA(0, 1), cA + hstepA, voffA);
    if (wr == 1) PG8_BAR;
    PG8_WAIT_V(2); PG8_BAR;
    PG8_STAGE(PG8_SB(1, 0), cB + kstep, voffB); PG8_STAGE(PG8_SA(1, 0), cA + kstep, voffA); PG8_STAGE(PG8_SB(1, 1), cB + hstepB + kstep, voffB);
    PG8_WAIT_V(6); PG8_BAR;
    for (;;) {
        const bool has_next = S.next(ui + 1, nxt);
        const char* nA = has_next ? (const char*)g.A + (size_t)nxt.aoff * 2 : cA; const char* nB = has_next ? (const char*)g.Bt + (size_t)nxt.boff * 2 : cB;
        for (int t = 0; t < nt; t += 2) {
            const bool last = (t == nt - 2);
            const char* a1 = cA + (size_t)(t + 1) * kstep;
            const char* a2 = last ? nA : cA + (size_t)(t + 2) * kstep; const char* b2 = last ? nB : cB + (size_t)(t + 2) * kstep;
            const char* a3 = a2 + kstep; const char* b3 = b2 + kstep;
            PG8_LDB(B0, 0, 0); PG8_LDB(B1, 0, 1); PG8_SCHED; PG8_LDA(At, 0, 0); PG8_STAGE(PG8_SA(1, 1), a1 + hstepA, voffA);
            PG8_WAIT_V(8); PG8_WAIT_L(0); PG8_BAR; PG8_MMA(0, 0, At, B0); PG8_MMA(0, 1, At, B1); PG8_BAR; PG8_SCHED;
            PG8_LDA(At, 0, 1); PG8_STAGE(PG8_SB(0, 0), b2, voffB); PG8_STAGE(PG8_SB(0, 1), b2 + hstepB, voffB); PG8_STAGE(PG8_SA(0, 0), a2, voffA);
            PG8_WAIT_V(8); PG8_WAIT_L(0); PG8_BAR; PG8_MMA(1, 0, At, B0); PG8_MMA(1, 1, At, B1); PG8_BAR; PG8_SCHED;
            PG8_LDB(B0, 1, 0); PG8_LDB(B1, 1, 1); PG8_SCHED; PG8_LDA(At, 1, 0); PG8_STAGE(PG8_SA(0, 1), a2 + hstepA, voffA);
            PG8_WAIT_V(8); PG8_WAIT_L(0); PG8_BAR; PG8_MMA(0, 0, At, B0); PG8_MMA(0, 1, At, B1); PG8_BAR; PG8_SCHED;
            PG8_LDA(At, 1, 1); PG8_STAGE(PG8_SB(1, 0), b3, voffB); PG8_STAGE(PG8_SB(1, 1), b3 + hstepB, voffB); PG8_STAGE(PG8_SA(1, 0), a3, voffA);
            PG8_WAIT_V(8); PG8_WAIT_L(0); PG8_BAR; PG8_MMA(1, 0, At, B0); PG8_MMA(1, 1, At, B1); PG8_BAR; PG8_SCHED;
        }
        if constexpr (ALIGN_EPI) { if (wr == 0) PG8_BAR; }
        E(acc, cur, wr, wc, fr, fq);
        if (!has_next) break;
#pragma unroll
        for (int a = 0; a < 2; ++a)
#pragma unroll
            for (int b = 0; b < 2; ++b)
#pragma unroll
                for (int m = 0; m < 4; ++m)
#pragma unroll
                    for (int n = 0; n < 2; ++n) acc[a][b][m][n] = (f32x4){0.f, 0.f, 0.f, 0.f};
        cur = nxt; cA = nA; cB = nB; ++ui;
        if constexpr (ALIGN_EPI) { if (wr == 1) PG8_BAR; }
    }
    PG8_WAIT_V(0);
    if constexpr (!ALIGN_EPI) { if (wr == 0) PG8_BAR; }
    PG8_BAR;
#undef PG8_SA
#undef PG8_SB
#undef PG8_STAGE
#undef PG8_LDA
#undef PG8_LDB
#undef PG8_MMA
#undef PG8_WAIT_V
#undef PG8_WAIT_L
#undef PG8_BAR
#undef PG8_SCHED
}
}
namespace att {
constexpr int KVB = 64;
template <int DQK> struct Lay { static constexpr int NQ = DQK / 16, KP = DQK * 2 + 16, KBYTES = 64 * KP; };
constexpr int VBYTES = 64 * 64 * 2;
constexpr int L_K = 0;
constexpr int L_V = 28672;
constexpr int L_WS = L_V + 2 * VBYTES;
constexpr int L_OST = L_WS + 8 * 64 * 4;
constexpr int L_BT = L_OST + 8 * 4096;
constexpr int L_END = L_BT + 2048;
static_assert(2 * Lay<96>::KBYTES <= L_V && L_END <= RING_BYTES, "attention LDS map");

__device__ __forceinline__ int crow(int r, int hi) { return (r & 3) + 8 * (r >> 2) + 4 * hi; }
__device__ __forceinline__ int v_st(int k, int c) { const int kk = (k & ~0xC) | ((k & 4) << 1) | ((k & 8) >> 1); return ((kk >> 3) * 2 + (c >> 5)) * 512 + ((kk & 7) * 32 + (c & 31)) * 2; }
__device__ __forceinline__ int v_rd_base(int lane) { return ((lane & 3) << 3) | (((lane >> 2) & 3) << 6) | (((lane >> 4) & 1) << 5) | (((lane >> 5) & 1) << 8); }
constexpr int v_rd_off(int d0, int ks, int half) { return d0 * 512 + ks * 2048 + half * 1024; }
template <int OFF> __device__ __forceinline__ s16x4 tr_read(int vb) {
    s16x4 r; asm volatile("ds_read_b64_tr_b16 %0, %1 offset:%2" : "=&v"(r) : "v"(vb), "i"(OFF) : "memory"); return r;
}
template <int D0> __device__ __forceinline__ void pv_one(f32x16& od, int vb, bf16x8 pa0, bf16x8 pa1, bf16x8 pa2, bf16x8 pa3) {
    const s16x4 l0 = tr_read<v_rd_off(D0, 0, 0)>(vb), h0 = tr_read<v_rd_off(D0, 0, 1)>(vb), l1 = tr_read<v_rd_off(D0, 1, 0)>(vb), h1 = tr_read<v_rd_off(D0, 1, 1)>(vb);
    const s16x4 l2 = tr_read<v_rd_off(D0, 2, 0)>(vb), h2 = tr_read<v_rd_off(D0, 2, 1)>(vb), l3 = tr_read<v_rd_off(D0, 3, 0)>(vb), h3 = tr_read<v_rd_off(D0, 3, 1)>(vb);
    asm volatile("s_waitcnt lgkmcnt(0)" ::: "memory"); __builtin_amdgcn_sched_barrier(0);
#define ATT_PK(L, H) (bf16x8){L[0], L[1], L[2], L[3], H[0], H[1], H[2], H[3]}
    od = __builtin_amdgcn_mfma_f32_32x32x16_bf16(pa0, ATT_PK(l0, h0), od, 0, 0, 0);
    od = __builtin_amdgcn_mfma_f32_32x32x16_bf16(pa1, ATT_PK(l1, h1), od, 0, 0, 0);
    od = __builtin_amdgcn_mfma_f32_32x32x16_bf16(pa2, ATT_PK(l2, h2), od, 0, 0, 0);
    od = __builtin_amdgcn_mfma_f32_32x32x16_bf16(pa3, ATT_PK(l3, h3), od, 0, 0, 0);
#undef ATT_PK
}

template <int DQK, bool WIN>
__device__ __forceinline__ void attn_unit(const bf16* Qp, int ldq, const bf16* Kn, int ldk, const bf16* Kr, int ldkr, const bf16* Vp, int ldv, bf16* Op, int ldo,
                                          int kt0, int kt1, float negc, int q0, const float* btab, float sinkl2, char* shm) {
    constexpr int NQ = Lay<DQK>::NQ, KP = Lay<DQK>::KP, KBYTES = Lay<DQK>::KBYTES;
    const int tid = threadIdx.x, lane = tid & 63, r32 = lane & 31, hi = lane >> 5; const int wid = __builtin_amdgcn_readfirstlane(tid >> 6);
    char* K_lds = shm + L_K; char* V_lds = shm + L_V;
    float* wsf = (float*)(shm + L_WS) + wid * 64;
    const float* bt = (const float*)(shm + L_BT);
    if constexpr (WIN) { ((float*)(shm + L_BT))[tid] = btab[tid]; }
    bf16x8 qr[NQ];
    { const bf16* Qw = Qp + (size_t)(wid * 32 + r32) * ldq + hi * 8;
#pragma unroll
      for (int d0 = 0; d0 < NQ; ++d0) qr[d0] = *reinterpret_cast<const bf16x8*>(Qw + d0 * 16); }
    const int srow = tid >> 3, sc = tid & 7;
    const bf16* kn_src = Kn + (size_t)srow * ldk + sc * 8;
    const bf16* v_src = Vp + (size_t)srow * ldv + sc * 8;
    const bf16* kr_src = (DQK == 96) ? (Kr + (size_t)(tid >> 2) * ldkr + (tid & 3) * 8) : nullptr;
    const int kn_dst = srow * KP + sc * 16, kr_dst = (tid >> 2) * KP + 128 + (tid & 3) * 16, v_dst = v_st(srow, sc * 8);
    const int vb0 = (int)(uintptr_t)V_lds + v_rd_base(lane);
    bf16x8 s_kn, s_kr, s_v;
#define ATT_LOAD(t) do { const size_t k0_ = (size_t)(t) * KVB; s_kn = *reinterpret_cast<const bf16x8*>(kn_src + k0_ * ldk); s_v = *reinterpret_cast<const bf16x8*>(v_src + k0_ * ldv); \
        if (DQK == 96) { if (tid < 256) s_kr = *reinterpret_cast<const bf16x8*>(kr_src + k0_ * ldkr); } } while (0)
#define ATT_WRITE(b) do { *reinterpret_cast<bf16x8*>(K_lds + (b) * KBYTES + kn_dst) = s_kn; *reinterpret_cast<bf16x8*>(V_lds + (b) * VBYTES + v_dst) = s_v; \
        if (DQK == 96) { if (tid < 256) *reinterpret_cast<bf16x8*>(K_lds + (b) * KBYTES + kr_dst) = s_kr; } } while (0)
    f32x16 o[2]; o[0] = f32x16{}; o[1] = f32x16{};
    float lsum = 0.f;
    f32x16 cinit;
#pragma unroll
    for (int r = 0; r < 16; ++r) cinit[r] = negc;
    const int qw = q0 + wid * 32;
    ATT_LOAD(kt0); ATT_WRITE(0); __syncthreads();
    for (int t = kt0; t < kt1; ++t) {
        const int cur = (t - kt0) & 1;
        if (t + 1 < kt1) ATT_LOAD(t + 1);
        bool active = true;
        if constexpr (WIN) { const int k0 = t * KVB; active = (k0 + 63 >= qw - 128) && (k0 <= qw + 159); }
        if (active) {
            f32x16 p0 = cinit, p1 = cinit;
            { const char* kb = K_lds + cur * KBYTES + r32 * KP + hi * 16;
#pragma unroll
              for (int d0 = 0; d0 < NQ; ++d0) {
                  const bf16x8 b0 = *reinterpret_cast<const bf16x8*>(kb + d0 * 32);
                  const bf16x8 b1 = *reinterpret_cast<const bf16x8*>(kb + 32 * KP + d0 * 32);
                  p0 = __builtin_amdgcn_mfma_f32_32x32x16_bf16(b0, qr[d0], p0, 0, 0, 0);
                  p1 = __builtin_amdgcn_mfma_f32_32x32x16_bf16(b1, qr[d0], p1, 0, 0, 0); } }
            if constexpr (WIN) {
                const int base = t * KVB - (qw + r32) + 256 + 4 * hi;
#pragma unroll
                for (int r = 0; r < 16; ++r) { const int ix = base + (r & 3) + 8 * (r >> 2); p0[r] += bt[ix]; p1[r] += bt[ix + 32]; }
            }
#pragma unroll
            for (int r = 0; r < 16; ++r) { p0[r] = __builtin_amdgcn_exp2f(p0[r]); p1[r] = __builtin_amdgcn_exp2f(p1[r]); }
            { float ps = 0.f;
#pragma unroll
              for (int r = 0; r < 16; ++r) ps += p0[r] + p1[r];
              lsum += ps; }
            bf16x8 pa0, pa1, pa2, pa3;
#define ATT_PK4(P, BASE, OUT) do { unsigned a0 = pk2(P[BASE + 0], P[BASE + 1]), a1 = pk2(P[BASE + 2], P[BASE + 3]);   \
        unsigned b0_ = pk2(P[BASE + 4], P[BASE + 5]), b1_ = pk2(P[BASE + 6], P[BASE + 7]);                              \
        auto r0 = __builtin_amdgcn_permlane32_swap(a0, b0_, false, false); auto r1 = __builtin_amdgcn_permlane32_swap(a1, b1_, false, false); \
        u32x4 w = {r0[0], r1[0], r0[1], r1[1]}; OUT = *reinterpret_cast<bf16x8*>(&w); } while (0)
            ATT_PK4(p0, 0, pa0); ATT_PK4(p0, 8, pa1); ATT_PK4(p1, 0, pa2); ATT_PK4(p1, 8, pa3);
#undef ATT_PK4
            __builtin_amdgcn_sched_barrier(0);
            pv_one<0>(o[0], vb0 + cur * VBYTES, pa0, pa1, pa2, pa3);
            pv_one<1>(o[1], vb0 + cur * VBYTES, pa0, pa1, pa2, pa3);
        }
        if (t + 1 < kt1) ATT_WRITE(cur ^ 1);
        __syncthreads();
    }
#undef ATT_LOAD
#undef ATT_WRITE
    { auto rr = __builtin_amdgcn_permlane32_swap(__float_as_uint(lsum), __float_as_uint(lsum), false, false); lsum = __uint_as_float(rr[0]) + __uint_as_float(rr[1]); }
    if constexpr (WIN) lsum += __builtin_amdgcn_exp2f(sinkl2 + negc);
    if (hi == 0) wsf[r32] = lsum;
    LDS_WAIT();
    float rli[16];
#pragma unroll
    for (int r = 0; r < 16; ++r) rli[r] = __builtin_amdgcn_rcpf(wsf[crow(r, hi)]);
    { bf16* stg = (bf16*)(shm + L_OST) + wid * 2048;
#pragma unroll
      for (int r = 0; r < 16; ++r) { const int orow = crow(r, hi);
#pragma unroll
          for (int d0 = 0; d0 < 2; ++d0) stg[orow * 64 + d0 * 32 + r32] = (bf16)f2bf(o[d0][r] * rli[r]); }
      LDS_WAIT();
      bf16* Ow = Op + (size_t)(wid * 32) * ldo;
#pragma unroll
      for (int i = 0; i < 4; ++i) { const int row = i * 8 + (lane >> 3), ch = lane & 7; const u32x4 v = *(const u32x4*)(stg + row * 64 + ch * 8); *(u32x4*)(Ow + (size_t)row * ldo + ch * 8) = v; } }
    __syncthreads();
}
}
struct WaveId { int gw, ngw, lane, wave; };

__device__ __forceinline__ void tr_item(const float* W, int ldw, int k0, int n0, bf16* WT, int ldt, int drow0, int dk0, LAS float* scr, int lane) {
#pragma unroll 8
    for (int i = 0; i < 32; ++i) { const int kk = 2 * i + (lane >> 5); scr[kk * 33 + (lane & 31)] = W[(size_t)(k0 + kk) * ldw + n0 + (lane & 31)]; }
    LDS_WAIT(); asm volatile("" ::: "memory");
    const int c = lane & 7;
#pragma unroll
    for (int j = 0; j < 4; ++j) { const int n = (lane >> 3) + 8 * j; const LAS float* s = scr + (8 * c) * 33 + n;
        u32x4 o; o.x = pk2(s[0 * 33], s[1 * 33]); o.y = pk2(s[2 * 33], s[3 * 33]); o.z = pk2(s[4 * 33], s[5 * 33]); o.w = pk2(s[6 * 33], s[7 * 33]);
        *(u32x4*)(WT + (size_t)(drow0 + n) * ldt + dk0 + k0 + 8 * c) = o; }
    LDS_WAIT(); asm volatile("" ::: "memory");
}
template <int MAP>
__device__ __forceinline__ void tr_seg(int it, const float* W, int ldw, int N, bf16* WT, int ldt, int roff, int dk0, LAS float* scr, int lane) {
    const int nblk = N / 32, kb = it / nblk, nb = it % nblk, n0 = 32 * nb;
    int drow0;
    if (MAP == 0) drow0 = roff + n0;
    else if (MAP == 1) {
        if (n0 < 384) drow0 = n0;
        else if (n0 < 416) drow0 = PC_KROPE + (n0 - 384);
        else drow0 = n0 - 416 + PC_BQ;
    } else { drow0 = (n0 >> 7) * 256 + (n0 & 127) + (MAP == 3 ? 128 : 0); }
    tr_item(W, ldw, 64 * kb, n0, WT, ldt, drow0, dk0, scr, lane);
}
__device__ __forceinline__ int ilog2u(unsigned v) { return 31 - __builtin_clz(v); }
__device__ __forceinline__ int t5_bucket_dev(int rel) {
    const int n = rel < 0 ? -rel : rel; int b = rel > 0 ? 16 : 0;
    if (n < 8) return b + n;
    int large = 2 + ilog2u((unsigned)(n * n)); if (large > 15) large = 15;
    return b + large;
}
__device__ __forceinline__ float gain_absmax(const float* g, int n, int lane) { float m = 0.f; for (int i = lane; i < n; i += 64) m = fmaxf(m, fabsf(g[i])); return wave_max(m); }

__device__ __forceinline__ void ph_rmsnorm(const float* X, const float* g, bf16* H, const WaveId& w) {
    f32x4 gv[4];
#pragma unroll
    for (int j = 0; j < 4; ++j) gv[j] = ((const f32x4*)g)[w.lane + 64 * j];
    for (int m = w.gw; m < NT; m += w.ngw) {
        const f32x4* xr = (const f32x4*)(X + (size_t)m * DM) + w.lane;
        f32x4 v[4]; float ss = 0.f;
#pragma unroll
        for (int j = 0; j < 4; ++j) { v[j] = xr[64 * j]; ss += (v[j].x * v[j].x + v[j].y * v[j].y) + (v[j].z * v[j].z + v[j].w * v[j].w); }
        const float rstd = 1.0f / sqrtf(wave_sum(ss) * (1.0f / DM) + EPS);
        u32x2* o = (u32x2*)(H + (size_t)m * DM) + w.lane;
#pragma unroll
        for (int j = 0; j < 4; ++j) { u32x2 q; q.x = pk2(v[j].x * rstd * gv[j].x, v[j].y * rstd * gv[j].y); q.y = pk2(v[j].z * rstd * gv[j].z, v[j].w * rstd * gv[j].w); o[64 * j] = q; }
    }
}

__device__ __forceinline__ void row_to_lds(const bf16* row, int nchunks, LAS float* buf, int lane) {
    for (int c = lane; c < nchunks; c += 64) { const u32x4 v = *(const u32x4*)(row + c * 8); LAS float* d = buf + c * 8;
        d[0] = bf2f(v.x & 0xffffu); d[1] = bf2f(v.x >> 16); d[2] = bf2f(v.y & 0xffffu); d[3] = bf2f(v.y >> 16);
        d[4] = bf2f(v.z & 0xffffu); d[5] = bf2f(v.z >> 16); d[6] = bf2f(v.w & 0xffffu); d[7] = bf2f(v.w >> 16); }
    LDS_WAIT(); asm volatile("" ::: "memory");
}
template <int HD>
__device__ __forceinline__ float head_rstd(const LAS float* x  ) {
    float ss = 0.f;
#pragma unroll
    for (int e = 0; e < 8; ++e) ss += x[e] * x[e];
    ss += __shfl_xor(ss, 1); ss += __shfl_xor(ss, 2); if (HD == 64) ss += __shfl_xor(ss, 4);
    return 1.0f / sqrtf(ss * (1.0f / HD) + EPS);
}
__device__ __forceinline__ void rope8(const LAS float* hx, const float* g, float rstd, const LAS f32x2* cs, int jj, float scale, float (&out)[8]) {
    const int d0 = 8 * jj; const bool lo = jj < 2; const int pd0 = lo ? d0 + 16 : d0 - 16;
#pragma unroll
    for (int e = 0; e < 8; ++e) {
        const float y = hx[d0 + e] * rstd * g[d0 + e], yp = hx[pd0 + e] * rstd * g[pd0 + e];
        const f32x2 c = cs[(d0 + e) & 15];
        out[e] = (lo ? (y * c.x - yp * c.y) : (y * c.x + yp * c.y)) * scale;
    }
}
__device__ __forceinline__ void store8(bf16* p, const float (&v)[8]) { u32x4 w; w.x = pk2(v[0], v[1]); w.y = pk2(v[2], v[3]); w.z = pk2(v[4], v[5]); w.w = pk2(v[6], v[7]); *(u32x4*)p = w; }

__device__ __forceinline__ void ph_prep1(bf16* PROJ, const float* qa_g, const float* kva_g, const float* gq_g, const float* gk_g, const float* kr_g, const float* invf,
                                         LAS float* buf  , const WaveId& w) {
    LAS f32x2* cs = (LAS f32x2*)(buf + 1280);
    const int lane = w.lane; const float sB = 0.125f * LOG2E;
    for (int m = w.gw; m < NT; m += w.ngw) {
        bf16* row = PROJ + (size_t)m * PROJ_LD; const int s = m & (SEQ - 1);
        row_to_lds(row, PROJ_LD / 8, buf, lane);
        if (lane < 48) { const int a = lane >> 4, i = lane & 15; const float pos = (float)(a == 0 ? s : (a == 1 ? (s >> 6) : (s & 63))); float sn, c; sincosf(pos * invf[i], &sn, &c); cs[lane] = (f32x2){c, sn}; }
        { const LAS float* x = buf + PC_QLAT + 4 * lane; float ss = x[0] * x[0] + x[1] * x[1] + x[2] * x[2] + x[3] * x[3];
          const float rstd = 1.0f / sqrtf(wave_sum(ss) * (1.0f / 256) + EPS); const float* g = qa_g + 4 * lane;
          u32x2 q; q.x = pk2(x[0] * rstd * g[0], x[1] * rstd * g[1]); q.y = pk2(x[2] * rstd * g[2], x[3] * rstd * g[3]); *(u32x2*)(row + PC_QLAT + 4 * lane) = q; }
        { const LAS float* x = buf + PC_KVLAT + 2 * lane; float ss = x[0] * x[0] + x[1] * x[1];
          const float rstd = 1.0f / sqrtf(wave_sum(ss) * (1.0f / 128) + EPS); const float* g = kva_g + 2 * lane;
          *(unsigned*)(row + PC_KVLAT + 2 * lane) = pk2(x[0] * rstd * g[0], x[1] * rstd * g[1]); }
        LDS_WAIT(); asm volatile("" ::: "memory");
#pragma unroll
        for (int rnd = 0; rnd < 2; ++rnd) {
            const int hh = (lane >> 3) + 8 * rnd, j = lane & 7;
            const bool on = (rnd == 0) || (lane < 16);
            const int hoff = PC_BQ + 64 * (on ? hh : 0);
            const LAS float* hx = buf + hoff;
            const float rstd = head_rstd<64>(hx + 8 * j);
            const float* g = rnd == 0 ? gq_g : gk_g;
            const int blk = j >> 2, jj = j & 3; float out[8];
            rope8(hx + 32 * blk, g + 32 * blk, rstd, cs + 16 * (1 + blk), jj, rnd == 0 ? sB : 1.0f, out);
            if (on) store8(row + hoff + 8 * j, out);
        }
        { const int j = lane & 3; const LAS float* hx = buf + PC_KROPE; const float rstd = head_rstd<32>(hx + 8 * j); float out[8];
          rope8(hx, kr_g, rstd, cs, j, 1.0f, out);
          if (lane < 4) store8(row + PC_KROPE + 8 * j, out); }
        LDS_WAIT(); asm volatile("" ::: "memory");
    }
}
__device__ __forceinline__ void ph_prep2(bf16* UPO, const float* qn_g, const float* qr_g, const float* kn_g, const float* invf, LAS float* buf  , const WaveId& w) {
    LAS f32x2* cs = (LAS f32x2*)(buf + 1792);
    const int lane = w.lane; const float sA = 0.10206207261596577f * LOG2E;
    for (int m = w.gw; m < NT; m += w.ngw) {
        bf16* row = UPO + (size_t)m * UP_LD; const int s = m & (SEQ - 1);
        row_to_lds(row, UP_LD / 8, buf, lane);
        if (lane < 16) { float sn, c; sincosf((float)s * invf[lane], &sn, &c); cs[lane] = (f32x2){c, sn}; }
        LDS_WAIT(); asm volatile("" ::: "memory");
        {
          const int h = lane >> 3, j = lane & 7; const LAS float* hx = buf + 96 * h; const float rstd = head_rstd<64>(hx + 8 * j); float out[8];
#pragma unroll
          for (int e = 0; e < 8; ++e) out[e] = hx[8 * j + e] * rstd * qn_g[8 * j + e] * sA;
          store8(row + 96 * h + 8 * j, out); }
        {
          const int h = (lane >> 2) & 7, j = lane & 3; const LAS float* hx = buf + 96 * h + 64; const float rstd = head_rstd<32>(hx + 8 * j); float out[8];
          rope8(hx, qr_g, rstd, cs, j, sA, out);
          if (lane < 32) store8(row + 96 * h + 64 + 8 * j, out); }
        {
          const int h = lane >> 3, j = lane & 7; const LAS float* hx = buf + 768 + 128 * h; const float rstd = head_rstd<64>(hx + 8 * j); float out[8];
#pragma unroll
          for (int e = 0; e < 8; ++e) out[e] = hx[8 * j + e] * rstd * kn_g[8 * j + e];
          store8(row + 768 + 128 * h + 8 * j, out); }
        LDS_WAIT(); asm volatile("" ::: "memory");
    }
}
__device__ __forceinline__ void ph_prepc(bf16* PC, const float* q_g, const float* k_g, LAS float* buf  , const WaveId& w) {
    const int lane = w.lane; const float sC = 0.125f * LOG2E;
    for (int m = w.gw; m < NT; m += w.ngw) {
        bf16* row = PC + (size_t)m * PC_LD;
        row_to_lds(row, 1280 / 8, buf, lane);
#pragma unroll
        for (int rnd = 0; rnd < 3; ++rnd) {
            const int hh = (lane >> 3) + 8 * rnd, j = lane & 7; const bool on = hh < 20;
            const LAS float* hx = buf + 64 * (on ? hh : 0); const float rstd = head_rstd<64>(hx + 8 * j);
            const float* g = hh < 16 ? q_g : k_g; const float sc = hh < 16 ? sC : 1.0f; float out[8];
#pragma unroll
            for (int e = 0; e < 8; ++e) out[e] = hx[8 * j + e] * rstd * g[8 * j + e] * sc;
            if (on) store8(row + 64 * hh + 8 * j, out);
        }
        LDS_WAIT(); asm volatile("" ::: "memory");
    }
}

__device__ __forceinline__ void ph_router(const float* XR, const float* g, bf16* H2, const LAS float* wr, const float* b_group, const float* b_router,
                                          int* eidx, float* wts, int* rank, unsigned* cnt, const WaveId& w) {
    const int lane = w.lane;
    f32x4 gv[4];
#pragma unroll
    for (int j = 0; j < 4; ++j) gv[j] = ((const f32x4*)g)[lane + 64 * j];
    float bg[4], br[16];
#pragma unroll
    for (int i = 0; i < 4; ++i) bg[i] = b_group[i];
#pragma unroll
    for (int i = 0; i < 16; ++i) br[i] = b_router[i];
    for (int m = w.gw; m < NT; m += w.ngw) {
        const f32x4* xr = (const f32x4*)(XR + (size_t)m * DM) + lane;
        f32x4 v[4]; float ss = 0.f;
#pragma unroll
        for (int j = 0; j < 4; ++j) { v[j] = xr[64 * j]; ss += (v[j].x * v[j].x + v[j].y * v[j].y) + (v[j].z * v[j].z + v[j].w * v[j].w); }
        const float rstd = 1.0f / sqrtf(wave_sum(ss) * (1.0f / DM) + EPS);
        u32x2* o = (u32x2*)(H2 + (size_t)m * DM) + lane;
#pragma unroll
        for (int j = 0; j < 4; ++j) { v[j].x *= rstd * gv[j].x; v[j].y *= rstd * gv[j].y; v[j].z *= rstd * gv[j].z; v[j].w *= rstd * gv[j].w;
            u32x2 q; q.x = pk2(v[j].x, v[j].y); q.y = pk2(v[j].z, v[j].w); o[64 * j] = q; }
        float lg[20];
#pragma unroll
        for (int c = 0; c < 20; ++c) { float a = 0.f;
#pragma unroll
            for (int j = 0; j < 4; ++j) { const f32x4 ww = *((const LAS f32x4*)(wr + c * 1024) + lane + 64 * j); a += (v[j].x * ww.x + v[j].y * ww.y) + (v[j].z * ww.z + v[j].w * ww.w); }
            lg[c] = wave_sum(a); }
        float g0 = lg[0] + bg[0], g1 = lg[1] + bg[1], g2 = lg[2] + bg[2], g3 = lg[3] + bg[3];
        int gi = 0; float gm = g0; if (g1 > gm) { gm = g1; gi = 1; } if (g2 > gm) { gm = g2; gi = 2; } if (g3 > gm) { gm = g3; gi = 3; }
        const float gp = 1.0f / (expf(g0 - gm) + expf(g1 - gm) + expf(g2 - gm) + expf(g3 - gm));
        float e0, e1, e2, e3;
        if (gi == 0)      { e0 = lg[4] + br[0];   e1 = lg[5] + br[1];   e2 = lg[6] + br[2];   e3 = lg[7] + br[3]; }
        else if (gi == 1) { e0 = lg[8] + br[4];   e1 = lg[9] + br[5];   e2 = lg[10] + br[6];  e3 = lg[11] + br[7]; }
        else if (gi == 2) { e0 = lg[12] + br[8];  e1 = lg[13] + br[9];  e2 = lg[14] + br[10]; e3 = lg[15] + br[11]; }
        else              { e0 = lg[16] + br[12]; e1 = lg[17] + br[13]; e2 = lg[18] + br[14]; e3 = lg[19] + br[15]; }
        int i1 = 0; float m1 = e0; if (e1 > m1) { m1 = e1; i1 = 1; } if (e2 > m1) { m1 = e2; i1 = 2; } if (e3 > m1) { m1 = e3; i1 = 3; }
        int i2 = -1; float m2 = -3.0e38f;
        if (i1 != 0 && e0 > m2) { m2 = e0; i2 = 0; } if (i1 != 1 && e1 > m2) { m2 = e1; i2 = 1; } if (i1 != 2 && e2 > m2) { m2 = e2; i2 = 2; } if (i1 != 3 && e3 > m2) { m2 = e3; i2 = 3; }
        const float t2 = expf(m2 - m1); const float w1 = gp / (1.0f + t2), w2 = gp * t2 / (1.0f + t2);
        if (lane == 0) {
            const int ea = gi * 4 + i1, eb = gi * 4 + i2;
            const unsigned ra = __hip_atomic_fetch_add(cnt + ea, 1u, __ATOMIC_RELAXED, __HIP_MEMORY_SCOPE_AGENT);
            const unsigned rb = __hip_atomic_fetch_add(cnt + eb, 1u, __ATOMIC_RELAXED, __HIP_MEMORY_SCOPE_AGENT);
            eidx[2 * m] = ea; eidx[2 * m + 1] = eb; wts[2 * m] = w1; wts[2 * m + 1] = w2; rank[2 * m] = (int)ra; rank[2 * m + 1] = (int)rb;
        }
    }
}
__device__ __forceinline__ int moe_offsets(const unsigned* cnt, int (&off)[17]) {
    int a = 0;
#pragma unroll
    for (int e = 0; e < 16; ++e) { off[e] = a; a += ((int)cnt[e] + 255) & ~255; }
    off[16] = a; return a >> 8;
}
__device__ __forceinline__ void ph_scatter(const bf16* H2, bf16* HS, const int* eidx, int* rank, const unsigned* cnt, const WaveId& w) {
    int off[17]; moe_offsets(cnt, off);
    for (int m = w.gw; m < NT; m += w.ngw) {
        const u32x4* src = (const u32x4*)(H2 + (size_t)m * DM) + w.lane;
        const u32x4 v0 = src[0], v1 = src[64];
#pragma unroll
        for (int k = 0; k < 2; ++k) {
            const int e = eidx[2 * m + k]; int base = 0;
#pragma unroll
            for (int q = 0; q < 16; ++q) base = (q == e) ? off[q] : base;
            const int slot = base + rank[2 * m + k];
            u32x4* dst = (u32x4*)(HS + (size_t)slot * DM) + w.lane; dst[0] = v0; dst[64] = v1;
            if (w.lane == 0) rank[2 * m + k] = slot;
        }
    }
}
template <bool NORM>
__device__ __forceinline__ void ph_combine(float* XR, const bf16* Y, const int* slot, const float* wts, const float* g, bf16* H, const WaveId& w) {
    const int lane = w.lane;
    f32x4 gv[4];
    if (NORM) {
#pragma unroll
        for (int j = 0; j < 4; ++j) gv[j] = ((const f32x4*)g)[lane + 64 * j];
    }
    for (int m = w.gw; m < NT; m += w.ngw) {
        f32x4* xr = (f32x4*)(XR + (size_t)m * DM) + lane;
        const int s0 = slot[2 * m], s1 = slot[2 * m + 1]; const float w0 = wts[2 * m], w1 = wts[2 * m + 1];
        const u32x2* y0 = (const u32x2*)(Y + (size_t)s0 * DM) + lane; const u32x2* y1 = (const u32x2*)(Y + (size_t)s1 * DM) + lane;
        f32x4 v[4]; float ss = 0.f;
#pragma unroll
        for (int j = 0; j < 4; ++j) { v[j] = xr[64 * j]; const u32x2 a = y0[64 * j], b = y1[64 * j];
            v[j].x += w0 * bf2f(a.x & 0xffffu) + w1 * bf2f(b.x & 0xffffu); v[j].y += w0 * bf2f(a.x >> 16) + w1 * bf2f(b.x >> 16);
            v[j].z += w0 * bf2f(a.y & 0xffffu) + w1 * bf2f(b.y & 0xffffu); v[j].w += w0 * bf2f(a.y >> 16) + w1 * bf2f(b.y >> 16);
            xr[64 * j] = v[j]; ss += (v[j].x * v[j].x + v[j].y * v[j].y) + (v[j].z * v[j].z + v[j].w * v[j].w); }
        if (NORM) {
            const float rstd = 1.0f / sqrtf(wave_sum(ss) * (1.0f / DM) + EPS);
            u32x2* o = (u32x2*)(H + (size_t)m * DM) + lane;
#pragma unroll
            for (int j = 0; j < 4; ++j) { u32x2 q; q.x = pk2(v[j].x * rstd * gv[j].x, v[j].y * rstd * gv[j].y); q.y = pk2(v[j].z * rstd * gv[j].z, v[j].w * rstd * gv[j].w); o[64 * j] = q; }
        }
    }
}

__device__ __forceinline__ float dot8(const u32x4 a, const u32x4 b) {
    return bf2f(a.x & 0xffffu) * bf2f(b.x & 0xffffu) + bf2f(a.x >> 16) * bf2f(b.x >> 16) + bf2f(a.y & 0xffffu) * bf2f(b.y & 0xffffu) + bf2f(a.y >> 16) * bf2f(b.y >> 16)
         + bf2f(a.z & 0xffffu) * bf2f(b.z & 0xffffu) + bf2f(a.z >> 16) * bf2f(b.z >> 16) + bf2f(a.w & 0xffffu) * bf2f(b.w & 0xffffu) + bf2f(a.w >> 16) * bf2f(b.w >> 16);
}
template <int MODE>
__device__ __forceinline__ void naive_gemm(const bf16* A, int lda, const bf16* Bt, int ldb, int M, int N, int K, bf16* C, const float* base, float* out, int ldc, const WaveId& w) {
    const int nch = N / 64; const long items = (long)(M / 4) * nch;
    for (long it = w.gw; it < items; it += w.ngw) {
        const int mt = (int)(it / nch), n = (int)(it % nch) * 64 + w.lane;
        float a0 = 0.f, a1 = 0.f, a2 = 0.f, a3 = 0.f;
        const bf16* bp = Bt + (size_t)n * ldb; const bf16* ap = A + (size_t)(mt * 4) * lda;
        for (int k = 0; k < K; k += 8) { const u32x4 b = *(const u32x4*)(bp + k);
            a0 += dot8(*(const u32x4*)(ap + k), b); a1 += dot8(*(const u32x4*)(ap + lda + k), b); a2 += dot8(*(const u32x4*)(ap + 2 * lda + k), b); a3 += dot8(*(const u32x4*)(ap + 3 * lda + k), b); }
        const float r[4] = {a0, a1, a2, a3};
#pragma unroll
        for (int q = 0; q < 4; ++q) { const size_t o = (size_t)(mt * 4 + q) * ldc + n;
            if (MODE == 0) C[o] = (bf16)f2bf(r[q]); else out[o] = base[o] + r[q]; }
    }
}
__device__ __forceinline__ void naive_moe1(const bf16* HS, const bf16* WGU, bf16* ACT, const unsigned* cnt, const WaveId& w) {
    int off[17]; const int ntile = moe_offsets(cnt, off); const long items = (long)ntile * 64 * 8;
    for (long it = w.gw; it < items; it += w.ngw) {
        const int rq = (int)(it >> 3), j = (int)(it & 7) * 64 + w.lane, row0 = rq * 4;
        int e = 0;
#pragma unroll
        for (int q = 1; q < 16; ++q) e = (row0 >= off[q]) ? q : e;
        const bf16* gp = WGU + (size_t)e * 1024 * 1024 + (size_t)((j >> 7) * 256 + (j & 127)) * 1024; const bf16* up = gp + 128 * 1024;
        const bf16* ap = HS + (size_t)row0 * DM;
        float g0 = 0, g1 = 0, g2 = 0, g3 = 0, u0 = 0, u1 = 0, u2 = 0, u3 = 0;
        for (int k = 0; k < DM; k += 8) { const u32x4 bg = *(const u32x4*)(gp + k), bu = *(const u32x4*)(up + k);
            const u32x4 x0 = *(const u32x4*)(ap + k), x1 = *(const u32x4*)(ap + DM + k), x2 = *(const u32x4*)(ap + 2 * DM + k), x3 = *(const u32x4*)(ap + 3 * DM + k);
            g0 += dot8(x0, bg); g1 += dot8(x1, bg); g2 += dot8(x2, bg); g3 += dot8(x3, bg); u0 += dot8(x0, bu); u1 += dot8(x1, bu); u2 += dot8(x2, bu); u3 += dot8(x3, bu); }
        const float gg[4] = {g0, g1, g2, g3}, uu[4] = {u0, u1, u2, u3};
#pragma unroll
        for (int q = 0; q < 4; ++q) { const float s = gg[q] / (1.0f + expf(-gg[q])); ACT[(size_t)(row0 + q) * DEXP + j] = (bf16)f2bf(s * uu[q]); }
    }
}
__device__ __forceinline__ void naive_moe2(const bf16* ACT, const bf16* WD, bf16* Y, const unsigned* cnt, const WaveId& w) {
    int off[17]; const int ntile = moe_offsets(cnt, off); const long items = (long)ntile * 64 * 16;
    for (long it = w.gw; it < items; it += w.ngw) {
        const int rq = (int)(it >> 4), n = (int)(it & 15) * 64 + w.lane, row0 = rq * 4;
        int e = 0;
#pragma unroll
        for (int q = 1; q < 16; ++q) e = (row0 >= off[q]) ? q : e;
        const bf16* bp = WD + (size_t)e * 1024 * 512 + (size_t)n * 512; const bf16* ap = ACT + (size_t)row0 * DEXP;
        float a0 = 0, a1 = 0, a2 = 0, a3 = 0;
        for (int k = 0; k < DEXP; k += 8) { const u32x4 b = *(const u32x4*)(bp + k);
            a0 += dot8(*(const u32x4*)(ap + k), b); a1 += dot8(*(const u32x4*)(ap + DEXP + k), b); a2 += dot8(*(const u32x4*)(ap + 2 * DEXP + k), b); a3 += dot8(*(const u32x4*)(ap + 3 * DEXP + k), b); }
        const float r[4] = {a0, a1, a2, a3};
#pragma unroll
        for (int q = 0; q < 4; ++q) Y[(size_t)(row0 + q) * DM + n] = (bf16)f2bf(r[q]);
    }
}
template <int DQK, bool WIN>
__device__ __forceinline__ void naive_attn_row(const bf16* qrow, const bf16* Kn, int ldk, const bf16* Kr, int ldkr, const bf16* Vp, int ldv, bf16* orow,
                                               int qpos, const float* btab, float sinkl2, LAS float* qf  , int lane) {
    for (int d = lane; d < DQK; d += 64) qf[d] = bf2f(qrow[d]);
    LDS_WAIT(); asm volatile("" ::: "memory");
    float m = -1.0e30f, l = 0.f, o = 0.f;
    const int kbeg = WIN ? qpos - 128 : 0, nch = WIN ? 5 : SEQ / 64;
    for (int ci = 0; ci < nch; ++ci) {
        const int key = kbeg + ci * 64 + lane; const bool valid = !WIN || (key >= 0 && key < SEQ && key - qpos <= 128);
        const int kc = valid ? key : 0;
        float s = 0.f;
        { const bf16* kp = Kn + (size_t)kc * ldk;
#pragma unroll
          for (int c = 0; c < 8; ++c) { const u32x4 kv = *(const u32x4*)(kp + c * 8); const LAS float* q = qf + c * 8;
              s += q[0] * bf2f(kv.x & 0xffffu) + q[1] * bf2f(kv.x >> 16) + q[2] * bf2f(kv.y & 0xffffu) + q[3] * bf2f(kv.y >> 16) + q[4] * bf2f(kv.z & 0xffffu) + q[5] * bf2f(kv.z >> 16) + q[6] * bf2f(kv.w & 0xffffu) + q[7] * bf2f(kv.w >> 16); }
          if (DQK == 96) { const bf16* rp = Kr + (size_t)kc * ldkr;
#pragma unroll
              for (int c = 0; c < 4; ++c) { const u32x4 kv = *(const u32x4*)(rp + c * 8); const LAS float* q = qf + 64 + c * 8;
                  s += q[0] * bf2f(kv.x & 0xffffu) + q[1] * bf2f(kv.x >> 16) + q[2] * bf2f(kv.y & 0xffffu) + q[3] * bf2f(kv.y >> 16) + q[4] * bf2f(kv.z & 0xffffu) + q[5] * bf2f(kv.z >> 16) + q[6] * bf2f(kv.w & 0xffffu) + q[7] * bf2f(kv.w >> 16); } } }
        if (WIN) s = valid ? s + btab[key - qpos + 256] : -INFINITY;
        const float mn = fmaxf(m, wave_max(s)); const float p = exp2f(s - mn), al = exp2f(m - mn);
        l = l * al + wave_sum(p); o *= al; m = mn;
        const int kb = kbeg + ci * 64;
        for (int j = 0; j < 64; ++j) { const float pj = __shfl(p, j); int kk = kb + j; if (WIN) kk = (kk < 0 || kk >= SEQ) ? 0 : kk; o += pj * bf2f(Vp[(size_t)kk * ldv + lane]); }
    }
    if (WIN) { const float mn = fmaxf(m, sinkl2); const float al = exp2f(m - mn); l = l * al + exp2f(sinkl2 - mn); o *= al; }
    orow[lane] = (bf16)f2bf(o / l);
    LDS_WAIT(); asm volatile("" ::: "memory");
}
constexpr int NPHASE = 21;
struct Args { const float* in[28]; float* out; unsigned char* ws; int ph_lo, ph_hi; };
enum { I_X = 0, I_MIXN, I_FFNN, I_WINAB, I_QAN, I_WQUP, I_KVAN, I_WKVUP, I_QNG, I_KNG, I_QRG, I_KRG, I_GQG, I_GKG, I_WOUTAB, I_WINC, I_WQG, I_WKG, I_SINK, I_WOUTC,
       I_RELB, I_WGRP, I_BGRP, I_WRTR, I_BRTR, I_WGATE, I_WUP, I_WDOWN };

__global__ void __launch_bounds__(512, 2) mk_fwd(Args args) {
    extern __shared__ __attribute__((aligned(16))) unsigned char lds[];
    LAS unsigned char* L = (LAS unsigned char*)lds;
    const int tid = threadIdx.x, lane = tid & 63, wave = __builtin_amdgcn_readfirstlane(tid >> 6);
    const int G = gridDim.x, bx = blockIdx.x;
    const int vcu = (G % 8 == 0) ? (bx % 8) * (G / 8) + bx / 8 : bx;
    WaveId W; W.gw = bx * 8 + wave; W.ngw = G * 8; W.lane = lane; W.wave = wave;
    unsigned char* ws = args.ws;
    unsigned* ctl = (unsigned*)(ws + WS_CTL);
    float* tab = (float*)(ws + WS_TAB);
    int* r_eidx = (int*)(ws + WS_ROUTE); float* r_wts = (float*)(ws + WS_ROUTE + 512 * 1024); int* r_slot = (int*)(ws + WS_ROUTE + 1024 * 1024);
    bf16* WT_AB = (bf16*)(ws + WS_WAB); bf16* WT_UP = (bf16*)(ws + WS_WUP); bf16* WT_OAB = (bf16*)(ws + WS_WOAB); bf16* WT_C = (bf16*)(ws + WS_WC); bf16* WT_OC = (bf16*)(ws + WS_WOC);
    bf16* WT_GU = (bf16*)(ws + WS_WGU); bf16* WT_D = (bf16*)(ws + WS_WD);
    bf16* HB = (bf16*)(ws + WS_H); bf16* PROJ = (bf16*)(ws + WS_PROJ); bf16* UPO = (bf16*)(ws + WS_UPO); bf16* PROJC = (bf16*)(ws + WS_PROJC);
    bf16* HS = (bf16*)(ws + WS_HS); bf16* ACT = (bf16*)(ws + WS_ACT);
    float* XR = args.out;
    volatile LAS unsigned* MISC = (volatile LAS unsigned*)(L + MISC_OFF);
    if (tid < 16) MISC[tid] = 0u;
    __syncthreads();
    const int lo = args.ph_lo, hi = args.ph_hi;
    XcdBarrier bar; bar.bar = ctl + CW_BAR; bar.x = 0; bar.st = nullptr;
    if (hi - lo > 1) bar = xcd_barrier_post(ctl + CW_BAR, MISC + 8);
#define IN(k) (lo <= (k) && (k) < hi)
#define SEAM(k) do { if (IN(k) && IN((k) + 1)) xcd_barrier(bar); } while (0)

    if (IN(0)) {
        LAS float* scr = (LAS float*)(L + wave * 16384);
        constexpr int I_AB = 16 * 37, I_QU = 4 * 24, I_KU = 2 * 32, I_O = 16 * 32, I_C = 16 * 48, I_E = 256;
        constexpr int NIT = I_AB + I_QU + I_KU + I_O + I_C + I_O + 3 * 32 * I_E;
        for (int it = W.gw; it < NIT; it += W.ngw) {
            int r = it;
            if (r < I_AB) { tr_seg<1>(r, args.in[I_WINAB], 1184, 1184, WT_AB, 1024, 0, 0, scr, lane); continue; } r -= I_AB;
            if (r < I_QU) { tr_seg<0>(r, args.in[I_WQUP], 768, 768, WT_UP, UP_K, 0, 0, scr, lane); continue; } r -= I_QU;
            if (r < I_KU) { tr_seg<0>(r, args.in[I_WKVUP], 1024, 1024, WT_UP, UP_K, 768, 256, scr, lane); continue; } r -= I_KU;
            if (r < I_O) { tr_seg<0>(r, args.in[I_WOUTAB], 1024, 1024, WT_OAB, 1024, 0, 0, scr, lane); continue; } r -= I_O;
            if (r < I_C) { tr_seg<0>(r, args.in[I_WINC], 1536, 1536, WT_C, 1024, 0, 0, scr, lane); continue; } r -= I_C;
            if (r < I_O) { tr_seg<0>(r, args.in[I_WOUTC], 1024, 1024, WT_OC, 1024, 0, 0, scr, lane); continue; } r -= I_O;
            const int le = r / (3 * I_E), q = r % (3 * I_E);
            if (q < I_E) tr_seg<2>(q, args.in[I_WGATE] + (size_t)le * 1024 * 512, 512, 512, WT_GU + (size_t)le * 1024 * 1024, 1024, 0, 0, scr, lane);
            else if (q < 2 * I_E) tr_seg<3>(q - I_E, args.in[I_WUP] + (size_t)le * 1024 * 512, 512, 512, WT_GU + (size_t)le * 1024 * 1024, 1024, 0, 0, scr, lane);
            else tr_seg<0>(q - 2 * I_E, args.in[I_WDOWN] + (size_t)le * 512 * 1024, 1024, 1024, WT_D + (size_t)le * 1024 * 512, 512, 0, 0, scr, lane);
        }
        { const int gt = W.gw * 64 + lane, ngt = W.ngw * 64; const u32x4 z = {0u, 0u, 0u, 0u};
          for (int i = gt; i < 96 * 128; i += ngt) *(u32x4*)(WT_AB + (size_t)(1184 + i / 128) * 1024 + (i % 128) * 8) = z;
          for (int i = gt; i < 768 * 16; i += ngt) *(u32x4*)(WT_UP + (size_t)(i / 16) * UP_K + 256 + (i % 16) * 8) = z;
          for (int i = gt; i < 1024 * 32; i += ngt) *(u32x4*)(WT_UP + (size_t)(768 + i / 32) * UP_K + (i % 32) * 8) = z;
          const float* relb = args.in[I_RELB];
          for (int i = gt; i < 16 * 512; i += ngt) { const int h = i >> 9, rel = (i & 511) - 256; tab[TB_BIAS + i] = (rel >= -128 && rel <= 128) ? relb[t5_bucket_dev(rel) * 16 + h] * LOG2E : -1.0e30f; } }
        if (W.gw == 0) {
            const float gqn = gain_absmax(args.in[I_QNG], 64, lane), gkn = gain_absmax(args.in[I_KNG], 64, lane), gqr = gain_absmax(args.in[I_QRG], 32, lane), gkr = gain_absmax(args.in[I_KRG], 32, lane);
            const float gbq = gain_absmax(args.in[I_GQG], 64, lane), gbk = gain_absmax(args.in[I_GKG], 64, lane), gcq = gain_absmax(args.in[I_WQG], 64, lane), gck = gain_absmax(args.in[I_WKG], 64, lane);
            float bm = 0.f; for (int i = lane; i < 512; i += 64) bm = fmaxf(bm, args.in[I_RELB][i]); bm = wave_max(bm);
            if (lane == 0) { tab[TB_CONST + 0] = -(0.10206207261596577f * LOG2E * (64.f * gqn * gkn + 32.f * gqr * gkr));
                             tab[TB_CONST + 1] = -(0.125f * LOG2E * 64.f * gbq * gbk);
                             tab[TB_CONST + 2] = -(0.125f * LOG2E * 64.f * gcq * gck + bm * LOG2E); }
            if (lane < 16) { tab[TB_CONST + 16 + lane] = args.in[I_SINK][lane] * LOG2E; tab[TB_INV + lane] = powf(10000.0f, -(float)lane * (1.0f / 16.0f)); }
        }
        ph_rmsnorm(args.in[I_X], args.in[I_MIXN], HB, W);
    }
    SEAM(0);


        if (IN(1)) {
#if MK_GEMM
            pg8::Gemm g{HB, WT_AB, 1024, 1024, 1024}; pg8::StaticOrder S; S.init(NT, PROJ_LD, 1024, 1024, G, bx); pg8::EpiStoreBf16 E{PROJ, PROJ_LD};
            pg8::gemm_phase<pg8::EpiStoreBf16, pg8::StaticOrder, true>(L, g, S, E);
#else
            naive_gemm<0>(HB, 1024, WT_AB, 1024, NT, PROJ_LD, 1024, PROJ, nullptr, nullptr, PROJ_LD, W);
#endif
        }
        SEAM(1);
        if (IN(2)) ph_prep1(PROJ, args.in[I_QAN], args.in[I_KVAN], args.in[I_GQG], args.in[I_GKG], args.in[I_KRG], tab + TB_INV, (LAS float*)(L + wave * 8192), W);
        SEAM(2);
        if (IN(3)) {
#if MK_GEMM
            pg8::Gemm g{PROJ, WT_UP, PROJ_LD, UP_K, UP_K}; pg8::StaticOrder S; S.init(NT, UP_LD, PROJ_LD, UP_K, G, bx); pg8::EpiStoreBf16 E{UPO, UP_LD};
            pg8::gemm_phase<pg8::EpiStoreBf16, pg8::StaticOrder, true>(L, g, S, E);
#else
            naive_gemm<0>(PROJ, PROJ_LD, WT_UP, UP_K, NT, UP_LD, UP_K, UPO, nullptr, nullptr, UP_LD, W);
#endif
        }
        SEAM(3);
        if (IN(4)) ph_prep2(UPO, args.in[I_QNG], args.in[I_QRG], args.in[I_KNG], tab + TB_INV, (LAS float*)(L + wave * 8192), W);
        SEAM(4);
        if (IN(5)) {
            const float negcA = tab[TB_CONST + 0], negcB = tab[TB_CONST + 1];
#if MK_ATTN
            for (int u = vcu; u < 1024; u += G) { const int b = u >> 7, h = (u >> 4) & 7, qb = u & 15; const size_t r0 = (size_t)b * SEQ, rq = r0 + qb * 256;
                att::attn_unit<96, false>(UPO + rq * UP_LD + 96 * h, UP_LD, UPO + r0 * UP_LD + 768 + 128 * h, UP_LD, PROJ + r0 * PROJ_LD + PC_KROPE, PROJ_LD,
                                          UPO + r0 * UP_LD + 768 + 128 * h + 64, UP_LD, HB + rq * DM + 64 * h, DM, 0, SEQ / 64, negcA, 0, nullptr, 0.f, (char*)lds); }
            for (int u = vcu; u < 1024; u += G) { const int b = u >> 7, h = (u >> 4) & 7, qb = u & 15; const size_t r0 = (size_t)b * SEQ, rq = r0 + qb * 256;
                att::attn_unit<64, false>(PROJ + rq * PROJ_LD + PC_BQ + 64 * h, PROJ_LD, PROJ + r0 * PROJ_LD + PC_BK + 64 * (h >> 2), PROJ_LD, nullptr, 0,
                                          PROJ + r0 * PROJ_LD + PC_BV + 64 * (h >> 2), PROJ_LD, HB + rq * DM + 512 + 64 * h, DM, 0, SEQ / 64, negcB, 0, nullptr, 0.f, (char*)lds); }
#else
            LAS float* qf = (LAS float*)(L + wave * 512);
            for (long it = W.gw; it < (long)NT * 8; it += W.ngw) { const int m = (int)(it >> 3), h = (int)(it & 7); const size_t r0 = (size_t)(m / SEQ) * SEQ;
                naive_attn_row<96, false>(UPO + (size_t)m * UP_LD + 96 * h, UPO + r0 * UP_LD + 768 + 128 * h, UP_LD, PROJ + r0 * PROJ_LD + PC_KROPE, PROJ_LD,
                                          UPO + r0 * UP_LD + 768 + 128 * h + 64, UP_LD, HB + (size_t)m * DM + 64 * h, 0, nullptr, 0.f, qf, lane); }
            for (long it = W.gw; it < (long)NT * 8; it += W.ngw) { const int m = (int)(it >> 3), h = (int)(it & 7); const size_t r0 = (size_t)(m / SEQ) * SEQ;
                naive_attn_row<64, false>(PROJ + (size_t)m * PROJ_LD + PC_BQ + 64 * h, PROJ + r0 * PROJ_LD + PC_BK + 64 * (h >> 2), PROJ_LD, nullptr, 0,
                                          PROJ + r0 * PROJ_LD + PC_BV + 64 * (h >> 2), PROJ_LD, HB + (size_t)m * DM + 512 + 64 * h, 0, nullptr, 0.f, qf, lane); }
            (void)negcA; (void)negcB;
#endif
        }
        SEAM(5);
        if (IN(6)) {
#if MK_GEMM
            pg8::Gemm g{HB, WT_OAB, 1024, 1024, 1024}; pg8::StaticOrder S; S.init(NT, DM, 1024, 1024, G, bx); pg8::EpiResF32 E{args.in[I_X], XR, DM};
            pg8::gemm_phase<pg8::EpiResF32, pg8::StaticOrder, true>(L, g, S, E);
#else
            naive_gemm<1>(HB, 1024, WT_OAB, 1024, NT, DM, 1024, nullptr, args.in[I_X], XR, DM, W);
#endif
        }
        SEAM(6);

    { constexpr int LAYER_ = 0;
    constexpr int layer = LAYER_; constexpr int pb = 9 * layer;
    unsigned* cnt = ctl + CW_CNT + 64 * layer;
    int* eidx = r_eidx + (size_t)layer * NT * 2; float* wts = r_wts + (size_t)layer * NT * 2; int* slot = r_slot + (size_t)layer * NT * 2;
    if (IN(7 + pb)) {
        LAS float* wr = (LAS float*)L;
        const float* wg = args.in[I_WGRP] + (size_t)layer * 1024 * 4; const float* wrt = args.in[I_WRTR] + (size_t)layer * 1024 * 16;
        for (int i = tid; i < 1024 * 4; i += 512) wr[(i & 3) * 1024 + (i >> 2)] = wg[i];
        for (int i = tid; i < 1024 * 16; i += 512) wr[(4 + (i & 15)) * 1024 + (i >> 4)] = wrt[i];
        __syncthreads();
        ph_router(XR, args.in[I_FFNN] + layer * DM, HB, wr, args.in[I_BGRP] + layer * 4, args.in[I_BRTR] + layer * 16, eidx, wts, slot, cnt, W);
    }
    SEAM(7 + pb);
    if (IN(8 + pb)) ph_scatter(HB, HS, eidx, slot, cnt, W);
    SEAM(8 + pb);
    if (IN(9 + pb)) {
#if MK_GEMM
        LAS unsigned char* tile_e = L + MISC_OFF + 1024;
        if (tid < 64) { int off[17]; const int ntile = moe_offsets(cnt, off);
            for (int t = lane; t < ntile; t += 64) { const int row = t * 256; int e = 0;
#pragma unroll
                for (int q = 1; q < 16; ++q) e = (row >= off[q]) ? q : e;
                tile_e[t] = (unsigned char)e; }
            if (lane == 0) MISC[4] = (unsigned)ntile; }
        __syncthreads();
        const int ntile = (int)MISC[4];
        pg8::Gemm g{HS, WT_GU + (size_t)layer * 16 * 1024 * 1024, 1024, 1024, 1024};
        pg8::MoeOrder S{tile_e, ntile, 4, G, vcu, 1024, 1024, (long)1024 * 1024}; pg8::EpiSwiGLU E{ACT, DEXP};
        pg8::gemm_phase<pg8::EpiSwiGLU, pg8::MoeOrder, true>(L, g, S, E);
#else
        naive_moe1(HS, WT_GU + (size_t)layer * 16 * 1024 * 1024, ACT, cnt, W);
#endif
    }
    SEAM(9 + pb);
    if (IN(10 + pb)) {
#if MK_GEMM
        LAS unsigned char* tile_e = L + MISC_OFF + 1024;
        if (tid < 64) { int off[17]; const int ntile = moe_offsets(cnt, off);
            for (int t = lane; t < ntile; t += 64) { const int row = t * 256; int e = 0;
#pragma unroll
                for (int q = 1; q < 16; ++q) e = (row >= off[q]) ? q : e;
                tile_e[t] = (unsigned char)e; }
            if (lane == 0) MISC[4] = (unsigned)ntile; }
        __syncthreads();
        const int ntile = (int)MISC[4];
        pg8::Gemm g{ACT, WT_D + (size_t)layer * 16 * 1024 * 512, DEXP, DEXP, DEXP};
        pg8::MoeOrder S{tile_e, ntile, 4, G, vcu, DEXP, DEXP, (long)1024 * 512}; pg8::EpiStoreBf16 E{HS, DM};
        pg8::gemm_phase<pg8::EpiStoreBf16, pg8::MoeOrder, true>(L, g, S, E);
#else
        naive_moe2(ACT, WT_D + (size_t)layer * 16 * 1024 * 512, HS, cnt, W);
#endif
    }
    SEAM(10 + pb);
    if (IN(11 + pb)) {
        if (layer == 0) ph_combine<true>(XR, HS, slot, wts, args.in[I_MIXN] + DM, HB, W);
        else ph_combine<false>(XR, HS, slot, wts, nullptr, nullptr, W);
    }
    if (layer == 0) SEAM(11);

    }

        if (IN(12)) {
#if MK_GEMM
            pg8::Gemm g{HB, WT_C, 1024, 1024, 1024}; pg8::StaticOrder S; S.init(NT, PC_LD, 1024, 1024, G, bx); pg8::EpiStoreBf16 E{PROJC, PC_LD};
            pg8::gemm_phase<pg8::EpiStoreBf16, pg8::StaticOrder, true>(L, g, S, E);
#else
            naive_gemm<0>(HB, 1024, WT_C, 1024, NT, PC_LD, 1024, PROJC, nullptr, nullptr, PC_LD, W);
#endif
        }
        SEAM(12);
        if (IN(13)) ph_prepc(PROJC, args.in[I_WQG], args.in[I_WKG], (LAS float*)(L + wave * 8192), W);
        SEAM(13);
        if (IN(14)) {
            const float negcC = tab[TB_CONST + 2];
#if MK_ATTN
            for (int u = vcu; u < 2048; u += G) { const int b = u >> 8, h = (u >> 4) & 15, qb = u & 15; const size_t r0 = (size_t)b * SEQ, rq = r0 + qb * 256;
                const int q0 = qb * 256; const int kt0 = q0 >= 128 ? (q0 - 128) / 64 : 0; const int kt1 = (q0 / 64 + 6) < 64 ? (q0 / 64 + 6) : 64;
                att::attn_unit<64, true>(PROJC + rq * PC_LD + 64 * h, PC_LD, PROJC + r0 * PC_LD + 1024 + 64 * (h >> 2), PC_LD, nullptr, 0,
                                         PROJC + r0 * PC_LD + 1280 + 64 * (h >> 2), PC_LD, HB + rq * DM + 64 * h, DM, kt0, kt1, negcC, q0, tab + TB_BIAS + 512 * h, tab[TB_CONST + 16 + h], (char*)lds); }
#else
            LAS float* qf = (LAS float*)(L + wave * 512);
            for (long it = W.gw; it < (long)NT * 16; it += W.ngw) { const int m = (int)(it >> 4), h = (int)(it & 15); const size_t r0 = (size_t)(m / SEQ) * SEQ;
                naive_attn_row<64, true>(PROJC + (size_t)m * PC_LD + 64 * h, PROJC + r0 * PC_LD + 1024 + 64 * (h >> 2), PC_LD, nullptr, 0,
                                         PROJC + r0 * PC_LD + 1280 + 64 * (h >> 2), PC_LD, HB + (size_t)m * DM + 64 * h, m & (SEQ - 1), tab + TB_BIAS + 512 * h, tab[TB_CONST + 16 + h], qf, lane); }
            (void)negcC;
#endif
        }
        SEAM(14);
        if (IN(15)) {
#if MK_GEMM
            pg8::Gemm g{HB, WT_OC, 1024, 1024, 1024}; pg8::StaticOrder S; S.init(NT, DM, 1024, 1024, G, bx); pg8::EpiResF32 E{XR, XR, DM};
            pg8::gemm_phase<pg8::EpiResF32, pg8::StaticOrder, true>(L, g, S, E);
#else
            naive_gemm<1>(HB, 1024, WT_OC, 1024, NT, DM, 1024, nullptr, XR, XR, DM, W);
#endif
        }
        SEAM(15);

    { constexpr int LAYER_ = 1;
    constexpr int layer = LAYER_; constexpr int pb = 9 * layer;
    unsigned* cnt = ctl + CW_CNT + 64 * layer;
    int* eidx = r_eidx + (size_t)layer * NT * 2; float* wts = r_wts + (size_t)layer * NT * 2; int* slot = r_slot + (size_t)layer * NT * 2;
    if (IN(7 + pb)) {
        LAS float* wr = (LAS float*)L;
        const float* wg = args.in[I_WGRP] + (size_t)layer * 1024 * 4; const float* wrt = args.in[I_WRTR] + (size_t)layer * 1024 * 16;
        for (int i = tid; i < 1024 * 4; i += 512) wr[(i & 3) * 1024 + (i >> 2)] = wg[i];
        for (int i = tid; i < 1024 * 16; i += 512) wr[(4 + (i & 15)) * 1024 + (i >> 4)] = wrt[i];
        __syncthreads();
        ph_router(XR, args.in[I_FFNN] + layer * DM, HB, wr, args.in[I_BGRP] + layer * 4, args.in[I_BRTR] + layer * 16, eidx, wts, slot, cnt, W);
    }
    SEAM(7 + pb);
    if (IN(8 + pb)) ph_scatter(HB, HS, eidx, slot, cnt, W);
    SEAM(8 + pb);
    if (IN(9 + pb)) {
#if MK_GEMM
        LAS unsigned char* tile_e = L + MISC_OFF + 1024;
        if (tid < 64) { int off[17]; const int ntile = moe_offsets(cnt, off);
            for (int t = lane; t < ntile; t += 64) { const int row = t * 256; int e = 0;
#pragma unroll
                for (int q = 1; q < 16; ++q) e = (row >= off[q]) ? q : e;
                tile_e[t] = (unsigned char)e; }
            if (lane == 0) MISC[4] = (unsigned)ntile; }
        __syncthreads();
        const int ntile = (int)MISC[4];
        pg8::Gemm g{HS, WT_GU + (size_t)layer * 16 * 1024 * 1024, 1024, 1024, 1024};
        pg8::MoeOrder S{tile_e, ntile, 4, G, vcu, 1024, 1024, (long)1024 * 1024}; pg8::EpiSwiGLU E{ACT, DEXP};
        pg8::gemm_phase<pg8::EpiSwiGLU, pg8::MoeOrder, true>(L, g, S, E);
#else
        naive_moe1(HS, WT_GU + (size_t)layer * 16 * 1024 * 1024, ACT, cnt, W);
#endif
    }
    SEAM(9 + pb);
    if (IN(10 + pb)) {
#if MK_GEMM
        LAS unsigned char* tile_e = L + MISC_OFF + 1024;
        if (tid < 64) { int off[17]; const int ntile = moe_offsets(cnt, off);
            for (int t = lane; t < ntile; t += 64) { const int row = t * 256; int e = 0;
#pragma unroll
                for (int q = 1; q < 16; ++q) e = (row >= off[q]) ? q : e;
                tile_e[t] = (unsigned char)e; }
            if (lane == 0) MISC[4] = (unsigned)ntile; }
        __syncthreads();
        const int ntile = (int)MISC[4];
        pg8::Gemm g{ACT, WT_D + (size_t)layer * 16 * 1024 * 512, DEXP, DEXP, DEXP};
        pg8::MoeOrder S{tile_e, ntile, 4, G, vcu, DEXP, DEXP, (long)1024 * 512}; pg8::EpiStoreBf16 E{HS, DM};
        pg8::gemm_phase<pg8::EpiStoreBf16, pg8::MoeOrder, true>(L, g, S, E);
#else
        naive_moe2(ACT, WT_D + (size_t)layer * 16 * 1024 * 512, HS, cnt, W);
#endif
    }
    SEAM(10 + pb);
    if (IN(11 + pb)) {
        if (layer == 0) ph_combine<true>(XR, HS, slot, wts, args.in[I_MIXN] + DM, HB, W);
        else ph_combine<false>(XR, HS, slot, wts, nullptr, nullptr, W);
    }
    if (layer == 0) SEAM(11);

    }
#undef IN
#undef SEAM
}

extern "C" void kernel_launch(void* const* d_in, const int* in_sizes, int n_in, void* d_out, int out_size, void* d_ws, size_t ws_size, hipStream_t stream) {
    static int grid = 0;
    if (grid == 0) {
        if (n_in != 28 || in_sizes[0] != NT * DM || out_size != NT * DM || ws_size < WS_END) {
            fprintf(stderr, "kernel_launch: shape mismatch: n_in %d in0 %d out %d ws %zu (need >= %zu); nothing launched\n", n_in, n_in > 0 ? in_sizes[0] : -1, out_size, ws_size, (size_t)WS_END); grid = -1; return; }
        int dev = 0, cus = 0, per_cu = 0;
        if (hipGetDevice(&dev) != hipSuccess || hipDeviceGetAttribute(&cus, hipDeviceAttributeMultiprocessorCount, dev) != hipSuccess) { fprintf(stderr, "kernel_launch: device query failed\n"); grid = -1; return; }
        if (hipFuncSetAttribute((const void*)mk_fwd, hipFuncAttributeMaxDynamicSharedMemorySize, LDS_BYTES) != hipSuccess) { fprintf(stderr, "kernel_launch: hipFuncSetAttribute failed\n"); grid = -1; return; }
        if (hipOccupancyMaxActiveBlocksPerMultiprocessor(&per_cu, (const void*)mk_fwd, 512, LDS_BYTES) != hipSuccess || per_cu < 1)
            fprintf(stderr, "kernel_launch: note: occupancy query reports %d workgroups per CU\n", per_cu);
        (void)hipGetLastError();
        grid = cus;
    }
    if (grid < 0) return;
    if (hipMemsetAsync((char*)d_ws + WS_CTL, 0, CTL_ZERO_BYTES, stream) != hipSuccess) { fprintf(stderr, "kernel_launch: memset failed\n"); return; }
    Args a{};
    for (int i = 0; i < 28; ++i) a.in[i] = (const float*)d_in[i];
    a.out = (float*)d_out; a.ws = (unsigned char*)d_ws;
#if MK_ONE_LAUNCH
    a.ph_lo = 0; a.ph_hi = NPHASE;
    hipLaunchKernelGGL(mk_fwd, dim3(grid), dim3(512), LDS_BYTES, stream, a);
#else
    for (int p = 0; p < NPHASE; ++p) { a.ph_lo = p; a.ph_hi = p + 1; hipLaunchKernelGGL(mk_fwd, dim3(grid), dim3(512), LDS_BYTES, stream, a); }
#endif
    const hipError_t le = hipPeekAtLastError();
    if (le != hipSuccess) fprintf(stderr, "kernel_launch: launch failed: %s\n", hipGetErrorName(le));
}
```

```cpp
#define MK_ONE_LAUNCH 1
#define MK_GEMM 1
#define MK_ATTN 1
#include <hip/hip_runtime.h>
#include <cstdio>
#include <cstdint>

#ifndef MK_ONE_LAUNCH
#define MK_ONE_LAUNCH 1
#endif
#ifndef MK_GEMM
#define MK_GEMM 1
#endif
#ifndef MK_ATTN
#define MK_ATTN 1
#endif

#define GAS __attribute__((address_space(1)))
#define LAS __attribute__((address_space(3)))
typedef unsigned short bf16;
typedef short bf16x8 __attribute__((ext_vector_type(8)));
typedef short s16x4 __attribute__((ext_vector_type(4)));
typedef float f32x2 __attribute__((ext_vector_type(2)));
typedef float f32x4 __attribute__((ext_vector_type(4)));
typedef float f32x16 __attribute__((ext_vector_type(16)));
typedef unsigned u32x2 __attribute__((ext_vector_type(2)));
typedef unsigned u32x4 __attribute__((ext_vector_type(4)));

constexpr int NBATCH = 8, SEQ = 4096, NT = NBATCH * SEQ, DM = 1024;
constexpr float EPS = 1e-6f;
constexpr float LOG2E = 1.4426950408889634f;
constexpr int PROJ_LD = 1280;
constexpr int UP_LD = 1792, UP_K = 384;
constexpr int PC_LD = 1536;
constexpr int PC_QLAT = 0, PC_KVLAT = 256, PC_BQ = 384, PC_BK = 896, PC_BV = 1024, PC_KROPE = 1152;
constexpr int NEXP = 16, DEXP = 512;
constexpr int MOE_ROWS = 2 * NT + NEXP * 256;

constexpr size_t MiB = 1u << 20;
constexpr size_t WS_CTL = 0, CTL_ZERO_BYTES = 64 * 1024;
constexpr size_t WS_TAB = 1 * MiB;
constexpr size_t WS_ROUTE = 2 * MiB;
constexpr size_t WS_WAB = 4 * MiB, WS_WUP = 7 * MiB, WS_WOAB = 9 * MiB, WS_WC = 11 * MiB, WS_WOC = 14 * MiB;
constexpr size_t WS_WGU = 16 * MiB;
constexpr size_t WS_WD = 80 * MiB;
constexpr size_t WS_H = 112 * MiB;
constexpr size_t WS_R = 176 * MiB;
constexpr size_t WS_PROJ = WS_R;
constexpr size_t WS_UPO = WS_R + 80 * MiB;
constexpr size_t WS_PROJC = WS_R;
constexpr size_t WS_Y = WS_R;
constexpr size_t WS_ACT = WS_R + 136 * MiB;
constexpr size_t WS_LIST = WS_R + 204 * MiB;
constexpr size_t WS_END = WS_R + 206 * MiB;
static_assert((size_t)MOE_ROWS * 1024 * 2 <= 136 * MiB && (size_t)MOE_ROWS * 512 * 2 <= 68 * MiB, "moe buffers");
constexpr int CW_CNT = 1024;
constexpr int CW_BAR = 4096;
constexpr int TB_BIAS = 0;
constexpr int TB_CONST = 8192;
constexpr int TB_CS = 32768;

constexpr int RING_BYTES = 131072;
constexpr int MISC_OFF = RING_BYTES;
constexpr int LDS_BYTES = 147456;

__device__ __forceinline__ float bf2f(unsigned b) { return __uint_as_float(b << 16); }
__device__ __forceinline__ unsigned f2bf(float f) { unsigned u = __float_as_uint(f); return (u + 0x7fffu + ((u >> 16) & 1u)) >> 16; }
__device__ __forceinline__ unsigned pk2(float lo, float hi) { unsigned r; asm volatile("v_cvt_pk_bf16_f32 %0, %1, %2" : "=v"(r) : "v"(lo), "v"(hi)); return r; }
__device__ __forceinline__ float wave_sum(float v) {
#pragma unroll
    for (int o = 1; o < 64; o <<= 1) v += __shfl_xor(v, o);
    return v;
}
__device__ __forceinline__ float wave_max(float v) {
#pragma unroll
    for (int o = 1; o < 64; o <<= 1) v = fmaxf(v, __shfl_xor(v, o));
    return v;
}
#define LDS_WAIT() asm volatile("s_waitcnt lgkmcnt(0)" ::: "memory")

#define XB_TMO      128
#define XB_XCNT(j)  (256  + 64 * (j))
#define XB_XSUB(j)  (1280 + 64 * (j))
#define XB_XGEN(j)  (2304 + 64 * (j))
#define XB_TOP      3328
#define XB_TOPGEN   3392
#define XCD_BAR_WORDS 3456
#define XB_SPIN_CAP (1u << 18)
__device__ __forceinline__ unsigned xb_ld(unsigned* p)              { return __hip_atomic_load(p, __ATOMIC_RELAXED, __HIP_MEMORY_SCOPE_AGENT); }
__device__ __forceinline__ unsigned xb_add(unsigned* p, unsigned v) { return __hip_atomic_fetch_add(p, v, __ATOMIC_RELAXED, __HIP_MEMORY_SCOPE_AGENT); }
__device__ __forceinline__ unsigned xb_xcc_id() { return (unsigned)__builtin_amdgcn_s_getreg((3 << 11) | 20) & 0xFu; }
#define XB_SPIN(cond, bar) do { unsigned _sp = 0; while (cond) { __builtin_amdgcn_s_sleep(1); \
    if ((++_sp & 255u) == 0u) { if (xb_ld(&(bar)[XB_TMO])) break; if (_sp > XB_SPIN_CAP) { atomicAdd(&(bar)[XB_TMO], 1u); break; } } } } while (0)
struct XcdBarrier { unsigned* bar; unsigned x; volatile LAS unsigned* st; };
__device__ __forceinline__ XcdBarrier xcd_barrier_post(unsigned* bar, volatile LAS unsigned* st) {
    XcdBarrier b; b.bar = bar; b.x = xb_xcc_id(); b.st = st;
    if (threadIdx.x == 0) (void)xb_add(&bar[XB_XCNT(b.x)], 1u);
    return b;
}
__device__ __forceinline__ void xcd_barrier_complete(unsigned* bar, unsigned x, unsigned& nloc, unsigned& nx) {
    const unsigned G = gridDim.x * gridDim.y * gridDim.z;
    unsigned sum, cnt, mine, sp = 0u;
    for (;;) {
        sum = 0u; cnt = 0u; mine = 0u;
#pragma unroll
        for (unsigned j = 0; j < 16; ++j) { const unsigned c = xb_ld(&bar[XB_XCNT(j)]); sum += c; cnt += (c > 0u) ? 1u : 0u; mine = (j == x) ? c : mine; }
        if (sum == G) break;
        __builtin_amdgcn_s_sleep(1);
        if ((++sp & 255u) == 0u) { if (xb_ld(&bar[XB_TMO])) break; if (sp > XB_SPIN_CAP) { atomicAdd(&bar[XB_TMO], 1u); break; } }
    }
    nloc = mine > 0u ? mine : 1u; nx = cnt > 0u ? cnt : 1u;
}
__device__ __forceinline__ void xcd_barrier(const XcdBarrier& b) {
    asm volatile("s_waitcnt vmcnt(0)" ::: "memory");
    __syncthreads();
    if (threadIdx.x == 0) {
        unsigned* bar = b.bar;
        __builtin_amdgcn_s_waitcnt(0);
        unsigned nloc = b.st[0], nx = b.st[1];
        if (nloc == 0u) { xcd_barrier_complete(bar, b.x, nloc, nx); b.st[0] = nloc; b.st[1] = nx; }
        const unsigned old = xb_add(&bar[XB_XSUB(b.x)], 1u);
        const unsigned gen = old / nloc;
        if (old + 1u == (gen + 1u) * nloc) {
            __builtin_amdgcn_fence(__ATOMIC_RELEASE, "agent");
            asm volatile("s_waitcnt vmcnt(0)" ::: "memory");
            const unsigned og = xb_add(&bar[XB_TOP], 1u);
            const unsigned tg = og / nx;
            if (og + 1u == (tg + 1u) * nx) xb_add(&bar[XB_TOPGEN], 1u);
            else XB_SPIN(xb_ld(&bar[XB_TOPGEN]) == tg, bar);
            __builtin_amdgcn_fence(__ATOMIC_ACQUIRE, "agent");
            xb_add(&bar[XB_XGEN(b.x)], 1u);
            asm volatile("s_waitcnt vmcnt(0)" ::: "memory");
        } else {
            XB_SPIN(xb_ld(&bar[XB_XGEN(b.x)]) == gen, bar);
            __builtin_amdgcn_fence(__ATOMIC_ACQUIRE, "agent");
            asm volatile("s_waitcnt vmcnt(0)" ::: "memory");
        }
    }
    __syncthreads();
}
namespace pg8 {
#define PG8_LAS __attribute__((address_space(3)))
typedef unsigned short bf16_t;
constexpr int BM = 256, BK = 64, HALF = 128, HTB = HALF * BK * 2, STAGE_BYTES = 8 * HTB, NXCD = 8, WGM = 8;

__host__ __device__ __forceinline__ int lds_byte(int r, int c) { const int st = (r >> 4) * 2 + (c >> 5), rr = r & 15, cc = c & 31, ob = rr * 64 + cc * 2; return st * 1024 + (ob ^ (((ob >> 9) & 1) << 5)); }
__host__ __device__ __forceinline__ void stage_rc(int b, int& R, int& C) { const int st = b / 1024, sb = b % 1024, swz = sb ^ (((sb >> 9) & 1) << 5); R = (st >> 1) * 16 + swz / 64; C = (st & 1) * 32 + (swz % 64) / 2; }
__host__ __device__ __forceinline__ int perm32(int rho) { const int n = rho >> 4, i = rho & 15; return 8 * (i >> 2) + 4 * n + (i & 3); }

struct Unit { int pm, pn; long aoff, boff; };
struct Gemm { const bf16_t* A; const bf16_t* Bt; int lda, ldb, K; };

struct StaticOrder {
    int nM, nN, nwg, G, c, lda, ldb;
    __device__ void init(int M, int N, int lda_, int ldb_, int G_, int c_) { nM = M / BM; nN = N / BM; nwg = nM * nN; G = G_; c = c_; lda = lda_; ldb = ldb_; }
    __device__ bool next(int i, Unit& u) const {
        const long L = (long)i * G + c; if (L >= nwg) return false;
        int wgid = (int)L; { const int q = nwg / NXCD, r = nwg % NXCD, xcd = wgid % NXCD, off = wgid / NXCD; wgid = (xcd < r ? xcd * (q + 1) : r * (q + 1) + (xcd - r) * q) + off; }
        const int nig = WGM * nN, gid = wgid / nig, fm = gid * WGM, gsz = (nM - fm) < WGM ? (nM - fm) : WGM;
        u.pm = fm + ((wgid % nig) % gsz); u.pn = (wgid % nig) / gsz;
        u.aoff = (long)u.pm * BM * lda; u.boff = (long)u.pn * BM * ldb; return true;
    }
};
struct MoeOrder {
    const PG8_LAS unsigned char* tile_e; int ntile, nN, G, vc, lda, ldb; long estride;
    __device__ bool next(int i, Unit& u) const {
        const long L = (long)i * G + vc; if (L >= (long)ntile * nN) return false;
        u.pm = (int)(L / nN); u.pn = (int)(L % nN);
        const int e = tile_e[u.pm];
        u.aoff = (long)u.pm * BM * lda; u.boff = (long)e * estride + (long)u.pn * BM * ldb; return true;
    }
};

struct EpiStoreBf16 {
    static constexpr bool PERM = true;
    bf16_t* O; int ldc;
    __device__ __forceinline__ void operator()(const f32x4 (&acc)[2][2][4][2], const Unit& u, int wr, int wc, int fr, int fq) const {
        const int row0 = u.pm * BM + wr * 64 + fr; const int col0 = u.pn * BM + wc * 32 + 8 * fq;
#pragma unroll
        for (int ai = 0; ai < 2; ++ai)
#pragma unroll
            for (int m = 0; m < 4; ++m) { bf16_t* rowp = O + (size_t)(row0 + ai * HALF + m * 16) * ldc + col0;
#pragma unroll
                for (int bj = 0; bj < 2; ++bj) { const f32x4 v0 = acc[ai][bj][m][0], v1 = acc[ai][bj][m][1];
                    u32x4 w; w.x = pk2(v0[0], v0[1]); w.y = pk2(v0[2], v0[3]); w.z = pk2(v1[0], v1[1]); w.w = pk2(v1[2], v1[3]);
                    *(u32x4*)(rowp + bj * HALF) = w; } }
    }
};
struct EpiResF32 {
    static constexpr bool PERM = false;
    const float* base; float* out; int ldc;
    __device__ __forceinline__ void operator()(const f32x4 (&acc)[2][2][4][2], const Unit& u, int wr, int wc, int fr, int fq) const {
        const int row0 = u.pm * BM + wr * 64 + fr; const int col0 = u.pn * BM + wc * 32 + 4 * fq;
#pragma unroll
        for (int ai = 0; ai < 2; ++ai)
#pragma unroll
            for (int m = 0; m < 4; ++m) { const size_t off = (size_t)(row0 + ai * HALF + m * 16) * ldc + col0;
#pragma unroll
                for (int bj = 0; bj < 2; ++bj)
#pragma unroll
                    for (int n = 0; n < 2; ++n) { const f32x4 b = *(const f32x4*)(base + off + bj * HALF + n * 16); *(f32x4*)(out + off + bj * HALF + n * 16) = b + acc[ai][bj][m][n]; } }
    }
};
struct EpiSwiGLU {
    static constexpr bool PERM = true;
    bf16_t* O; int ldc;
    __device__ __forceinline__ void operator()(const f32x4 (&acc)[2][2][4][2], const Unit& u, int wr, int wc, int fr, int fq) const {
        const int row0 = u.pm * BM + wr * 64 + fr; const int col0 = u.pn * HALF + wc * 32 + 8 * fq;
#pragma unroll
        for (int ai = 0; ai < 2; ++ai)
#pragma unroll
            for (int m = 0; m < 4; ++m) { bf16_t* rowp = O + (size_t)(row0 + ai * HALF + m * 16) * ldc + col0;
                float a[8];
#pragma unroll
                for (int n = 0; n < 2; ++n)
#pragma unroll
                    for (int i = 0; i < 4; ++i) { const float g = acc[ai][0][m][n][i], up = acc[ai][1][m][n][i];
                        const float s = g * __builtin_amdgcn_rcpf(1.0f + __builtin_amdgcn_exp2f(-g * 1.4426950408889634f)); a[n * 4 + i] = s * up; }
                u32x4 w; w.x = pk2(a[0], a[1]); w.y = pk2(a[2], a[3]); w.z = pk2(a[4], a[5]); w.w = pk2(a[6], a[7]);
                *(u32x4*)rowp = w; }
    }
};

template <class Epi, class Sched, bool ALIGN_EPI, bool GATHER = false>
__device__ __forceinline__ void gemm_phase(PG8_LAS unsigned char* lds, const Gemm g, const Sched& S, const Epi& E, const PG8_LAS int* rowtok = nullptr) {
    const int tid = threadIdx.x, wid = __builtin_amdgcn_readfirstlane(tid >> 6), lane = tid & 63, wr = wid >> 2, wc = wid & 3, fr = lane & 15, fq = lane >> 4;
    const int K = g.K, nt = K / BK;
    unsigned voffA[2], voffB[2]; int RA[2], CA[2];
#pragma unroll
    for (int i = 0; i < 2; ++i) { int R, C; stage_rc(tid * 16 + i * 8192, R, C); const int Rb = Epi::PERM ? ((R & ~31) + perm32(R & 31)) : R;
        voffA[i] = (unsigned)(R * g.lda + C) * 2u; voffB[i] = (unsigned)(Rb * g.ldb + C) * 2u; RA[i] = R; CA[i] = C; }
    unsigned gcur[2][2], gnxt[2][2];
#define PG8_GOFF(dst, u_) do { _Pragma("unroll") for (int h_ = 0; h_ < 2; ++h_) _Pragma("unroll") for (int i_ = 0; i_ < 2; ++i_) \
        dst[h_][i_] = (unsigned)(rowtok[(u_) * 256 + h_ * HALF + RA[i_]] * g.lda + CA[i_]) * 2u; } while (0)
    const char* baseA = (const char*)g.A;

    const size_t kstep = (size_t)(BK * 2);
    const size_t hstepA = (size_t)HALF * g.lda * 2, hstepB = (size_t)HALF * g.ldb * 2;
    const unsigned ldsw = (unsigned)wid * 1024u;
    const int aoff = lds_byte(wr * 64 + fr, fq * 8), boff = lds_byte(wc * 32 + fr, fq * 8);
#define PG8_SA(b, h) (((b) * 2 + (h)) * HTB)
#define PG8_SB(b, h) ((4 + (b) * 2 + (h)) * HTB)
#define PG8_STAGE(bufoff, gbase, voff) do { _Pragma("unroll") for (int _i = 0; _i < 2; ++_i) \
        __builtin_amdgcn_global_load_lds((const unsigned*)((const char*)(gbase) + (voff)[_i]), (PG8_LAS unsigned*)(lds + (bufoff) + ldsw + _i * 8192), 16, 0, 0); } while (0)
#define PG8_LDA(dst, b, h) do { _Pragma("unroll") for (int m = 0; m < 4; ++m) _Pragma("unroll") for (int k = 0; k < 2; ++k) dst[m][k] = *(const PG8_LAS bf16x8*)(lds + PG8_SA(b, h) + aoff + m * 2048 + k * 1024); } while (0)
#define PG8_LDB(dst, b, h) do { _Pragma("unroll") for (int n = 0; n < 2; ++n) _Pragma("unroll") for (int k = 0; k < 2; ++k) dst[n][k] = *(const PG8_LAS bf16x8*)(lds + PG8_SB(b, h) + boff + n * 2048 + k * 1024); } while (0)
#define PG8_MMA(ai, bj, At, Bt) do { __builtin_amdgcn_s_setprio(1); _Pragma("unroll") for (int m = 0; m < 4; ++m) _Pragma("unroll") for (int n = 0; n < 2; ++n) _Pragma("unroll") for (int k = 0; k < 2; ++k) \
        acc[ai][bj][m][n] = __builtin_amdgcn_mfma_f32_16x16x32_bf16(Bt[n][k], At[m][k], acc[ai][bj][m][n], 0, 0, 0); __builtin_amdgcn_s_setprio(0); } while (0)
#define PG8_WAIT_V(n) asm volatile("s_waitcnt vmcnt(" #n ")" ::: "memory")
#define PG8_WAIT_L(n) asm volatile("s_waitcnt lgkmcnt(" #n ")" ::: "memory")
#define PG8_BAR __builtin_amdgcn_s_barrier()
#define PG8_SCHED __builtin_amdgcn_sched_barrier(0)
    Unit cur, nxt; int ui = 0;
    if (!S.next(0, cur)) return;
    f32x4 acc[2][2][4][2];
#pragma unroll
    for (int a = 0; a < 2; ++a)
#pragma unroll
        for (int b = 0; b < 2; ++b)
#pragma unroll
            for (int m = 0; m < 4; ++m)
#pragma unroll
                for (int n = 0; n < 2; ++n) acc[a][b][m][n] = (f32x4){0.f, 0.f, 0.f, 0.f};
    bf16x8 At[4][2], B0[2][2], B1[2][2];
    const char* cA = (const char*)g.A + (size_t)cur.aoff * 2; const char* cB = (const char*)g.Bt + (size_t)cur.boff * 2;
    if constexpr (GATHER) { PG8_GOFF(gcur, 0); }
    PG8_STAGE(PG8_SB(0, 0), cB, voffB); PG8_STAGE(PG8_SB(0, 1), cB + hstepB, voffB);
    if constexpr (GATHER) { PG8_STAGE(PG8_SA(0, 0), baseA, gcur[0]); PG8_STAGE(PG8_SA(0, 1), baseA, gcur[1]); } else { PG8_STAGE(PG8_SA(0, 0), cA, voffA); PG8_STAGE(PG8_SA(0, 1), cA + hstepA, voffA); }
    if (wr == 1) PG8_BAR;
    PG8_WAIT_V(2); PG8_BAR;
    PG8_STAGE(PG8_SB(1, 0), cB + kstep, voffB);
    if constexpr (GATHER) { PG8_STAGE(PG8_SA(1, 0), baseA + kstep, gcur[0]); } else { PG8_STAGE(PG8_SA(1, 0), cA + kstep, voffA); }
    PG8_STAGE(PG8_SB(1, 1), cB + hstepB + kstep, voffB);
    PG8_WAIT_V(6); PG8_BAR;
    for (;;) {
        const bool has_next = S.next(ui + 1, nxt);
        const char* nA = has_next ? (const char*)g.A + (size_t)nxt.aoff * 2 : cA; const char* nB = has_next ? (const char*)g.Bt + (size_t)nxt.boff * 2 : cB;
        if constexpr (GATHER) { if (has_next) { PG8_GOFF(gnxt, ui + 1); } else { _Pragma("unroll") for (int h_ = 0; h_ < 2; ++h_) _Pragma("unroll") for (int i_ = 0; i_ < 2; ++i_) gnxt[h_][i_] = gcur[h_][i_]; } }
        for (int t = 0; t < nt; t += 2) {
            const bool last = (t == nt - 2);
            const char* a1 = cA + (size_t)(t + 1) * kstep;
            const char* a2 = last ? nA : cA + (size_t)(t + 2) * kstep; const char* b2 = last ? nB : cB + (size_t)(t + 2) * kstep;
            const char* a3 = a2 + kstep; const char* b3 = b2 + kstep;
            unsigned gs[2][2]; size_t k2o = 0;
            if constexpr (GATHER) { _Pragma("unroll") for (int h_ = 0; h_ < 2; ++h_) _Pragma("unroll") for (int i_ = 0; i_ < 2; ++i_) gs[h_][i_] = last ? gnxt[h_][i_] : gcur[h_][i_]; k2o = last ? 0 : (size_t)(t + 2) * kstep; }
            PG8_LDB(B0, 0, 0); PG8_LDB(B1, 0, 1); PG8_SCHED; PG8_LDA(At, 0, 0); if constexpr (GATHER) { PG8_STAGE(PG8_SA(1, 1), baseA + (size_t)(t + 1) * kstep, gcur[1]); } else { PG8_STAGE(PG8_SA(1, 1), a1 + hstepA, voffA); }
            PG8_WAIT_V(8); PG8_WAIT_L(0); PG8_BAR; PG8_MMA(0, 0, At, B0); PG8_MMA(0, 1, At, B1); PG8_BAR; PG8_SCHED;
            PG8_LDA(At, 0, 1); PG8_STAGE(PG8_SB(0, 0), b2, voffB); PG8_STAGE(PG8_SB(0, 1), b2 + hstepB, voffB); if constexpr (GATHER) { PG8_STAGE(PG8_SA(0, 0), baseA + k2o, gs[0]); } else { PG8_STAGE(PG8_SA(0, 0), a2, voffA); }
            PG8_WAIT_V(8); PG8_WAIT_L(0); PG8_BAR; PG8_MMA(1, 0, At, B0); PG8_MMA(1, 1, At, B1); PG8_BAR; PG8_SCHED;
            PG8_LDB(B0, 1, 0); PG8_LDB(B1, 1, 1); PG8_SCHED; PG8_LDA(At, 1, 0); if constexpr (GATHER) { PG8_STAGE(PG8_SA(0, 1), baseA + k2o, gs[1]); } else { PG8_STAGE(PG8_SA(0, 1), a2 + hstepA, voffA); }
            PG8_WAIT_V(8); PG8_WAIT_L(0); PG8_BAR; PG8_MMA(0, 0, At, B0); PG8_MMA(0, 1, At, B1); PG8_BAR; PG8_SCHED;
            PG8_LDA(At, 1, 1); PG8_STAGE(PG8_SB(1, 0), b3, voffB); PG8_STAGE(PG8_SB(1, 1), b3 + hstepB, voffB); if constexpr (GATHER) { PG8_STAGE(PG8_SA(1, 0), baseA + k2o + kstep, gs[0]); } else { PG8_STAGE(PG8_SA(1, 0), a3, voffA); }
            PG8_WAIT_V(8); PG8_WAIT_L(0); PG8_BAR; PG8_MMA(1, 0, At, B0); PG8_MMA(1, 1, At, B1); PG8_BAR; PG8_SCHED;
        }
        if constexpr (ALIGN_EPI) { if (wr == 0) PG8_BAR; }
        E(acc, cur, wr, wc, fr, fq);
        if (!has_next) break;
#pragma unroll
        for (int a = 0; a < 2; ++a)
#pragma unroll
            for (int b = 0; b < 2; ++b)
#pragma unroll
                for (int m = 0; m < 4; ++m)
#pragma unroll
                    for (int n = 0; n < 2; ++n) acc[a][b][m][n] = (f32x4){0.f, 0.f, 0.f, 0.f};
        cur = nxt; cA = nA; cB = nB; ++ui;
        if constexpr (GATHER) { _Pragma("unroll") for (int h_ = 0; h_ < 2; ++h_) _Pragma("unroll") for (int i_ = 0; i_ < 2; ++i_) gcur[h_][i_] = gnxt[h_][i_]; }
        if constexpr (ALIGN_EPI) { if (wr == 1) PG8_BAR; }
    }
    PG8_WAIT_V(0);
    if constexpr (!ALIGN_EPI) { if (wr == 0) PG8_BAR; }
    PG8_BAR;
#undef PG8_GOFF
#undef PG8_SA
#undef PG8_SB
#undef PG8_STAGE
#undef PG8_LDA
#undef PG8_LDB
#undef PG8_MMA
#undef PG8_WAIT_V
#undef PG8_WAIT_L
#undef PG8_BAR
#undef PG8_SCHED
}
}
namespace att {
constexpr int KVB = 64;
template <int DQK> struct Lay { static constexpr int NQ = DQK / 16, KP = DQK * 2 + 16, KBYTES = 64 * KP; };
constexpr int VBYTES = 64 * 64 * 2;
constexpr int L_K = 0;
constexpr int L_V = 28672;
constexpr int L_WS = L_V + 2 * VBYTES;
constexpr int L_OST = L_WS + 8 * 64 * 4;
constexpr int L_BT = L_OST + 8 * 4096;
constexpr int L_END = L_BT + 2048;
static_assert(2 * Lay<96>::KBYTES <= L_V && L_END <= RING_BYTES, "attention LDS map");

__device__ __forceinline__ int crow(int r, int hi) { return (r & 3) + 8 * (r >> 2) + 4 * hi; }
__device__ __forceinline__ int v_st(int k, int c) { const int kk = (k & ~0xC) | ((k & 4) << 1) | ((k & 8) >> 1); return ((kk >> 3) * 2 + (c >> 5)) * 512 + ((kk & 7) * 32 + (c & 31)) * 2; }
__device__ __forceinline__ int v_rd_base(int lane) { return ((lane & 3) << 3) | (((lane >> 2) & 3) << 6) | (((lane >> 4) & 1) << 5) | (((lane >> 5) & 1) << 8); }
constexpr int v_rd_off(int d0, int ks, int half) { return d0 * 512 + ks * 2048 + half * 1024; }
template <int OFF> __device__ __forceinline__ s16x4 tr_read(int vb) {
    s16x4 r; asm volatile("ds_read_b64_tr_b16 %0, %1 offset:%2" : "=&v"(r) : "v"(vb), "i"(OFF) : "memory"); return r;
}
template <int D0> __device__ __forceinline__ void pv_one(f32x16& od, int vb, bf16x8 pa0, bf16x8 pa1, bf16x8 pa2, bf16x8 pa3) {
    const s16x4 l0 = tr_read<v_rd_off(D0, 0, 0)>(vb), h0 = tr_read<v_rd_off(D0, 0, 1)>(vb), l1 = tr_read<v_rd_off(D0, 1, 0)>(vb), h1 = tr_read<v_rd_off(D0, 1, 1)>(vb);
    const s16x4 l2 = tr_read<v_rd_off(D0, 2, 0)>(vb), h2 = tr_read<v_rd_off(D0, 2, 1)>(vb), l3 = tr_read<v_rd_off(D0, 3, 0)>(vb), h3 = tr_read<v_rd_off(D0, 3, 1)>(vb);
    asm volatile("s_waitcnt lgkmcnt(0)" ::: "memory"); __builtin_amdgcn_sched_barrier(0);
#define ATT_PK(L, H) (bf16x8){L[0], L[1], L[2], L[3], H[0], H[1], H[2], H[3]}
    od = __builtin_amdgcn_mfma_f32_32x32x16_bf16(pa0, ATT_PK(l0, h0), od, 0, 0, 0);
    od = __builtin_amdgcn_mfma_f32_32x32x16_bf16(pa1, ATT_PK(l1, h1), od, 0, 0, 0);
    od = __builtin_amdgcn_mfma_f32_32x32x16_bf16(pa2, ATT_PK(l2, h2), od, 0, 0, 0);
    od = __builtin_amdgcn_mfma_f32_32x32x16_bf16(pa3, ATT_PK(l3, h3), od, 0, 0, 0);
#undef ATT_PK
}

template <int DQK, bool WIN>
__device__ __forceinline__ void attn_unit(const bf16* Qp, int ldq, const bf16* Kn, int ldk, const bf16* Kr, int ldkr, const bf16* Vp, int ldv, bf16* Op, int ldo,
                                          int kt0, int kt1, float negc, int q0, const float* btab, float sinkl2, char* shm) {
    constexpr int NQ = Lay<DQK>::NQ, KP = Lay<DQK>::KP, KBYTES = Lay<DQK>::KBYTES;
    const int tid = threadIdx.x, lane = tid & 63, r32 = lane & 31, hi = lane >> 5; const int wid = __builtin_amdgcn_readfirstlane(tid >> 6);
    char* K_lds = shm + L_K; char* V_lds = shm + L_V;
    float* wsf = (float*)(shm + L_WS) + wid * 64;
    const float* bt = (const float*)(shm + L_BT);
    if constexpr (WIN) { ((float*)(shm + L_BT))[tid] = btab[tid]; }
    bf16x8 qr[NQ];
    { const bf16* Qw = Qp + (size_t)(wid * 32 + r32) * ldq + hi * 8;
#pragma unroll
      for (int d0 = 0; d0 < NQ; ++d0) qr[d0] = *reinterpret_cast<const bf16x8*>(Qw + d0 * 16); }
    const int srow = tid >> 3, sc = tid & 7;
    const bf16* kn_src = Kn + (size_t)srow * ldk + sc * 8;
    const bf16* v_src = Vp + (size_t)srow * ldv + sc * 8;
    const bf16* kr_src = (DQK == 96) ? (Kr + (size_t)(tid >> 2) * ldkr + (tid & 3) * 8) : nullptr;
    const int kn_dst = srow * KP + sc * 16, kr_dst = (tid >> 2) * KP + 128 + (tid & 3) * 16, v_dst = v_st(srow, sc * 8);
    const int vb0 = (int)(uintptr_t)V_lds + v_rd_base(lane);
    bf16x8 s_kn, s_kr, s_v;
#define ATT_LOAD(t) do { const size_t k0_ = (size_t)(t) * KVB; s_kn = *reinterpret_cast<const bf16x8*>(kn_src + k0_ * ldk); s_v = *reinterpret_cast<const bf16x8*>(v_src + k0_ * ldv); \
        if (DQK == 96) { if (tid < 256) s_kr = *reinterpret_cast<const bf16x8*>(kr_src + k0_ * ldkr); } } while (0)
#define ATT_WRITE(b) do { *reinterpret_cast<bf16x8*>(K_lds + (b) * KBYTES + kn_dst) = s_kn; *reinterpret_cast<bf16x8*>(V_lds + (b) * VBYTES + v_dst) = s_v; \
        if (DQK == 96) { if (tid < 256) *reinterpret_cast<bf16x8*>(K_lds + (b) * KBYTES + kr_dst) = s_kr; } } while (0)
    f32x16 o[2]; o[0] = f32x16{}; o[1] = f32x16{};
    float lsum = 0.f;
    f32x16 cinit;
#pragma unroll
    for (int r = 0; r < 16; ++r) cinit[r] = negc;
    const int qw = q0 + wid * 32;
    ATT_LOAD(kt0); ATT_WRITE(0); __syncthreads();
    for (int t = kt0; t < kt1; ++t) {
        const int cur = (t - kt0) & 1;
        if (t + 1 < kt1) ATT_LOAD(t + 1);
        bool active = true;
        if constexpr (WIN) { const int k0 = t * KVB; active = (k0 + 63 >= qw - 128) && (k0 <= qw + 159); }
        if (active) {
            f32x16 p0 = cinit, p1 = cinit;
            { const char* kb = K_lds + cur * KBYTES + r32 * KP + hi * 16;
#pragma unroll
              for (int d0 = 0; d0 < NQ; ++d0) {
                  const bf16x8 b0 = *reinterpret_cast<const bf16x8*>(kb + d0 * 32);
                  const bf16x8 b1 = *reinterpret_cast<const bf16x8*>(kb + 32 * KP + d0 * 32);
                  p0 = __builtin_amdgcn_mfma_f32_32x32x16_bf16(b0, qr[d0], p0, 0, 0, 0);
                  p1 = __builtin_amdgcn_mfma_f32_32x32x16_bf16(b1, qr[d0], p1, 0, 0, 0); } }
            if constexpr (WIN) {
                const int base = t * KVB - (qw + r32) + 256 + 4 * hi;
#pragma unroll
                for (int r = 0; r < 16; ++r) { const int ix = base + (r & 3) + 8 * (r >> 2); p0[r] += bt[ix]; p1[r] += bt[ix + 32]; }
            }
#pragma unroll
            for (int r = 0; r < 16; ++r) { p0[r] = __builtin_amdgcn_exp2f(p0[r]); p1[r] = __builtin_amdgcn_exp2f(p1[r]); }
            { float ps = 0.f;
#pragma unroll
              for (int r = 0; r < 16; ++r) ps += p0[r] + p1[r];
              lsum += ps; }
            bf16x8 pa0, pa1, pa2, pa3;
#define ATT_PK4(P, BASE, OUT) do { unsigned a0 = pk2(P[BASE + 0], P[BASE + 1]), a1 = pk2(P[BASE + 2], P[BASE + 3]);   \
        unsigned b0_ = pk2(P[BASE + 4], P[BASE + 5]), b1_ = pk2(P[BASE + 6], P[BASE + 7]);                              \
        auto r0 = __builtin_amdgcn_permlane32_swap(a0, b0_, false, false); auto r1 = __builtin_amdgcn_permlane32_swap(a1, b1_, false, false); \
        u32x4 w = {r0[0], r1[0], r0[1], r1[1]}; OUT = *reinterpret_cast<bf16x8*>(&w); } while (0)
            ATT_PK4(p0, 0, pa0); ATT_PK4(p0, 8, pa1); ATT_PK4(p1, 0, pa2); ATT_PK4(p1, 8, pa3);
#undef ATT_PK4
            __builtin_amdgcn_sched_barrier(0);
            pv_one<0>(o[0], vb0 + cur * VBYTES, pa0, pa1, pa2, pa3);
            pv_one<1>(o[1], vb0 + cur * VBYTES, pa0, pa1, pa2, pa3);
        }
        if (t + 1 < kt1) ATT_WRITE(cur ^ 1);
        __syncthreads();
    }
#undef ATT_LOAD
#undef ATT_WRITE
    { auto rr = __builtin_amdgcn_permlane32_swap(__float_as_uint(lsum), __float_as_uint(lsum), false, false); lsum = __uint_as_float(rr[0]) + __uint_as_float(rr[1]); }
    if constexpr (WIN) lsum += __builtin_amdgcn_exp2f(sinkl2 + negc);
    if (hi == 0) wsf[r32] = lsum;
    LDS_WAIT();
    float rli[16];
#pragma unroll
    for (int r = 0; r < 16; ++r) rli[r] = __builtin_amdgcn_rcpf(wsf[crow(r, hi)]);
    { bf16* stg = (bf16*)(shm + L_OST) + wid * 2048;
#pragma unroll
      for (int r = 0; r < 16; ++r) { const int orow = crow(r, hi);
#pragma unroll
          for (int d0 = 0; d0 < 2; ++d0) stg[orow * 64 + d0 * 32 + r32] = (bf16)f2bf(o[d0][r] * rli[r]); }
      LDS_WAIT();
      bf16* Ow = Op + (size_t)(wid * 32) * ldo;
#pragma unroll
      for (int i = 0; i < 4; ++i) { const int row = i * 8 + (lane >> 3), ch = lane & 7; const u32x4 v = *(const u32x4*)(stg + row * 64 + ch * 8); *(u32x4*)(Ow + (size_t)row * ldo + ch * 8) = v; } }
    __syncthreads();
}
}
struct WaveId { int gw, ngw, lane, wave; };

__device__ __forceinline__ void tr_item(const float* W, int ldw, int k0, int n0, bf16* WT, int ldt, int drow0, int dk0, LAS float* scr, int lane) {
#pragma unroll 8
    for (int i = 0; i < 32; ++i) { const int kk = 2 * i + (lane >> 5); scr[kk * 33 + (lane & 31)] = W[(size_t)(k0 + kk) * ldw + n0 + (lane & 31)]; }
    LDS_WAIT(); asm volatile("" ::: "memory");
    const int c = lane & 7;
#pragma unroll
    for (int j = 0; j < 4; ++j) { const int n = (lane >> 3) + 8 * j; const LAS float* s = scr + (8 * c) * 33 + n;
        u32x4 o; o.x = pk2(s[0 * 33], s[1 * 33]); o.y = pk2(s[2 * 33], s[3 * 33]); o.z = pk2(s[4 * 33], s[5 * 33]); o.w = pk2(s[6 * 33], s[7 * 33]);
        *(u32x4*)(WT + (size_t)(drow0 + n) * ldt + dk0 + k0 + 8 * c) = o; }
    LDS_WAIT(); asm volatile("" ::: "memory");
}
template <int MAP>
__device__ __forceinline__ void tr_seg(int it, const float* W, int ldw, int N, bf16* WT, int ldt, int roff, int dk0, LAS float* scr, int lane) {
    const int nblk = N / 32, kb = it / nblk, nb = it % nblk, n0 = 32 * nb;
    int drow0;
    if (MAP == 0) drow0 = roff + n0;
    else if (MAP == 1) {
        if (n0 < 384) drow0 = n0;
        else if (n0 < 416) drow0 = PC_KROPE + (n0 - 384);
        else drow0 = n0 - 416 + PC_BQ;
    } else { drow0 = (n0 >> 7) * 256 + (n0 & 127) + (MAP == 3 ? 128 : 0); }
    tr_item(W, ldw, 64 * kb, n0, WT, ldt, drow0, dk0, scr, lane);
}
__device__ __forceinline__ int ilog2u(unsigned v) { return 31 - __builtin_clz(v); }
__device__ __forceinline__ int t5_bucket_dev(int rel) {
    const int n = rel < 0 ? -rel : rel; int b = rel > 0 ? 16 : 0;
    if (n < 8) return b + n;
    int large = 2 + ilog2u((unsigned)(n * n)); if (large > 15) large = 15;
    return b + large;
}
__device__ __forceinline__ float gain_absmax(const float* g, int n, int lane) { float m = 0.f; for (int i = lane; i < n; i += 64) m = fmaxf(m, fabsf(g[i])); return wave_max(m); }


__device__ __forceinline__ void unpack8(const u32x4 v, float (&x)[8]) {
    x[0] = bf2f(v.x & 0xffffu); x[1] = bf2f(v.x >> 16); x[2] = bf2f(v.y & 0xffffu); x[3] = bf2f(v.y >> 16);
    x[4] = bf2f(v.z & 0xffffu); x[5] = bf2f(v.z >> 16); x[6] = bf2f(v.w & 0xffffu); x[7] = bf2f(v.w >> 16);
}
__device__ __forceinline__ u32x4 pack8(const float (&v)[8]) { u32x4 w; w.x = pk2(v[0], v[1]); w.y = pk2(v[2], v[3]); w.z = pk2(v[4], v[5]); w.w = pk2(v[6], v[7]); return w; }
template <bool ROPE>
__device__ __forceinline__ u32x4 norm_chunk(const u32x4 raw, const float (&g)[8], int nred, float invn, float scale, bool rope, bool lo, const f32x4 (&t)[4]) {
    float x[8]; unpack8(raw, x);
    float ss = 0.f;
#pragma unroll
    for (int e = 0; e < 8; ++e) ss += x[e] * x[e];
    ss += __shfl_xor(ss, 1); ss += __shfl_xor(ss, 2);
    { const float t4 = __shfl_xor(ss, 4); ss += (nred >= 3) ? t4 : 0.f; }
    { const float t8 = __shfl_xor(ss, 8); ss += (nred >= 4) ? t8 : 0.f; }
    { const float t16 = __shfl_xor(ss, 16); ss += (nred >= 5) ? t16 : 0.f; }
    const float rstd = 1.0f / sqrtf(ss * invn + EPS);
    float o[8];
#pragma unroll
    for (int e = 0; e < 8; ++e) { const float y = x[e] * rstd * g[e];
        if (ROPE) { const float yp = __shfl_xor(y, 2); const float c = t[e >> 1][(e & 1) * 2], s = t[e >> 1][(e & 1) * 2 + 1];
            const float r = lo ? (y * c - yp * s) : (y * c + yp * s); o[e] = (rope ? r : y) * scale; }
        else o[e] = y * scale; }
    return pack8(o);
}
__device__ __forceinline__ void load8f(const float* p, float (&g)[8]) { const f32x4 a = *(const f32x4*)p, b = *(const f32x4*)(p + 4); g[0] = a.x; g[1] = a.y; g[2] = a.z; g[3] = a.w; g[4] = b.x; g[5] = b.y; g[6] = b.z; g[7] = b.w; }

__device__ __forceinline__ void ph_rmsnorm(const float* X, const float* g, bf16* H, const WaveId& w) {
    f32x4 gv[4];
#pragma unroll
    for (int j = 0; j < 4; ++j) gv[j] = ((const f32x4*)g)[w.lane + 64 * j];
    int m = w.gw; if (m >= NT) return;
    f32x4 v[4];
#pragma unroll
    for (int j = 0; j < 4; ++j) v[j] = ((const f32x4*)(X + (size_t)m * DM) + w.lane)[64 * j];
    for (; m < NT; m += w.ngw) {
        const int mn = (m + w.ngw < NT) ? m + w.ngw : m; f32x4 nv[4];
#pragma unroll
        for (int j = 0; j < 4; ++j) nv[j] = ((const f32x4*)(X + (size_t)mn * DM) + w.lane)[64 * j];
        float ss = 0.f;
#pragma unroll
        for (int j = 0; j < 4; ++j) ss += (v[j].x * v[j].x + v[j].y * v[j].y) + (v[j].z * v[j].z + v[j].w * v[j].w);
        const float rstd = 1.0f / sqrtf(wave_sum(ss) * (1.0f / DM) + EPS);
        u32x2* o = (u32x2*)(H + (size_t)m * DM) + w.lane;
#pragma unroll
        for (int j = 0; j < 4; ++j) { u32x2 q; q.x = pk2(v[j].x * rstd * gv[j].x, v[j].y * rstd * gv[j].y); q.y = pk2(v[j].z * rstd * gv[j].z, v[j].w * rstd * gv[j].w); o[64 * j] = q; }
#pragma unroll
        for (int j = 0; j < 4; ++j) v[j] = nv[j];
    }
}

__device__ __forceinline__ void ph_prep1(const bf16* PROJ, bf16* OUT, const float* qa_g, const float* kva_g, const float* gq_g, const float* gk_g, const float* kr_g, const float* tabcs  , const WaveId& w) {
    const int lane = w.lane; const float sB = 0.125f * LOG2E;
    float g0[8], g1[8], g2[8];
    load8f(lane < 32 ? qa_g + 8 * lane : (lane < 48 ? kva_g + 8 * (lane - 32) : gq_g + 8 * (lane & 7)), g0);
    load8f(lane < 48 ? gq_g + 8 * (lane & 7) : gk_g + 8 * (lane & 7), g1);
    load8f(kr_g + 8 * (lane & 3), g2);
    const int nred0 = lane < 32 ? 5 : (lane < 48 ? 4 : 3); const float invn0 = lane < 32 ? (1.0f / 256) : (lane < 48 ? (1.0f / 128) : (1.0f / 64));
    const float sc0 = lane >= 48 ? sB : 1.0f, sc1 = lane < 48 ? sB : 1.0f;
    const bool rope0 = lane >= 48, lo = !(lane & 2), k2 = (lane >= 16 && lane < 20);
    const int fi = (lane & 1) * 8, blk = (lane >> 2) & 1;
#define P1_LOAD(R, mm) do { const bf16* row_ = PROJ + (size_t)(mm) * PROJ_LD; const int s_ = (mm) & (SEQ - 1); const int pax_ = blk ? (s_ & 63) : (s_ >> 6); \
        R##c0 = *(const u32x4*)(row_ + 8 * lane); R##c1 = *(const u32x4*)(row_ + 8 * (64 + lane)); R##c2 = *(const u32x4*)(row_ + 8 * (128 + (lane & 31))); \
        const f32x4* ta_ = (const f32x4*)(tabcs + ((size_t)(k2 ? s_ : pax_) * 16 + fi) * 2); const f32x4* tb_ = (const f32x4*)(tabcs + ((size_t)pax_ * 16 + fi) * 2); \
        _Pragma("unroll") for (int k_ = 0; k_ < 4; ++k_) { R##ta[k_] = ta_[k_]; R##tb[k_] = tb_[k_]; } } while (0)
    int m = w.gw; if (m >= NT) return;
    u32x4 Cc0, Cc1, Cc2; f32x4 Cta[4], Ctb[4];
    P1_LOAD(C, m);
    for (; m < NT; m += w.ngw) {
        const int mn = (m + w.ngw < NT) ? m + w.ngw : m;
        u32x4 Nc0, Nc1, Nc2; f32x4 Nta[4], Ntb[4];
        P1_LOAD(N, mn);
        bf16* row = OUT + (size_t)m * PROJ_LD;
        const u32x4 o0 = norm_chunk<true>(Cc0, g0, nred0, invn0, sc0, rope0, lo, Cta);
        const u32x4 o1 = norm_chunk<true>(Cc1, g1, 3, 1.0f / 64, sc1, true, lo, Ctb);
        const u32x4 o2 = norm_chunk<true>(Cc2, g2, 2, 1.0f / 32, 1.0f, true, lo, Cta);
        *(u32x4*)(row + 8 * lane) = o0; *(u32x4*)(row + 8 * (64 + lane)) = o1;
        if (k2) *(u32x4*)(row + 8 * (128 + lane)) = o2;
        Cc0 = Nc0; Cc1 = Nc1; Cc2 = Nc2;
#pragma unroll
        for (int k = 0; k < 4; ++k) { Cta[k] = Nta[k]; Ctb[k] = Ntb[k]; }
    }
#undef P1_LOAD
}
__device__ __forceinline__ void ph_prep2(const bf16* UPO, bf16* OUT, const float* qn_g, const float* qr_g, const float* kn_g, const float* tabcs, const WaveId& w) {
    const int lane = w.lane; const float sA = 0.10206207261596577f * LOG2E;
    float ga[8], gb[8], gc[8];
    load8f(qn_g + 8 * (lane & 7), ga); load8f(qr_g + 8 * (lane & 3), gb); load8f(kn_g + 8 * (lane & 7), gc);
    const bool lo = !(lane & 2); const int fi = (lane & 1) * 8;
    const int ca = 12 * (lane >> 3) + (lane & 7), cb = 12 * ((lane >> 2) & 7) + 8 + (lane & 3), cc = 96 + 16 * (lane >> 3) + (lane & 7);
#define P2_LOAD(R, mm) do { const bf16* row_ = UPO + (size_t)(mm) * UP_LD; const int s_ = (mm) & (SEQ - 1); \
        R##c0 = *(const u32x4*)(row_ + 8 * ca); R##c1 = *(const u32x4*)(row_ + 8 * cb); R##c2 = *(const u32x4*)(row_ + 8 * cc); \
        const f32x4* ta_ = (const f32x4*)(tabcs + ((size_t)s_ * 16 + fi) * 2); \
        _Pragma("unroll") for (int k_ = 0; k_ < 4; ++k_) R##ta[k_] = ta_[k_]; } while (0)
    int m = w.gw; if (m >= NT) return;
    u32x4 Cc0, Cc1, Cc2; f32x4 Cta[4];
    P2_LOAD(C, m);
    for (; m < NT; m += w.ngw) {
        const int mn = (m + w.ngw < NT) ? m + w.ngw : m;
        u32x4 Nc0, Nc1, Nc2; f32x4 Nta[4];
        P2_LOAD(N, mn);
        bf16* row = OUT + (size_t)m * UP_LD;
        const u32x4 o0 = norm_chunk<false>(Cc0, ga, 3, 1.0f / 64, sA, false, lo, Cta);
        const u32x4 o1 = norm_chunk<true>(Cc1, gb, 2, 1.0f / 32, sA, true, lo, Cta);
        const u32x4 o2 = norm_chunk<false>(Cc2, gc, 3, 1.0f / 64, 1.0f, false, lo, Cta);
        *(u32x4*)(row + 8 * ca) = o0; if (lane < 32) *(u32x4*)(row + 8 * cb) = o1; *(u32x4*)(row + 8 * cc) = o2;
        Cc0 = Nc0; Cc1 = Nc1; Cc2 = Nc2;
#pragma unroll
        for (int k = 0; k < 4; ++k) Cta[k] = Nta[k];
    }
#undef P2_LOAD
}
__device__ __forceinline__ void ph_prepc(const bf16* PC, bf16* OUT, const float* q_g, const float* k_g, const WaveId& w) {
    const int lane = w.lane; const float sC = 0.125f * LOG2E;
    float gq[8], gk[8]; load8f(q_g + 8 * (lane & 7), gq); load8f(k_g + 8 * (lane & 7), gk);
    const f32x4 dummy[4] = {};
#define PC_LOAD(R, mm) do { const bf16* row_ = PC + (size_t)(mm) * PC_LD; \
        R##c0 = *(const u32x4*)(row_ + 8 * lane); R##c1 = *(const u32x4*)(row_ + 8 * (64 + lane)); R##c2 = *(const u32x4*)(row_ + 8 * (128 + (lane & 31))); } while (0)
    int m = w.gw; if (m >= NT) return;
    u32x4 Cc0, Cc1, Cc2;
    PC_LOAD(C, m);
    for (; m < NT; m += w.ngw) {
        const int mn = (m + w.ngw < NT) ? m + w.ngw : m;
        u32x4 Nc0, Nc1, Nc2;
        PC_LOAD(N, mn);
        bf16* row = OUT + (size_t)m * PC_LD;
        const u32x4 o0 = norm_chunk<false>(Cc0, gq, 3, 1.0f / 64, sC, false, false, dummy);
        const u32x4 o1 = norm_chunk<false>(Cc1, gq, 3, 1.0f / 64, sC, false, false, dummy);
        const u32x4 o2 = norm_chunk<false>(Cc2, gk, 3, 1.0f / 64, 1.0f, false, false, dummy);
        *(u32x4*)(row + 8 * lane) = o0; *(u32x4*)(row + 8 * (64 + lane)) = o1; if (lane < 32) *(u32x4*)(row + 8 * (128 + lane)) = o2;
        Cc0 = Nc0; Cc1 = Nc1; Cc2 = Nc2;
    }
#undef PC_LOAD
}

__host__ __device__ constexpr int rt_lane(int c) { const int hi = c / 10, b4 = (c % 10) / 5, r = c % 5, b3 = r >= 3 ? 1 : 0, i3 = r - 3 * b3, b2 = i3 >= 2 ? 1 : 0, b1 = i3 - 2 * b2; return 32 * hi + 16 * b4 + 8 * b3 + 4 * b2 + 2 * b1; }
__device__ __forceinline__ void ph_router(const float* XR, const float* g, bf16* H2, const LAS float* wr, const float* b_group, const float* b_router,
                                          int* eidx, float* wts, int* rank, int* list, unsigned* cnt, LAS int* tinfo  , const WaveId& w) {
    const int lane = w.lane;
    f32x4 gv[4];
#pragma unroll
    for (int j = 0; j < 4; ++j) gv[j] = ((const f32x4*)g)[lane + 64 * j];
    float bg[4], br[16];
#pragma unroll
    for (int i = 0; i < 4; ++i) bg[i] = b_group[i];
#pragma unroll
    for (int i = 0; i < 16; ++i) br[i] = b_router[i];
    const bool hi5 = lane & 32, b4 = lane & 16, b3 = lane & 8, b2 = lane & 4, b1 = lane & 2;
    int m = w.gw, it = 0;
    f32x4 v[4];
#pragma unroll
    for (int j = 0; j < 4; ++j) v[j] = ((const f32x4*)(XR + (size_t)(m < NT ? m : 0) * DM) + lane)[64 * j];
    for (; m < NT; m += w.ngw) {
        const int mn = (m + w.ngw < NT) ? m + w.ngw : m; f32x4 nv[4];
#pragma unroll
        for (int j = 0; j < 4; ++j) nv[j] = ((const f32x4*)(XR + (size_t)mn * DM) + lane)[64 * j];
        float ss = 0.f;
#pragma unroll
        for (int j = 0; j < 4; ++j) ss += (v[j].x * v[j].x + v[j].y * v[j].y) + (v[j].z * v[j].z + v[j].w * v[j].w);
        const float rstd = 1.0f / sqrtf(wave_sum(ss) * (1.0f / DM) + EPS);
        u32x2* o = (u32x2*)(H2 + (size_t)m * DM) + lane;
#pragma unroll
        for (int j = 0; j < 4; ++j) { v[j].x *= rstd * gv[j].x; v[j].y *= rstd * gv[j].y; v[j].z *= rstd * gv[j].z; v[j].w *= rstd * gv[j].w;
            u32x2 q; q.x = pk2(v[j].x, v[j].y); q.y = pk2(v[j].z, v[j].w); o[64 * j] = q; }
        float a[20];
#pragma unroll
        for (int c = 0; c < 20; ++c) { float s = 0.f;
#pragma unroll
            for (int j = 0; j < 4; ++j) { const f32x4 ww = *((const LAS f32x4*)(wr + c * 1024) + lane + 64 * j); s += (v[j].x * ww.x + v[j].y * ww.y) + (v[j].z * ww.z + v[j].w * ww.w); }
            a[c] = s; }
        float s10[10], s5[5], s3[3], s2[2];
#pragma unroll
        for (int i = 0; i < 10; ++i) { const float send = hi5 ? a[i] : a[10 + i], keep = hi5 ? a[10 + i] : a[i]; s10[i] = keep + __shfl_xor(send, 32); }
#pragma unroll
        for (int i = 0; i < 5; ++i) { const float send = b4 ? s10[i] : s10[5 + i], keep = b4 ? s10[5 + i] : s10[i]; s5[i] = keep + __shfl_xor(send, 16); }
#pragma unroll
        for (int i = 0; i < 3; ++i) { const float lo_ = s5[i], hi_ = (i < 2) ? s5[3 + i] : 0.f; const float send = b3 ? lo_ : hi_, keep = b3 ? hi_ : lo_; s3[i] = keep + __shfl_xor(send, 8); }
#pragma unroll
        for (int i = 0; i < 2; ++i) { const float lo_ = s3[i], hi_ = (i == 0) ? s3[2] : 0.f; const float send = b2 ? lo_ : hi_, keep = b2 ? hi_ : lo_; s2[i] = keep + __shfl_xor(send, 4); }
        float s1; { const float send = b1 ? s2[0] : s2[1], keep = b1 ? s2[1] : s2[0]; s1 = keep + __shfl_xor(send, 2); }
        s1 += __shfl_xor(s1, 1);
        float lg[20];
#pragma unroll
        for (int c = 0; c < 20; ++c) lg[c] = __builtin_bit_cast(float, __builtin_amdgcn_readlane(__builtin_bit_cast(int, s1), rt_lane(c)));
        const float g0 = lg[0] + bg[0], g1 = lg[1] + bg[1], g2 = lg[2] + bg[2], g3 = lg[3] + bg[3];
        int gi = 0; float gm = g0; if (g1 > gm) { gm = g1; gi = 1; } if (g2 > gm) { gm = g2; gi = 2; } if (g3 > gm) { gm = g3; gi = 3; }
        const float gp = 1.0f / (expf(g0 - gm) + expf(g1 - gm) + expf(g2 - gm) + expf(g3 - gm));
        float e0, e1, e2, e3;
        if (gi == 0)      { e0 = lg[4] + br[0];   e1 = lg[5] + br[1];   e2 = lg[6] + br[2];   e3 = lg[7] + br[3]; }
        else if (gi == 1) { e0 = lg[8] + br[4];   e1 = lg[9] + br[5];   e2 = lg[10] + br[6];  e3 = lg[11] + br[7]; }
        else if (gi == 2) { e0 = lg[12] + br[8];  e1 = lg[13] + br[9];  e2 = lg[14] + br[10]; e3 = lg[15] + br[11]; }
        else              { e0 = lg[16] + br[12]; e1 = lg[17] + br[13]; e2 = lg[18] + br[14]; e3 = lg[19] + br[15]; }
        int i1 = 0; float m1 = e0; if (e1 > m1) { m1 = e1; i1 = 1; } if (e2 > m1) { m1 = e2; i1 = 2; } if (e3 > m1) { m1 = e3; i1 = 3; }
        int i2 = -1; float m2 = -3.0e38f;
        if (i1 != 0 && e0 > m2) { m2 = e0; i2 = 0; } if (i1 != 1 && e1 > m2) { m2 = e1; i2 = 1; } if (i1 != 2 && e2 > m2) { m2 = e2; i2 = 2; } if (i1 != 3 && e3 > m2) { m2 = e3; i2 = 3; }
        const float t2 = expf(m2 - m1); const float w1 = gp / (1.0f + t2), w2 = gp * t2 / (1.0f + t2);
        if (lane == 0) {
            const int ea = gi * 4 + i1, eb = gi * 4 + i2;
            const int la = __hip_atomic_fetch_add(tinfo + ea, 1, __ATOMIC_RELAXED, __HIP_MEMORY_SCOPE_WORKGROUP);
            const int lb = __hip_atomic_fetch_add(tinfo + eb, 1, __ATOMIC_RELAXED, __HIP_MEMORY_SCOPE_WORKGROUP);
            eidx[2 * m] = ea; eidx[2 * m + 1] = eb; wts[2 * m] = w1; wts[2 * m + 1] = w2;
            LAS int* ti = tinfo + 32 + 4 * (it * 8 + w.wave); ti[0] = m; ti[1] = ea | (eb << 8); ti[2] = la; ti[3] = lb;
        }
        ++it;
#pragma unroll
        for (int j = 0; j < 4; ++j) v[j] = nv[j];
    }
    __syncthreads();
    if (threadIdx.x < 16) tinfo[16 + threadIdx.x] = (int)__hip_atomic_fetch_add(cnt + 64 * threadIdx.x, (unsigned)tinfo[threadIdx.x], __ATOMIC_RELAXED, __HIP_MEMORY_SCOPE_AGENT);
    __syncthreads();
    { const int nloc = (NT - (int)blockIdx.x * 8 + w.ngw - 1) / w.ngw * 8;
      for (int k = threadIdx.x; k < nloc; k += 512) { const int wv = k & 7, itk = k >> 3; const int mm = ((int)blockIdx.x * 8 + wv) + itk * w.ngw;
          if (mm < NT) { const LAS int* ti = tinfo + 32 + 4 * k; const int ea = ti[1] & 255, eb = ti[1] >> 8; const int ra = tinfo[16 + ea] + ti[2], rb = tinfo[16 + eb] + ti[3];
              rank[2 * mm] = ra; rank[2 * mm + 1] = rb; list[(size_t)ea * NT + ra] = mm; list[(size_t)eb * NT + rb] = mm; } } }
}
__device__ __forceinline__ int moe_offsets(const unsigned* cnt, int (&off)[17]) {
    int a = 0;
#pragma unroll
    for (int e = 0; e < 16; ++e) { off[e] = a; a += ((int)cnt[64 * e] + 255) & ~255; }
    off[16] = a; return a >> 8;
}
template <bool NORM>
__device__ __forceinline__ void ph_combine(const float* XR, float* XO, const bf16* Y, const int* eidx, const int* rank, const float* wts, const unsigned* cnt, const float* g, bf16* H, const WaveId& w) {
    const int lane = w.lane;
    int off[17]; moe_offsets(cnt, off);
    f32x4 gv[4];
    if (NORM) {
#pragma unroll
        for (int j = 0; j < 4; ++j) gv[j] = ((const f32x4*)g)[lane + 64 * j];
    }
#define CB_LOAD(R, mm) do { const int e0_ = eidx[2 * (mm)], e1_ = eidx[2 * (mm) + 1]; int b0_ = 0, b1_ = 0; \
        _Pragma("unroll") for (int q_ = 0; q_ < 16; ++q_) { b0_ = (q_ == e0_) ? off[q_] : b0_; b1_ = (q_ == e1_) ? off[q_] : b1_; } \
        const int s0_ = b0_ + rank[2 * (mm)], s1_ = b1_ + rank[2 * (mm) + 1]; R##w0 = wts[2 * (mm)]; R##w1 = wts[2 * (mm) + 1]; \
        const f32x4* xr_ = (const f32x4*)(XR + (size_t)(mm) * DM) + lane; const u32x2* y0_ = (const u32x2*)(Y + (size_t)s0_ * DM) + lane; const u32x2* y1_ = (const u32x2*)(Y + (size_t)s1_ * DM) + lane; \
        _Pragma("unroll") for (int j_ = 0; j_ < 4; ++j_) { R##x[j_] = xr_[64 * j_]; R##a[j_] = y0_[64 * j_]; R##b[j_] = y1_[64 * j_]; } } while (0)
    int m = w.gw; if (m >= NT) return;
    f32x4 Cx[4]; u32x2 Ca[4], Cb[4]; float Cw0, Cw1;
    CB_LOAD(C, m);
    for (; m < NT; m += w.ngw) {
        const int mn = (m + w.ngw < NT) ? m + w.ngw : m;
        f32x4 Nx[4]; u32x2 Na[4], Nb[4]; float Nw0, Nw1;
        CB_LOAD(N, mn);
        f32x4* xr = (f32x4*)(XO + (size_t)m * DM) + lane;
        f32x4 v[4]; float ss = 0.f;
#pragma unroll
        for (int j = 0; j < 4; ++j) { v[j] = Cx[j]; const u32x2 a = Ca[j], b = Cb[j];
            v[j].x += Cw0 * bf2f(a.x & 0xffffu) + Cw1 * bf2f(b.x & 0xffffu); v[j].y += Cw0 * bf2f(a.x >> 16) + Cw1 * bf2f(b.x >> 16);
            v[j].z += Cw0 * bf2f(a.y & 0xffffu) + Cw1 * bf2f(b.y & 0xffffu); v[j].w += Cw0 * bf2f(a.y >> 16) + Cw1 * bf2f(b.y >> 16);
            xr[64 * j] = v[j]; ss += (v[j].x * v[j].x + v[j].y * v[j].y) + (v[j].z * v[j].z + v[j].w * v[j].w); }
        if (NORM) {
            const float rstd = 1.0f / sqrtf(wave_sum(ss) * (1.0f / DM) + EPS);
            u32x2* o = (u32x2*)(H + (size_t)m * DM) + lane;
#pragma unroll
            for (int j = 0; j < 4; ++j) { u32x2 q; q.x = pk2(v[j].x * rstd * gv[j].x, v[j].y * rstd * gv[j].y); q.y = pk2(v[j].z * rstd * gv[j].z, v[j].w * rstd * gv[j].w); o[64 * j] = q; }
        }
#pragma unroll
        for (int j = 0; j < 4; ++j) { Cx[j] = Nx[j]; Ca[j] = Na[j]; Cb[j] = Nb[j]; }
        Cw0 = Nw0; Cw1 = Nw1;
    }
#undef CB_LOAD
}

template <int DQK, bool WIN>
__device__ __forceinline__ void naive_attn_row(const bf16* qrow, const bf16* Kn, int ldk, const bf16* Kr, int ldkr, const bf16* Vp, int ldv, bf16* orow,
                                               int qpos, const float* btab, float sinkl2, LAS float* qf  , int lane) {
    for (int d = lane; d < DQK; d += 64) qf[d] = bf2f(qrow[d]);
    LDS_WAIT(); asm volatile("" ::: "memory");
    float m = -1.0e30f, l = 0.f, o = 0.f;
    const int kbeg = WIN ? qpos - 128 : 0, nch = WIN ? 5 : SEQ / 64;
    for (int ci = 0; ci < nch; ++ci) {
        const int key = kbeg + ci * 64 + lane; const bool valid = !WIN || (key >= 0 && key < SEQ && key - qpos <= 128);
        const int kc = valid ? key : 0;
        float s = 0.f;
        { const bf16* kp = Kn + (size_t)kc * ldk;
#pragma unroll
          for (int c = 0; c < 8; ++c) { const u32x4 kv = *(const u32x4*)(kp + c * 8); const LAS float* q = qf + c * 8;
              s += q[0] * bf2f(kv.x & 0xffffu) + q[1] * bf2f(kv.x >> 16) + q[2] * bf2f(kv.y & 0xffffu) + q[3] * bf2f(kv.y >> 16) + q[4] * bf2f(kv.z & 0xffffu) + q[5] * bf2f(kv.z >> 16) + q[6] * bf2f(kv.w & 0xffffu) + q[7] * bf2f(kv.w >> 16); }
          if (DQK == 96) { const bf16* rp = Kr + (size_t)kc * ldkr;
#pragma unroll
              for (int c = 0; c < 4; ++c) { const u32x4 kv = *(const u32x4*)(rp + c * 8); const LAS float* q = qf + 64 + c * 8;
                  s += q[0] * bf2f(kv.x & 0xffffu) + q[1] * bf2f(kv.x >> 16) + q[2] * bf2f(kv.y & 0xffffu) + q[3] * bf2f(kv.y >> 16) + q[4] * bf2f(kv.z & 0xffffu) + q[5] * bf2f(kv.z >> 16) + q[6] * bf2f(kv.w & 0xffffu) + q[7] * bf2f(kv.w >> 16); } } }
        if (WIN) s = valid ? s + btab[key - qpos + 256] : -INFINITY;
        const float mn = fmaxf(m, wave_max(s)); const float p = exp2f(s - mn), al = exp2f(m - mn);
        l = l * al + wave_sum(p); o *= al; m = mn;
        const int kb = kbeg + ci * 64;
        for (int j = 0; j < 64; ++j) { const float pj = __shfl(p, j); int kk = kb + j; if (WIN) kk = (kk < 0 || kk >= SEQ) ? 0 : kk; o += pj * bf2f(Vp[(size_t)kk * ldv + lane]); }
    }
    if (WIN) { const float mn = fmaxf(m, sinkl2); const float al = exp2f(m - mn); l = l * al + exp2f(sinkl2 - mn); o *= al; }
    orow[lane] = (bf16)f2bf(o / l);
    LDS_WAIT(); asm volatile("" ::: "memory");
}
constexpr int NPHASE = 19;
struct Args { const float* in[28]; float* out; unsigned char* ws; int ph_lo, ph_hi; };
enum { I_X = 0, I_MIXN, I_FFNN, I_WINAB, I_QAN, I_WQUP, I_KVAN, I_WKVUP, I_QNG, I_KNG, I_QRG, I_KRG, I_GQG, I_GKG, I_WOUTAB, I_WINC, I_WQG, I_WKG, I_SINK, I_WOUTC,
       I_RELB, I_WGRP, I_BGRP, I_WRTR, I_BRTR, I_WGATE, I_WUP, I_WDOWN };

__global__ void __launch_bounds__(512, 2) mk_fwd(Args args) {
    extern __shared__ __attribute__((aligned(16))) unsigned char lds[];
    LAS unsigned char* L = (LAS unsigned char*)lds;
    const int tid = threadIdx.x, lane = tid & 63, wave = __builtin_amdgcn_readfirstlane(tid >> 6);
    const int G = gridDim.x, bx = blockIdx.x;
    const int vcu = (G % 8 == 0) ? (bx % 8) * (G / 8) + bx / 8 : bx;
    WaveId W; W.gw = bx * 8 + wave; W.ngw = G * 8; W.lane = lane; W.wave = wave;
    const __attribute__((address_space(4))) Args* argp_ = (const __attribute__((address_space(4))) Args*)__builtin_amdgcn_kernarg_segment_ptr();
#define INP(i) ({ const __attribute__((address_space(4))) Args* a_ = argp_; asm volatile("" : "+s"(a_)); (const float*)a_->in[i]; })
    unsigned char* ws = args.ws;
    unsigned* ctl = (unsigned*)(ws + WS_CTL);
    float* tab = (float*)(ws + WS_TAB);
    int* r_eidx = (int*)(ws + WS_ROUTE); float* r_wts = (float*)(ws + WS_ROUTE + 512 * 1024); int* r_slot = (int*)(ws + WS_ROUTE + 1024 * 1024);
    bf16* WT_AB = (bf16*)(ws + WS_WAB); bf16* WT_UP = (bf16*)(ws + WS_WUP); bf16* WT_OAB = (bf16*)(ws + WS_WOAB); bf16* WT_C = (bf16*)(ws + WS_WC); bf16* WT_OC = (bf16*)(ws + WS_WOC);
    bf16* WT_GU = (bf16*)(ws + WS_WGU); bf16* WT_D = (bf16*)(ws + WS_WD);
    bf16* HB = (bf16*)(ws + WS_H); bf16* PROJ = (bf16*)(ws + WS_PROJ); bf16* UPO = (bf16*)(ws + WS_UPO); bf16* PROJC = (bf16*)(ws + WS_PROJC);
    bf16* ACT = (bf16*)(ws + WS_ACT); bf16* DUMMY = (bf16*)(ws + WS_END);
    float* XR = args.out;
    volatile LAS unsigned* MISC = (volatile LAS unsigned*)(L + MISC_OFF);
    if (tid < 16) MISC[tid] = 0u;
    __syncthreads();
    const int lo = args.ph_lo, hi = args.ph_hi;
    XcdBarrier bar; bar.bar = ctl + CW_BAR; bar.x = 0; bar.st = nullptr;
    if (hi - lo > 1) bar = xcd_barrier_post(ctl + CW_BAR, MISC + 8);
#define IN(k) (lo <= (k) && (k) < hi)
#define SEAM(k) do { if (IN(k) && IN((k) + 1)) xcd_barrier(bar); } while (0)
#ifndef MK_REP_MASK
#define MK_REP_MASK 0
#endif
#ifndef MK_REP_N
#define MK_REP_N 1
#endif
#define REPS(k) (((MK_REP_MASK >> (k)) & 1) ? MK_REP_N : 1)
#define PH_BEGIN(k) if (IN(k)) { for (int rep_ = 0; rep_ < REPS(k); ++rep_) { if (rep_) xcd_barrier(bar);
#define PH_END(k) } } SEAM(k);

    PH_BEGIN(0) {
        LAS float* scr = (LAS float*)(L + wave * 16384);
        constexpr int I_AB = 16 * 37, I_QU = 4 * 24, I_KU = 2 * 32, I_O = 16 * 32, I_C = 16 * 48, I_E = 256;
        constexpr int NIT = I_AB + I_QU + I_KU + I_O + I_C + I_O + 3 * 32 * I_E;
        for (int it = W.gw; it < NIT; it += W.ngw) {
            int r = it;
            if (r < I_AB) { tr_seg<1>(r, INP(I_WINAB), 1184, 1184, WT_AB, 1024, 0, 0, scr, lane); continue; } r -= I_AB;
            if (r < I_QU) { tr_seg<0>(r, INP(I_WQUP), 768, 768, WT_UP, UP_K, 0, 0, scr, lane); continue; } r -= I_QU;
            if (r < I_KU) { tr_seg<0>(r, INP(I_WKVUP), 1024, 1024, WT_UP, UP_K, 768, 256, scr, lane); continue; } r -= I_KU;
            if (r < I_O) { tr_seg<0>(r, INP(I_WOUTAB), 1024, 1024, WT_OAB, 1024, 0, 0, scr, lane); continue; } r -= I_O;
            if (r < I_C) { tr_seg<0>(r, INP(I_WINC), 1536, 1536, WT_C, 1024, 0, 0, scr, lane); continue; } r -= I_C;
            if (r < I_O) { tr_seg<0>(r, INP(I_WOUTC), 1024, 1024, WT_OC, 1024, 0, 0, scr, lane); continue; } r -= I_O;
            const int le = r / (3 * I_E), q = r % (3 * I_E);
            if (q < I_E) tr_seg<2>(q, INP(I_WGATE) + (size_t)le * 1024 * 512, 512, 512, WT_GU + (size_t)le * 1024 * 1024, 1024, 0, 0, scr, lane);
            else if (q < 2 * I_E) tr_seg<3>(q - I_E, INP(I_WUP) + (size_t)le * 1024 * 512, 512, 512, WT_GU + (size_t)le * 1024 * 1024, 1024, 0, 0, scr, lane);
            else tr_seg<0>(q - 2 * I_E, INP(I_WDOWN) + (size_t)le * 512 * 1024, 1024, 1024, WT_D + (size_t)le * 1024 * 512, 512, 0, 0, scr, lane);
        }
        { const int gt = W.gw * 64 + lane, ngt = W.ngw * 64; const u32x4 z = {0u, 0u, 0u, 0u};
          for (int i = gt; i < 96 * 128; i += ngt) *(u32x4*)(WT_AB + (size_t)(1184 + i / 128) * 1024 + (i % 128) * 8) = z;
          for (int i = gt; i < 768 * 16; i += ngt) *(u32x4*)(WT_UP + (size_t)(i / 16) * UP_K + 256 + (i % 16) * 8) = z;
          for (int i = gt; i < 1024 * 32; i += ngt) *(u32x4*)(WT_UP + (size_t)(768 + i / 32) * UP_K + (i % 32) * 8) = z;
          for (int i = gt; i < 4096 * 16; i += ngt) { const float ang = (float)(i >> 4) * powf(10000.0f, -(float)(i & 15) * (1.0f / 16.0f)); tab[TB_CS + 2 * i] = cosf(ang); tab[TB_CS + 2 * i + 1] = sinf(ang); }
          const float* relb = INP(I_RELB);
          for (int i = gt; i < 16 * 512; i += ngt) { const int h = i >> 9, rel = (i & 511) - 256; tab[TB_BIAS + i] = (rel >= -128 && rel <= 128) ? relb[t5_bucket_dev(rel) * 16 + h] * LOG2E : -1.0e30f; } }
        if (W.gw == 0) {
            const float gqn = gain_absmax(INP(I_QNG), 64, lane), gkn = gain_absmax(INP(I_KNG), 64, lane), gqr = gain_absmax(INP(I_QRG), 32, lane), gkr = gain_absmax(INP(I_KRG), 32, lane);
            const float gbq = gain_absmax(INP(I_GQG), 64, lane), gbk = gain_absmax(INP(I_GKG), 64, lane), gcq = gain_absmax(INP(I_WQG), 64, lane), gck = gain_absmax(INP(I_WKG), 64, lane);
            float bm = 0.f; for (int i = lane; i < 512; i += 64) bm = fmaxf(bm, INP(I_RELB)[i]); bm = wave_max(bm);
            if (lane == 0) { tab[TB_CONST + 0] = -(0.10206207261596577f * LOG2E * (64.f * gqn * gkn + 32.f * gqr * gkr));
                             tab[TB_CONST + 1] = -(0.125f * LOG2E * 64.f * gbq * gbk);
                             tab[TB_CONST + 2] = -(0.125f * LOG2E * 64.f * gcq * gck + bm * LOG2E); }
            if (lane < 16) tab[TB_CONST + 16 + lane] = INP(I_SINK)[lane] * LOG2E;
        }
        ph_rmsnorm(INP(I_X), INP(I_MIXN), HB, W);
    }
    PH_END(0)
#ifdef MK_EXTRA_BAR
    if (IN(0) && IN(1)) { for (int xb_ = 0; xb_ < MK_EXTRA_BAR; ++xb_) xcd_barrier(bar); }
#endif


        PH_BEGIN(1) {
#if MK_GEMM
            pg8::Gemm g{HB, WT_AB, 1024, 1024, 1024}; pg8::StaticOrder S; S.init(NT, PROJ_LD, 1024, 1024, G, bx); pg8::EpiStoreBf16 E{PROJ, PROJ_LD};
            pg8::gemm_phase<pg8::EpiStoreBf16, pg8::StaticOrder, true>(L, g, S, E);
#else
            naive_gemm<0>(HB, 1024, WT_AB, 1024, NT, PROJ_LD, 1024, PROJ, nullptr, nullptr, PROJ_LD, W);
#endif
        }
        PH_END(1)
        PH_BEGIN(2) ph_prep1(PROJ, rep_ ? DUMMY : PROJ, INP(I_QAN), INP(I_KVAN), INP(I_GQG), INP(I_GKG), INP(I_KRG), tab + TB_CS, W);
        PH_END(2)
        PH_BEGIN(3) {
#if MK_GEMM
            pg8::Gemm g{PROJ, WT_UP, PROJ_LD, UP_K, UP_K}; pg8::StaticOrder S; S.init(NT, UP_LD, PROJ_LD, UP_K, G, bx); pg8::EpiStoreBf16 E{UPO, UP_LD};
            pg8::gemm_phase<pg8::EpiStoreBf16, pg8::StaticOrder, true>(L, g, S, E);
#else
            naive_gemm<0>(PROJ, PROJ_LD, WT_UP, UP_K, NT, UP_LD, UP_K, UPO, nullptr, nullptr, UP_LD, W);
#endif
        }
        PH_END(3)
        PH_BEGIN(4) ph_prep2(UPO, rep_ ? DUMMY : UPO, INP(I_QNG), INP(I_QRG), INP(I_KNG), tab + TB_CS, W);
        PH_END(4)
        PH_BEGIN(5) {
            const float negcA = tab[TB_CONST + 0], negcB = tab[TB_CONST + 1];
#if MK_ATTN
            for (int u = vcu; u < 1024; u += G) { const int b = u >> 7, h = (u >> 4) & 7, qb = u & 15; const size_t r0 = (size_t)b * SEQ, rq = r0 + qb * 256;
                att::attn_unit<96, false>(UPO + rq * UP_LD + 96 * h, UP_LD, UPO + r0 * UP_LD + 768 + 128 * h, UP_LD, PROJ + r0 * PROJ_LD + PC_KROPE, PROJ_LD,
                                          UPO + r0 * UP_LD + 768 + 128 * h + 64, UP_LD, HB + rq * DM + 64 * h, DM, 0, SEQ / 64, negcA, 0, nullptr, 0.f, (char*)lds); }
            for (int u = vcu; u < 1024; u += G) { const int b = u >> 7, h = (u >> 4) & 7, qb = u & 15; const size_t r0 = (size_t)b * SEQ, rq = r0 + qb * 256;
                att::attn_unit<64, false>(PROJ + rq * PROJ_LD + PC_BQ + 64 * h, PROJ_LD, PROJ + r0 * PROJ_LD + PC_BK + 64 * (h >> 2), PROJ_LD, nullptr, 0,
                                          PROJ + r0 * PROJ_LD + PC_BV + 64 * (h >> 2), PROJ_LD, HB + rq * DM + 512 + 64 * h, DM, 0, SEQ / 64, negcB, 0, nullptr, 0.f, (char*)lds); }
#else
            LAS float* qf = (LAS float*)(L + wave * 512);
            for (long it = W.gw; it < (long)NT * 8; it += W.ngw) { const int m = (int)(it >> 3), h = (int)(it & 7); const size_t r0 = (size_t)(m / SEQ) * SEQ;
                naive_attn_row<96, false>(UPO + (size_t)m * UP_LD + 96 * h, UPO + r0 * UP_LD + 768 + 128 * h, UP_LD, PROJ + r0 * PROJ_LD + PC_KROPE, PROJ_LD,
                                          UPO + r0 * UP_LD + 768 + 128 * h + 64, UP_LD, HB + (size_t)m * DM + 64 * h, 0, nullptr, 0.f, qf, lane); }
            for (long it = W.gw; it < (long)NT * 8; it += W.ngw) { const int m = (int)(it >> 3), h = (int)(it & 7); const size_t r0 = (size_t)(m / SEQ) * SEQ;
                naive_attn_row<64, false>(PROJ + (size_t)m * PROJ_LD + PC_BQ + 64 * h, PROJ + r0 * PROJ_LD + PC_BK + 64 * (h >> 2), PROJ_LD, nullptr, 0,
                                          PROJ + r0 * PROJ_LD + PC_BV + 64 * (h >> 2), PROJ_LD, HB + (size_t)m * DM + 512 + 64 * h, 0, nullptr, 0.f, qf, lane); }
            (void)negcA; (void)negcB;
#endif
        }
        PH_END(5)
        PH_BEGIN(6) {
#if MK_GEMM
            pg8::Gemm g{HB, WT_OAB, 1024, 1024, 1024}; pg8::StaticOrder S; S.init(NT, DM, 1024, 1024, G, bx); pg8::EpiResF32 E{INP(I_X), XR, DM};
            pg8::gemm_phase<pg8::EpiResF32, pg8::StaticOrder, true>(L, g, S, E);
#else
            naive_gemm<1>(HB, 1024, WT_OAB, 1024, NT, DM, 1024, nullptr, INP(I_X), XR, DM, W);
#endif
        }
        PH_END(6)

    { constexpr int LAYER_ = 0;
    constexpr int layer = LAYER_; constexpr int pb = 8 * layer;
    unsigned* cnt = ctl + CW_CNT + 1024 * layer;
    int* eidx = r_eidx + (size_t)layer * NT * 2; float* wts = r_wts + (size_t)layer * NT * 2; int* rank = r_slot + (size_t)layer * NT * 2;
    int* list = (int*)(ws + WS_LIST);
    bf16* YB = (bf16*)(ws + WS_Y);
    PH_BEGIN(7 + pb) {
        LAS float* wr = (LAS float*)L;
        const float* wg = INP(I_WGRP) + (size_t)layer * 1024 * 4; const float* wrt = INP(I_WRTR) + (size_t)layer * 1024 * 16;
        for (int i = tid; i < 1024 * 4; i += 512) wr[(i & 3) * 1024 + (i >> 2)] = wg[i];
        for (int i = tid; i < 1024 * 16; i += 512) wr[(4 + (i & 15)) * 1024 + (i >> 4)] = wrt[i];
        if (tid < 32) ((LAS int*)(L + 81920))[tid] = 0;
        __syncthreads();
        if (rep_ == 0) ph_router(XR, INP(I_FFNN) + layer * DM, HB, wr, INP(I_BGRP) + layer * 4, INP(I_BRTR) + layer * 16, eidx, wts, rank, list, cnt, (LAS int*)(L + 81920), W);
        else ph_router(XR, INP(I_FFNN) + layer * DM, DUMMY, wr, INP(I_BGRP) + layer * 4, INP(I_BRTR) + layer * 16, (int*)(DUMMY + 40 * MiB), (float*)(DUMMY + 41 * MiB), (int*)(DUMMY + 42 * MiB), (int*)(DUMMY + 43 * MiB), ctl + 8192, (LAS int*)(L + 81920), W);
    }
    PH_END(7 + pb)
    PH_BEGIN(8 + pb) {
        LAS unsigned char* tile_e = L + MISC_OFF + 1024; LAS int* rowtok = (LAS int*)(L + MISC_OFF + 2048);
        if (tid < 64) { int off[17]; const int ntile = moe_offsets(cnt, off);
            for (int t = lane; t < ntile; t += 64) { const int row = t * 256; int e = 0;
#pragma unroll
                for (int q = 1; q < 16; ++q) e = (row >= off[q]) ? q : e;
                tile_e[t] = (unsigned char)e; }
            if (lane == 0) MISC[4] = (unsigned)ntile; }
        __syncthreads();
        const int ntile = (int)MISC[4];
        { int off[17]; moe_offsets(cnt, off);
          for (int idx = tid; idx < 13 * 256; idx += 512) { const int ui = idx >> 8, r = idx & 255; const long Lu = (long)ui * G + vcu;
              if (Lu < (long)ntile * 4) { const int pm = (int)(Lu >> 2); const int e = tile_e[pm]; int base = 0, ce = 0;
#pragma unroll
                  for (int q = 0; q < 16; ++q) { base = (q == e) ? off[q] : base; ce = (q == e) ? (int)cnt[64 * q] : ce; }
                  const int lr = pm * 256 - base + r; rowtok[idx] = (lr < ce) ? list[(size_t)e * NT + lr] : 0; } } }
        __syncthreads();
        pg8::Gemm g{HB, WT_GU + (size_t)layer * 16 * 1024 * 1024, 1024, 1024, 1024};
        pg8::MoeOrder S{tile_e, ntile, 4, G, vcu, 1024, 1024, (long)1024 * 1024}; pg8::EpiSwiGLU E{ACT, DEXP};
        pg8::gemm_phase<pg8::EpiSwiGLU, pg8::MoeOrder, true, true>(L, g, S, E, rowtok);
    }
    PH_END(8 + pb)
    PH_BEGIN(9 + pb) {
        LAS unsigned char* tile_e = L + MISC_OFF + 1024;
        if (tid < 64) { int off[17]; const int ntile = moe_offsets(cnt, off);
            for (int t = lane; t < ntile; t += 64) { const int row = t * 256; int e = 0;
#pragma unroll
                for (int q = 1; q < 16; ++q) e = (row >= off[q]) ? q : e;
                tile_e[t] = (unsigned char)e; }
            if (lane == 0) MISC[4] = (unsigned)ntile; }
        __syncthreads();
        const int ntile = (int)MISC[4];
        pg8::Gemm g{ACT, WT_D + (size_t)layer * 16 * 1024 * 512, DEXP, DEXP, DEXP};
        pg8::MoeOrder S{tile_e, ntile, 4, G, vcu, DEXP, DEXP, (long)1024 * 512}; pg8::EpiStoreBf16 E{YB, DM};
        pg8::gemm_phase<pg8::EpiStoreBf16, pg8::MoeOrder, true>(L, g, S, E);
    }
    PH_END(9 + pb)
    PH_BEGIN(10 + pb) {
        if (layer == 0) ph_combine<true>(XR, rep_ ? (float*)DUMMY : XR, YB, eidx, rank, wts, cnt, INP(I_MIXN) + DM, rep_ ? ACT : HB, W);
        else ph_combine<false>(XR, rep_ ? (float*)DUMMY : XR, YB, eidx, rank, wts, cnt, nullptr, nullptr, W);
    } } } if (layer == 0) SEAM(10);

    }

        PH_BEGIN(11) {
#if MK_GEMM
            pg8::Gemm g{HB, WT_C, 1024, 1024, 1024}; pg8::StaticOrder S; S.init(NT, PC_LD, 1024, 1024, G, bx); pg8::EpiStoreBf16 E{PROJC, PC_LD};
            pg8::gemm_phase<pg8::EpiStoreBf16, pg8::StaticOrder, true>(L, g, S, E);
#else
            naive_gemm<0>(HB, 1024, WT_C, 1024, NT, PC_LD, 1024, PROJC, nullptr, nullptr, PC_LD, W);
#endif
        }
        PH_END(11)
        PH_BEGIN(12) ph_prepc(PROJC, rep_ ? DUMMY : PROJC, INP(I_WQG), INP(I_WKG), W);
        PH_END(12)
        PH_BEGIN(13) {
            const float negcC = tab[TB_CONST + 2];
#if MK_ATTN
            for (int u = vcu; u < 2048; u += G) { const int b = u >> 8, h = (u >> 4) & 15, qb = u & 15; const size_t r0 = (size_t)b * SEQ, rq = r0 + qb * 256;
                const int q0 = qb * 256; const int kt0 = q0 >= 128 ? (q0 - 128) / 64 : 0; const int kt1 = (q0 / 64 + 6) < 64 ? (q0 / 64 + 6) : 64;
                att::attn_unit<64, true>(PROJC + rq * PC_LD + 64 * h, PC_LD, PROJC + r0 * PC_LD + 1024 + 64 * (h >> 2), PC_LD, nullptr, 0,
                                         PROJC + r0 * PC_LD + 1280 + 64 * (h >> 2), PC_LD, HB + rq * DM + 64 * h, DM, kt0, kt1, negcC, q0, tab + TB_BIAS + 512 * h, tab[TB_CONST + 16 + h], (char*)lds); }
#else
            LAS float* qf = (LAS float*)(L + wave * 512);
            for (long it = W.gw; it < (long)NT * 16; it += W.ngw) { const int m = (int)(it >> 4), h = (int)(it & 15); const size_t r0 = (size_t)(m / SEQ) * SEQ;
                naive_attn_row<64, true>(PROJC + (size_t)m * PC_LD + 64 * h, PROJC + r0 * PC_LD + 1024 + 64 * (h >> 2), PC_LD, nullptr, 0,
                                         PROJC + r0 * PC_LD + 1280 + 64 * (h >> 2), PC_LD, HB + (size_t)m * DM + 64 * h, m & (SEQ - 1), tab + TB_BIAS + 512 * h, tab[TB_CONST + 16 + h], qf, lane); }
            (void)negcC;
#endif
        }
        PH_END(13)
        PH_BEGIN(14) {
#if MK_GEMM
            pg8::Gemm g{HB, WT_OC, 1024, 1024, 1024}; pg8::StaticOrder S; S.init(NT, DM, 1024, 1024, G, bx); pg8::EpiResF32 E{XR, XR, DM};
            pg8::gemm_phase<pg8::EpiResF32, pg8::StaticOrder, true>(L, g, S, E);
#else
            naive_gemm<1>(HB, 1024, WT_OC, 1024, NT, DM, 1024, nullptr, XR, XR, DM, W);
#endif
        }
        PH_END(14)

    { constexpr int LAYER_ = 1;
    constexpr int layer = LAYER_; constexpr int pb = 8 * layer;
    unsigned* cnt = ctl + CW_CNT + 1024 * layer;
    int* eidx = r_eidx + (size_t)layer * NT * 2; float* wts = r_wts + (size_t)layer * NT * 2; int* rank = r_slot + (size_t)layer * NT * 2;
    int* list = (int*)(ws + WS_LIST);
    bf16* YB = (bf16*)(ws + WS_Y);
    PH_BEGIN(7 + pb) {
        LAS float* wr = (LAS float*)L;
        const float* wg = INP(I_WGRP) + (size_t)layer * 1024 * 4; const float* wrt = INP(I_WRTR) + (size_t)layer * 1024 * 16;
        for (int i = tid; i < 1024 * 4; i += 512) wr[(i & 3) * 1024 + (i >> 2)] = wg[i];
        for (int i = tid; i < 1024 * 16; i += 512) wr[(4 + (i & 15)) * 1024 + (i >> 4)] = wrt[i];
        if (tid < 32) ((LAS int*)(L + 81920))[tid] = 0;
        __syncthreads();
        if (rep_ == 0) ph_router(XR, INP(I_FFNN) + layer * DM, HB, wr, INP(I_BGRP) + layer * 4, INP(I_BRTR) + layer * 16, eidx, wts, rank, list, cnt, (LAS int*)(L + 81920), W);
        else ph_router(XR, INP(I_FFNN) + layer * DM, DUMMY, wr, INP(I_BGRP) + layer * 4, INP(I_BRTR) + layer * 16, (int*)(DUMMY + 40 * MiB), (float*)(DUMMY + 41 * MiB), (int*)(DUMMY + 42 * MiB), (int*)(DUMMY + 43 * MiB), ctl + 8192, (LAS int*)(L + 81920), W);
    }
    PH_END(7 + pb)
    PH_BEGIN(8 + pb) {
        LAS unsigned char* tile_e = L + MISC_OFF + 1024; LAS int* rowtok = (LAS int*)(L + MISC_OFF + 2048);
        if (tid < 64) { int off[17]; const int ntile = moe_offsets(cnt, off);
            for (int t = lane; t < ntile; t += 64) { const int row = t * 256; int e = 0;
#pragma unroll
                for (int q = 1; q < 16; ++q) e = (row >= off[q]) ? q : e;
                tile_e[t] = (unsigned char)e; }
            if (lane == 0) MISC[4] = (unsigned)ntile; }
        __syncthreads();
        const int ntile = (int)MISC[4];
        { int off[17]; moe_offsets(cnt, off);
          for (int idx = tid; idx < 13 * 256; idx += 512) { const int ui = idx >> 8, r = idx & 255; const long Lu = (long)ui * G + vcu;
              if (Lu < (long)ntile * 4) { const int pm = (int)(Lu >> 2); const int e = tile_e[pm]; int base = 0, ce = 0;
#pragma unroll
                  for (int q = 0; q < 16; ++q) { base = (q == e) ? off[q] : base; ce = (q == e) ? (int)cnt[64 * q] : ce; }
                  const int lr = pm * 256 - base + r; rowtok[idx] = (lr < ce) ? list[(size_t)e * NT + lr] : 0; } } }
        __syncthreads();
        pg8::Gemm g{HB, WT_GU + (size_t)layer * 16 * 1024 * 1024, 1024, 1024, 1024};
        pg8::MoeOrder S{tile_e, ntile, 4, G, vcu, 1024, 1024, (long)1024 * 1024}; pg8::EpiSwiGLU E{ACT, DEXP};
        pg8::gemm_phase<pg8::EpiSwiGLU, pg8::MoeOrder, true, true>(L, g, S, E, rowtok);
    }
    PH_END(8 + pb)
    PH_BEGIN(9 + pb) {
        LAS unsigned char* tile_e = L + MISC_OFF + 1024;
        if (tid < 64) { int off[17]; const int ntile = moe_offsets(cnt, off);
            for (int t = lane; t < ntile; t += 64) { const int row = t * 256; int e = 0;
#pragma unroll
                for (int q = 1; q < 16; ++q) e = (row >= off[q]) ? q : e;
                tile_e[t] = (unsigned char)e; }
            if (lane == 0) MISC[4] = (unsigned)ntile; }
        __syncthreads();
        const int ntile = (int)MISC[4];
        pg8::Gemm g{ACT, WT_D + (size_t)layer * 16 * 1024 * 512, DEXP, DEXP, DEXP};
        pg8::MoeOrder S{tile_e, ntile, 4, G, vcu, DEXP, DEXP, (long)1024 * 512}; pg8::EpiStoreBf16 E{YB, DM};
        pg8::gemm_phase<pg8::EpiStoreBf16, pg8::MoeOrder, true>(L, g, S, E);
    }
    PH_END(9 + pb)
    PH_BEGIN(10 + pb) {
        if (layer == 0) ph_combine<true>(XR, rep_ ? (float*)DUMMY : XR, YB, eidx, rank, wts, cnt, INP(I_MIXN) + DM, rep_ ? ACT : HB, W);
        else ph_combine<false>(XR, rep_ ? (float*)DUMMY : XR, YB, eidx, rank, wts, cnt, nullptr, nullptr, W);
    } } } if (layer == 0) SEAM(10);

    }
#undef IN
#undef INP
#undef SEAM
#undef PH_BEGIN
#undef PH_END
}

extern "C" void kernel_launch(void* const* d_in, const int* in_sizes, int n_in, void* d_out, int out_size, void* d_ws, size_t ws_size, hipStream_t stream) {
    static int grid = 0;
    if (grid == 0) {
        if (n_in != 28 || in_sizes[0] != NT * DM || out_size != NT * DM || ws_size < WS_END) {
            fprintf(stderr, "kernel_launch: shape mismatch: n_in %d in0 %d out %d ws %zu (need >= %zu); nothing launched\n", n_in, n_in > 0 ? in_sizes[0] : -1, out_size, ws_size, (size_t)WS_END); grid = -1; return; }
        int dev = 0, cus = 0, per_cu = 0;
        if (hipGetDevice(&dev) != hipSuccess || hipDeviceGetAttribute(&cus, hipDeviceAttributeMultiprocessorCount, dev) != hipSuccess) { fprintf(stderr, "kernel_launch: device query failed\n"); grid = -1; return; }
        if (hipFuncSetAttribute((const void*)mk_fwd, hipFuncAttributeMaxDynamicSharedMemorySize, LDS_BYTES) != hipSuccess) { fprintf(stderr, "kernel_launch: hipFuncSetAttribute failed\n"); grid = -1; return; }
        if (hipOccupancyMaxActiveBlocksPerMultiprocessor(&per_cu, (const void*)mk_fwd, 512, LDS_BYTES) != hipSuccess || per_cu < 1)
            fprintf(stderr, "kernel_launch: note: occupancy query reports %d workgroups per CU\n", per_cu);
        (void)hipGetLastError();
        grid = cus;
    }
    if (grid < 0) return;
    if (hipMemsetAsync((char*)d_ws + WS_CTL, 0, CTL_ZERO_BYTES, stream) != hipSuccess) { fprintf(stderr, "kernel_launch: memset failed\n"); return; }
    Args a{};
    for (int i = 0; i < 28; ++i) a.in[i] = (const float*)d_in[i];
    a.out = (float*)d_out; a.ws = (unsigned char*)d_ws;
#if MK_ONE_LAUNCH
    a.ph_lo = 0; a.ph_hi = NPHASE;
    hipLaunchKernelGGL(mk_fwd, dim3(grid), dim3(512), LDS_BYTES, stream, a);
#else
    for (int p = 0; p < NPHASE; ++p) { a.ph_lo = p; a.ph_hi = p + 1; hipLaunchKernelGGL(mk_fwd, dim3(grid), dim3(512), LDS_BYTES, stream, a); }
#endif
    const hipError_t le = hipPeekAtLastError();
    if (le != hipSuccess) fprintf(stderr, "kernel_launch: launch failed: %s\n", hipGetErrorName(le));
}
```

```cpp
#define MK_ONE_LAUNCH 1
#define MK_GEMM 1
#define MK_ATTN 1
#define ATT_SG_ON 0
#include <hip/hip_runtime.h>
#include <cstdio>
#include <cstdint>

#ifndef MK_ONE_LAUNCH
#define MK_ONE_LAUNCH 1
#endif
#ifndef MK_GEMM
#define MK_GEMM 1
#endif
#ifndef MK_ATTN
#define MK_ATTN 1
#endif

#define GAS __attribute__((address_space(1)))
#define LAS __attribute__((address_space(3)))
typedef unsigned short bf16;
typedef short bf16x8 __attribute__((ext_vector_type(8)));
typedef short s16x4 __attribute__((ext_vector_type(4)));
typedef float f32x2 __attribute__((ext_vector_type(2)));
typedef float f32x4 __attribute__((ext_vector_type(4)));
typedef float f32x16 __attribute__((ext_vector_type(16)));
typedef unsigned u32x2 __attribute__((ext_vector_type(2)));
typedef unsigned u32x4 __attribute__((ext_vector_type(4)));

constexpr int NBATCH = 8, SEQ = 4096, NT = NBATCH * SEQ, DM = 1024;
constexpr float EPS = 1e-6f;
constexpr float LOG2E = 1.4426950408889634f;
constexpr int PROJ_LD = 1280;
constexpr int UP_LD = 1792, UP_K = 256;
constexpr int PC_LD = 1536;
constexpr int PC_QLAT = 0, PC_KVLAT = 256, PC_BQ = 384, PC_BK = 896, PC_BV = 1024, PC_KROPE = 1152;
constexpr int NEXP = 16, DEXP = 512;
constexpr int MOE_ROWS = 2 * NT + NEXP * 256;

constexpr size_t MiB = 1u << 20;
constexpr size_t WS_CTL = 0, CTL_ZERO_BYTES = 64 * 1024;
constexpr size_t WS_TAB = 1 * MiB;
constexpr size_t WS_ROUTE = 2 * MiB;
constexpr size_t WS_RS = WS_ROUTE + 1536 * 1024;
constexpr size_t WS_WAB = 4 * MiB, WS_WUP = 7 * MiB, WS_WOAB = 9 * MiB, WS_WC = 11 * MiB, WS_WOC = 14 * MiB;
constexpr size_t WS_WGU = 16 * MiB;
constexpr size_t WS_WD = 80 * MiB;
constexpr size_t WS_H = 112 * MiB;
constexpr size_t WS_R = 176 * MiB;
constexpr size_t WS_PROJ = WS_R;
constexpr size_t WS_UPO = WS_R + 80 * MiB;
constexpr size_t WS_PROJC = WS_R;
constexpr size_t WS_Y = WS_R;
constexpr size_t WS_ACT = WS_R + 136 * MiB;
constexpr size_t WS_LIST = WS_R + 204 * MiB;
constexpr size_t WS_XR = WS_R + 206 * MiB;
constexpr size_t WS_RTAB = WS_R + 270 * MiB;
constexpr size_t WS_END = WS_R + 271 * MiB;
static_assert((size_t)MOE_ROWS * 1024 * 2 <= 136 * MiB && (size_t)MOE_ROWS * 512 * 2 <= 68 * MiB, "moe buffers");
constexpr int CW_CNT = 1024;
constexpr int CW_BAR = 4096;
constexpr int TB_BIAS = 0;
constexpr int TB_CONST = 8192;
constexpr int TB_CS = 32768;

constexpr int RING_BYTES = 131072;
constexpr int MISC_OFF = RING_BYTES;
constexpr int LDS_BYTES = 163840;

__device__ __forceinline__ float bf2f(unsigned b) { return __uint_as_float(b << 16); }
__device__ __forceinline__ unsigned f2bf(float f) { unsigned u = __float_as_uint(f); return (u + 0x7fffu + ((u >> 16) & 1u)) >> 16; }
__device__ __forceinline__ unsigned pk2(float lo, float hi) { unsigned r; asm volatile("v_cvt_pk_bf16_f32 %0, %1, %2" : "=v"(r) : "v"(lo), "v"(hi)); return r; }
__device__ __forceinline__ float wave_sum(float v) {
#pragma unroll
    for (int o = 1; o < 64; o <<= 1) v += __shfl_xor(v, o);
    return v;
}
__device__ __forceinline__ float wave_max(float v) {
#pragma unroll
    for (int o = 1; o < 64; o <<= 1) v = fmaxf(v, __shfl_xor(v, o));
    return v;
}
#define LDS_WAIT() asm volatile("s_waitcnt lgkmcnt(0)" ::: "memory")

#define XB_TMO      128
#define XB_XCNT(j)  (256  + 64 * (j))
#define XB_XSUB(j)  (1280 + 64 * (j))
#define XB_XGEN(j)  (2304 + 64 * (j))
#define XB_TOP      3328
#define XB_TOPGEN   3392
#define XCD_BAR_WORDS 3456
#define XB_SPIN_CAP (1u << 18)
__device__ __forceinline__ unsigned xb_ld(unsigned* p)              { return __hip_atomic_load(p, __ATOMIC_RELAXED, __HIP_MEMORY_SCOPE_AGENT); }
__device__ __forceinline__ unsigned xb_add(unsigned* p, unsigned v) { return __hip_atomic_fetch_add(p, v, __ATOMIC_RELAXED, __HIP_MEMORY_SCOPE_AGENT); }
__device__ __forceinline__ unsigned xb_xcc_id() { return (unsigned)__builtin_amdgcn_s_getreg((3 << 11) | 20) & 0xFu; }
#define XB_SPIN(cond, bar) do { unsigned _sp = 0; while (cond) { __builtin_amdgcn_s_sleep(1); \
    if ((++_sp & 255u) == 0u) { if (xb_ld(&(bar)[XB_TMO])) break; if (_sp > XB_SPIN_CAP) { atomicAdd(&(bar)[XB_TMO], 1u); break; } } } } while (0)
struct XcdBarrier { unsigned* bar; unsigned x; volatile LAS unsigned* st; };
__device__ __forceinline__ XcdBarrier xcd_barrier_post(unsigned* bar, volatile LAS unsigned* st) {
    XcdBarrier b; b.bar = bar; b.x = xb_xcc_id(); b.st = st;
    if (threadIdx.x == 0) (void)xb_add(&bar[XB_XCNT(b.x)], 1u);
    return b;
}
__device__ __forceinline__ void xcd_barrier_complete(unsigned* bar, unsigned x, unsigned& nloc, unsigned& nx) {
    const unsigned G = gridDim.x * gridDim.y * gridDim.z;
    unsigned sum, cnt, mine, sp = 0u;
    for (;;) {
        sum = 0u; cnt = 0u; mine = 0u;
#pragma unroll
        for (unsigned j = 0; j < 16; ++j) { const unsigned c = xb_ld(&bar[XB_XCNT(j)]); sum += c; cnt += (c > 0u) ? 1u : 0u; mine = (j == x) ? c : mine; }
        if (sum == G) break;
        __builtin_amdgcn_s_sleep(1);
        if ((++sp & 255u) == 0u) { if (xb_ld(&bar[XB_TMO])) break; if (sp > XB_SPIN_CAP) { atomicAdd(&bar[XB_TMO], 1u); break; } }
    }
    nloc = mine > 0u ? mine : 1u; nx = cnt > 0u ? cnt : 1u;
}
__device__ __forceinline__ void xcd_barrier(const XcdBarrier& b) {
    asm volatile("s_waitcnt vmcnt(0)" ::: "memory");
    __syncthreads();
    if (threadIdx.x == 0) {
        unsigned* bar = b.bar;
        __builtin_amdgcn_s_waitcnt(0);
        unsigned nloc = b.st[0], nx = b.st[1];
        if (nloc == 0u) { xcd_barrier_complete(bar, b.x, nloc, nx); b.st[0] = nloc; b.st[1] = nx; }
        const unsigned old = xb_add(&bar[XB_XSUB(b.x)], 1u);
        const unsigned gen = old / nloc;
        if (old + 1u == (gen + 1u) * nloc) {
            __builtin_amdgcn_fence(__ATOMIC_RELEASE, "agent");
            asm volatile("s_waitcnt vmcnt(0)" ::: "memory");
            const unsigned og = xb_add(&bar[XB_TOP], 1u);
            const unsigned tg = og / nx;
            if (og + 1u == (tg + 1u) * nx) xb_add(&bar[XB_TOPGEN], 1u);
            else XB_SPIN(xb_ld(&bar[XB_TOPGEN]) == tg, bar);
            __builtin_amdgcn_fence(__ATOMIC_ACQUIRE, "agent");
            xb_add(&bar[XB_XGEN(b.x)], 1u);
            asm volatile("s_waitcnt vmcnt(0)" ::: "memory");
        } else {
            XB_SPIN(xb_ld(&bar[XB_XGEN(b.x)]) == gen, bar);
            __builtin_amdgcn_fence(__ATOMIC_ACQUIRE, "agent");
            asm volatile("s_waitcnt vmcnt(0)" ::: "memory");
        }
    }
    __syncthreads();
}
namespace pg8 {
#define PG8_LAS __attribute__((address_space(3)))
typedef unsigned short bf16_t;
constexpr int BM = 256, BK = 64, HALF = 128, HTB = HALF * BK * 2, STAGE_BYTES = 8 * HTB, NXCD = 8, WGM = 8;

__host__ __device__ __forceinline__ int lds_byte(int r, int c) { const int st = (r >> 4) * 2 + (c >> 5), rr = r & 15, cc = c & 31, ob = rr * 64 + cc * 2; return st * 1024 + (ob ^ (((ob >> 9) & 1) << 5)); }
__host__ __device__ __forceinline__ void stage_rc(int b, int& R, int& C) { const int st = b / 1024, sb = b % 1024, swz = sb ^ (((sb >> 9) & 1) << 5); R = (st >> 1) * 16 + swz / 64; C = (st & 1) * 32 + (swz % 64) / 2; }
__host__ __device__ __forceinline__ int perm32(int rho) { const int n = rho >> 4, i = rho & 15; return 8 * (i >> 2) + 4 * n + (i & 3); }

struct Unit { int pm, pn, ui; long aoff, boff; };
struct Gemm { const bf16_t* A; const bf16_t* Bt; int lda, ldb, K; };

struct StaticOrder {
    int nM, nN, nwg, G, c, lda, ldb, asplit;
    __device__ void init(int M, int N, int lda_, int ldb_, int G_, int c_, int asplit_ = 1 << 20) { nM = M / BM; nN = N / BM; nwg = nM * nN; G = G_; c = c_; lda = lda_; ldb = ldb_; asplit = asplit_; }
    __device__ bool next(int i, Unit& u) const {
        const long L = (long)i * G + c; if (L >= nwg) return false;
        int wgid = (int)L; { const int q = nwg / NXCD, r = nwg % NXCD, xcd = wgid % NXCD, off = wgid / NXCD; wgid = (xcd < r ? xcd * (q + 1) : r * (q + 1) + (xcd - r) * q) + off; }
        const int nig = WGM * nN, gid = wgid / nig, fm = gid * WGM, gsz = (nM - fm) < WGM ? (nM - fm) : WGM;
        u.pm = fm + ((wgid % nig) % gsz); u.pn = (wgid % nig) / gsz;
        u.aoff = (long)u.pm * BM * lda + (u.pn >= asplit ? 128 : 0); u.boff = (long)u.pn * BM * ldb; u.ui = i; return true;
    }
};
struct MoeOrder {
    const PG8_LAS unsigned char* tile_e; int ntile, nN, G, vc, lda, ldb; long estride;
    __device__ bool next(int i, Unit& u) const {
        const long L = (long)i * G + vc; if (L >= (long)ntile * nN) return false;
        u.pm = (int)(L / nN); u.pn = (int)(L % nN);
        const int e = tile_e[u.pm];
        u.aoff = (long)u.pm * BM * lda; u.boff = (long)e * estride + (long)u.pn * BM * ldb; u.ui = i; return true;
    }
};

#ifndef NT_STORE
#define NT_STORE 1
#endif
#ifndef NT_RES
#define NT_RES 0
#endif
#ifndef NT_HEAD
#define NT_HEAD 0
#endif
#ifndef NT_PROJ
#define NT_PROJ 0
#endif
#ifndef NT_SWIGLU
#define NT_SWIGLU 0
#endif
#define EPI_STORE16(nt_, p_, w_) do { if (nt_) __builtin_nontemporal_store((w_), (u32x4*)(p_)); else *(u32x4*)(p_) = (w_); } while (0)
struct EpiStoreBf16 {
    static constexpr bool PERM = true;
    bf16_t* O; int ldc;
    __device__ __forceinline__ void operator()(const f32x4 (&acc)[2][2][4][2], const Unit& u, int wr, int wc, int fr, int fq) const {
        const int row0 = u.pm * BM + wr * 64 + fr; const int col0 = u.pn * BM + wc * 32 + 8 * fq;
#pragma unroll
        for (int ai = 0; ai < 2; ++ai)
#pragma unroll
            for (int m = 0; m < 4; ++m) { bf16_t* rowp = O + (size_t)(row0 + ai * HALF + m * 16) * ldc + col0;
#pragma unroll
                for (int bj = 0; bj < 2; ++bj) { const f32x4 v0 = acc[ai][bj][m][0], v1 = acc[ai][bj][m][1];
                    u32x4 w; w.x = pk2(v0[0], v0[1]); w.y = pk2(v0[2], v0[3]); w.z = pk2(v1[0], v1[1]); w.w = pk2(v1[2], v1[3]);
                    EPI_STORE16(NT_STORE, rowp + bj * HALF, w); } }
    }
};
#define LO2(v_) ((f32x2){(v_)[0], (v_)[1]})
#define HI2(v_) ((f32x2){(v_)[2], (v_)[3]})
__device__ __forceinline__ float sumsq16(const f32x4 a0, const f32x4 a1, const f32x4 b0, const f32x4 b1) {
    f32x2 q = LO2(a0) * LO2(a0); q = HI2(a0) * HI2(a0) + q; q = LO2(a1) * LO2(a1) + q; q = HI2(a1) * HI2(a1) + q;
    f32x2 p = LO2(b0) * LO2(b0); p = HI2(b0) * HI2(b0) + p; p = LO2(b1) * LO2(b1) + p; p = HI2(b1) * HI2(b1) + p;
    q = q + p; return q.x + q.y;
}
__device__ __forceinline__ u32x4 scale_pack8(const f32x4 v0, const f32x4 v1, const f32x2 rs2, const f32x4 g0, const f32x4 g1) {
    const f32x2 a = (LO2(v0) * rs2) * LO2(g0), b = (HI2(v0) * rs2) * HI2(g0), c = (LO2(v1) * rs2) * LO2(g1), d = (HI2(v1) * rs2) * HI2(g1);
    u32x4 w; w.x = pk2(a.x, a.y); w.y = pk2(b.x, b.y); w.z = pk2(c.x, c.y); w.w = pk2(d.x, d.y); return w;
}
#define DPP_ROR8(old_, src_, bank_) __builtin_amdgcn_update_dpp((int)(old_), (int)(src_), 0x128, 0xf, (bank_), false)
struct EpiStoreAdj {
    static constexpr bool PERM = true; static constexpr bool ADJ = true;
    bf16_t* O; int ldc;
    __device__ __forceinline__ void operator()(const f32x4 (&acc)[2][2][4][2], const Unit& u, int wr, int wc, int fr, int fq) const {
        const int half = fr >> 3, r8 = fr & 7;
        bf16_t* base = O + (size_t)(u.pm * BM + wr * 64 + r8) * ldc + u.pn * BM + wc * 64 + half * 32 + 8 * fq;
#pragma unroll
        for (int ai = 0; ai < 2; ++ai)
#pragma unroll
            for (int m = 0; m < 4; ++m) {
                u32x4 w0, w1;
                { const f32x4 v0 = acc[ai][0][m][0], v1 = acc[ai][0][m][1]; w0.x = pk2(v0[0], v0[1]); w0.y = pk2(v0[2], v0[3]); w0.z = pk2(v1[0], v1[1]); w0.w = pk2(v1[2], v1[3]); }
                { const f32x4 v0 = acc[ai][1][m][0], v1 = acc[ai][1][m][1]; w1.x = pk2(v0[0], v0[1]); w1.y = pk2(v0[2], v0[3]); w1.z = pk2(v1[0], v1[1]); w1.w = pk2(v1[2], v1[3]); }
                u32x4 dA, dB;
                dA.x = DPP_ROR8(w0.x, w1.x, 0xc); dA.y = DPP_ROR8(w0.y, w1.y, 0xc); dA.z = DPP_ROR8(w0.z, w1.z, 0xc); dA.w = DPP_ROR8(w0.w, w1.w, 0xc);
                dB.x = DPP_ROR8(w1.x, w0.x, 0x3); dB.y = DPP_ROR8(w1.y, w0.y, 0x3); dB.z = DPP_ROR8(w1.z, w0.z, 0x3); dB.w = DPP_ROR8(w1.w, w0.w, 0x3);
                bf16_t* p = base + (size_t)(ai * HALF + m * 16) * ldc;
                EPI_STORE16(NT_STORE, p, dA); EPI_STORE16(NT_STORE, p + (size_t)8 * ldc, dB); }
    }
};
struct EpiResXB {
    static constexpr bool PERM = true;
    const float* base; bf16_t* out; int ldc;
    __device__ __forceinline__ void operator()(const f32x4 (&acc)[2][2][4][2], const Unit& u, int wr, int wc, int fr, int fq) const {
        const int row0 = u.pm * BM + wr * 64 + fr; const int col0 = u.pn * BM + wc * 32 + 8 * fq;
#pragma unroll
        for (int ai = 0; ai < 2; ++ai)
#pragma unroll
            for (int mp = 0; mp < 2; ++mp) {
                f32x4 b[2][2][2];
#pragma unroll
                for (int mm = 0; mm < 2; ++mm) { const size_t off = (size_t)(row0 + ai * HALF + (2 * mp + mm) * 16) * ldc + col0;
#pragma unroll
                    for (int bj = 0; bj < 2; ++bj) { b[mm][bj][0] = *(const f32x4*)(base + off + bj * HALF); b[mm][bj][1] = *(const f32x4*)(base + off + bj * HALF + 4); } }
                asm volatile("" ::: "memory");
#pragma unroll
                for (int mm = 0; mm < 2; ++mm) { const size_t off = (size_t)(row0 + ai * HALF + (2 * mp + mm) * 16) * ldc + col0;
#pragma unroll
                    for (int bj = 0; bj < 2; ++bj) { const f32x4 v0 = b[mm][bj][0] + acc[ai][bj][2 * mp + mm][0], v1 = b[mm][bj][1] + acc[ai][bj][2 * mp + mm][1];
                        u32x4 w; w.x = pk2(v0[0], v0[1]); w.y = pk2(v0[2], v0[3]); w.z = pk2(v1[0], v1[1]); w.w = pk2(v1[2], v1[3]);
                        EPI_STORE16(NT_RES, out + off + bj * HALF, w); } }
                asm volatile("" ::: "memory");
            }
    }
};
struct EpiResBB {
    static constexpr bool PERM = true;
    bf16_t* io; int ldc;
    __device__ __forceinline__ void operator()(const f32x4 (&acc)[2][2][4][2], const Unit& u, int wr, int wc, int fr, int fq) const {
        const int row0 = u.pm * BM + wr * 64 + fr; const int col0 = u.pn * BM + wc * 32 + 8 * fq;
#pragma unroll
        for (int ai = 0; ai < 2; ++ai) {
            u32x4 b[4][2];
#pragma unroll
            for (int m = 0; m < 4; ++m) { const size_t off = (size_t)(row0 + ai * HALF + m * 16) * ldc + col0;
#pragma unroll
                for (int bj = 0; bj < 2; ++bj) b[m][bj] = *(const u32x4*)(io + off + bj * HALF); }
            asm volatile("" ::: "memory");
#pragma unroll
            for (int m = 0; m < 4; ++m) { const size_t off = (size_t)(row0 + ai * HALF + m * 16) * ldc + col0;
#pragma unroll
                for (int bj = 0; bj < 2; ++bj) { const u32x4 x = b[m][bj]; const f32x4 a0 = acc[ai][bj][m][0], a1 = acc[ai][bj][m][1];
                    u32x4 w; w.x = pk2(bf2f(x.x & 0xffffu) + a0[0], bf2f(x.x >> 16) + a0[1]); w.y = pk2(bf2f(x.y & 0xffffu) + a0[2], bf2f(x.y >> 16) + a0[3]);
                    w.z = pk2(bf2f(x.z & 0xffffu) + a1[0], bf2f(x.z >> 16) + a1[1]); w.w = pk2(bf2f(x.w & 0xffffu) + a1[2], bf2f(x.w >> 16) + a1[3]);
                    EPI_STORE16(NT_RES, io + off + bj * HALF, w); } }
            asm volatile("" ::: "memory");
        }
    }
};
struct EpiResXBA {
    static constexpr bool PERM = true; static constexpr bool ADJ = true;
    const float* base; bf16_t* out; int ldc;
    __device__ __forceinline__ void operator()(const f32x4 (&acc)[2][2][4][2], const Unit& u, int wr, int wc, int fr, int fq) const {
        const int half = fr >> 3, r8 = fr & 7;
        const size_t lo = (size_t)(u.pm * BM + wr * 64 + fr) * ldc + u.pn * BM + wc * 64 + 8 * fq;
        const size_t so = (size_t)(u.pm * BM + wr * 64 + r8) * ldc + u.pn * BM + wc * 64 + half * 32 + 8 * fq;
#pragma unroll
        for (int ai = 0; ai < 2; ++ai)
#pragma unroll
            for (int mp = 0; mp < 2; ++mp) {
                f32x4 b[2][2][2];
#pragma unroll
                for (int mm = 0; mm < 2; ++mm) { const size_t off = lo + (size_t)(ai * HALF + (2 * mp + mm) * 16) * ldc;
#pragma unroll
                    for (int bj = 0; bj < 2; ++bj) { b[mm][bj][0] = *(const f32x4*)(base + off + bj * 32); b[mm][bj][1] = *(const f32x4*)(base + off + bj * 32 + 4); } }
                asm volatile("" ::: "memory");
#pragma unroll
                for (int mm = 0; mm < 2; ++mm) { const int m = 2 * mp + mm; u32x4 w[2];
#pragma unroll
                    for (int bj = 0; bj < 2; ++bj) { const f32x4 v0 = b[mm][bj][0] + acc[ai][bj][m][0], v1 = b[mm][bj][1] + acc[ai][bj][m][1];
                        w[bj].x = pk2(v0[0], v0[1]); w[bj].y = pk2(v0[2], v0[3]); w[bj].z = pk2(v1[0], v1[1]); w[bj].w = pk2(v1[2], v1[3]); }
                    u32x4 dA, dB;
                    dA.x = DPP_ROR8(w[0].x, w[1].x, 0xc); dA.y = DPP_ROR8(w[0].y, w[1].y, 0xc); dA.z = DPP_ROR8(w[0].z, w[1].z, 0xc); dA.w = DPP_ROR8(w[0].w, w[1].w, 0xc);
                    dB.x = DPP_ROR8(w[1].x, w[0].x, 0x3); dB.y = DPP_ROR8(w[1].y, w[0].y, 0x3); dB.z = DPP_ROR8(w[1].z, w[0].z, 0x3); dB.w = DPP_ROR8(w[1].w, w[0].w, 0x3);
                    bf16_t* p = out + so + (size_t)(ai * HALF + m * 16) * ldc;
                    EPI_STORE16(NT_RES, p, dA); EPI_STORE16(NT_RES, p + (size_t)8 * ldc, dB); }
                asm volatile("" ::: "memory");
            }
    }
};
struct EpiResBBA {
    static constexpr bool PERM = true; static constexpr bool ADJ = true;
    bf16_t* io; int ldc;
    __device__ __forceinline__ void operator()(const f32x4 (&acc)[2][2][4][2], const Unit& u, int wr, int wc, int fr, int fq) const {
        const int half = fr >> 3, r8 = fr & 7;
        const size_t lo = (size_t)(u.pm * BM + wr * 64 + fr) * ldc + u.pn * BM + wc * 64 + 8 * fq;
        const size_t so = (size_t)(u.pm * BM + wr * 64 + r8) * ldc + u.pn * BM + wc * 64 + half * 32 + 8 * fq;
#pragma unroll
        for (int ai = 0; ai < 2; ++ai) {
            u32x4 b[4][2];
#pragma unroll
            for (int m = 0; m < 4; ++m) { const size_t off = lo + (size_t)(ai * HALF + m * 16) * ldc;
#pragma unroll
                for (int bj = 0; bj < 2; ++bj) b[m][bj] = *(const u32x4*)(io + off + bj * 32); }
            asm volatile("s_waitcnt vmcnt(0)" ::: "memory");
#pragma unroll
            for (int m = 0; m < 4; ++m) { u32x4 w[2];
#pragma unroll
                for (int bj = 0; bj < 2; ++bj) { const u32x4 x = b[m][bj]; const f32x4 a0 = acc[ai][bj][m][0], a1 = acc[ai][bj][m][1];
                    w[bj].x = pk2(bf2f(x.x & 0xffffu) + a0[0], bf2f(x.x >> 16) + a0[1]); w[bj].y = pk2(bf2f(x.y & 0xffffu) + a0[2], bf2f(x.y >> 16) + a0[3]);
                    w[bj].z = pk2(bf2f(x.z & 0xffffu) + a1[0], bf2f(x.z >> 16) + a1[1]); w[bj].w = pk2(bf2f(x.w & 0xffffu) + a1[2], bf2f(x.w >> 16) + a1[3]); }
                u32x4 dA, dB;
                dA.x = DPP_ROR8(w[0].x, w[1].x, 0xc); dA.y = DPP_ROR8(w[0].y, w[1].y, 0xc); dA.z = DPP_ROR8(w[0].z, w[1].z, 0xc); dA.w = DPP_ROR8(w[0].w, w[1].w, 0xc);
                dB.x = DPP_ROR8(w[1].x, w[0].x, 0x3); dB.y = DPP_ROR8(w[1].y, w[0].y, 0x3); dB.z = DPP_ROR8(w[1].z, w[0].z, 0x3); dB.w = DPP_ROR8(w[1].w, w[0].w, 0x3);
                bf16_t* p = io + so + (size_t)(ai * HALF + m * 16) * ldc;
                EPI_STORE16(NT_RES, p, dA); EPI_STORE16(NT_RES, p + (size_t)8 * ldc, dB); }
            asm volatile("" ::: "memory");
        }
    }
};
struct EpiHeadNorm {
    static constexpr bool PERM = true;
    bf16_t* O; int ldc; const float* qg; const float* kg; float qscale; PG8_LAS float* xch; float eps; int nq, nk;
    const float* rowrs;
    __device__ __forceinline__ void operator()(const f32x4 (&acc)[2][2][4][2], const Unit& u, int wr, int wc, int fr, int fq) const {
        const int row0 = u.pm * BM + wr * 64 + fr; const int col0 = u.pn * BM + wc * 32 + 8 * fq;
        if (u.pn >= nk) {
#pragma unroll
            for (int ai = 0; ai < 2; ++ai)
#pragma unroll
                for (int m = 0; m < 4; ++m) { bf16_t* rowp = O + (size_t)(row0 + ai * HALF + m * 16) * ldc + col0; const float r = rowrs ? rowrs[row0 + ai * HALF + m * 16] : 1.0f;
#pragma unroll
                    for (int bj = 0; bj < 2; ++bj) { const f32x4 v0 = acc[ai][bj][m][0], v1 = acc[ai][bj][m][1];
                        u32x4 w; w.x = pk2(v0[0] * r, v0[1] * r); w.y = pk2(v0[2] * r, v0[3] * r); w.z = pk2(v1[0] * r, v1[1] * r); w.w = pk2(v1[2] * r, v1[3] * r);
                        EPI_STORE16(NT_HEAD, rowp + bj * HALF, w); } }
            return;
        }
        const float* gp = (u.pn < nq ? qg : kg) + 32 * (wc & 1) + 8 * fq; const float sc = u.pn < nq ? qscale : 1.0f;
        const f32x4 g0 = *(const f32x4*)gp, g1 = *(const f32x4*)(gp + 4);
        float ss[2][4][2];
#pragma unroll
        for (int ai = 0; ai < 2; ++ai)
#pragma unroll
            for (int m = 0; m < 4; ++m) { const float r = rowrs ? rowrs[row0 + ai * HALF + m * 16] : 1.0f;
#pragma unroll
                for (int bj = 0; bj < 2; ++bj) { const f32x4 a = acc[ai][bj][m][0], b = acc[ai][bj][m][1];
                    float s = (a[0] * a[0] + a[1] * a[1]) + (a[2] * a[2] + a[3] * a[3]) + (b[0] * b[0] + b[1] * b[1]) + (b[2] * b[2] + b[3] * b[3]);
                    s += __shfl_xor(s, 16); s += __shfl_xor(s, 32);
                    s *= r * r;
                    ss[ai][m][bj] = s;
                    if (fq == 0) xch[((ai * HALF + wr * 64 + m * 16 + fr) * 2 + bj) * 4 + wc] = s; } }
        asm volatile("s_waitcnt lgkmcnt(0)" ::: "memory"); __builtin_amdgcn_s_barrier(); asm volatile("" ::: "memory");
#pragma unroll
        for (int ai = 0; ai < 2; ++ai)
#pragma unroll
            for (int m = 0; m < 4; ++m) { bf16_t* rowp = O + (size_t)(row0 + ai * HALF + m * 16) * ldc + col0; const float r = rowrs ? rowrs[row0 + ai * HALF + m * 16] : 1.0f;
#pragma unroll
                for (int bj = 0; bj < 2; ++bj) { const float tot = ss[ai][m][bj] + xch[((ai * HALF + wr * 64 + m * 16 + fr) * 2 + bj) * 4 + (wc ^ 1)];
                    const float rs = r * sc / sqrtf(tot * (1.0f / 64) + eps);
                    const f32x4 v0 = acc[ai][bj][m][0], v1 = acc[ai][bj][m][1];
                    u32x4 w; w.x = pk2(v0[0] * rs * g0[0], v0[1] * rs * g0[1]); w.y = pk2(v0[2] * rs * g0[2], v0[3] * rs * g0[3]);
                    w.z = pk2(v1[0] * rs * g1[0], v1[1] * rs * g1[1]); w.w = pk2(v1[2] * rs * g1[2], v1[3] * rs * g1[3]);
                    EPI_STORE16(NT_HEAD, rowp + bj * HALF, w); } }
        asm volatile("s_waitcnt lgkmcnt(0)" ::: "memory"); __builtin_amdgcn_s_barrier(); asm volatile("" ::: "memory");
    }
};
struct EpiHeadNormA {
    static constexpr bool PERM = true; static constexpr bool ADJ = true;
    bf16_t* O; int ldc; const float* qg; const float* kg; float qscale; float eps; int nq, nk;
    const float* rowrs;
    __device__ __forceinline__ void operator()(const f32x4 (&acc)[2][2][4][2], const Unit& u, int wr, int wc, int fr, int fq) const {
        const int half = fr >> 3, r8 = fr & 7; const int rowb = u.pm * BM + wr * 64;
        bf16_t* base = O + (size_t)(rowb + r8) * ldc + u.pn * BM + wc * 64 + half * 32 + 8 * fq;
        const bool plain = u.pn >= nk;
        const float* gp = (u.pn < nq ? qg : kg) + 8 * fq; const float sc = u.pn < nq ? qscale : 1.0f;
        f32x4 g00 = {1.f, 1.f, 1.f, 1.f}, g01 = g00, g10 = g00, g11 = g00;
        if (!plain) { g00 = *(const f32x4*)gp; g01 = *(const f32x4*)(gp + 4); g10 = *(const f32x4*)(gp + 32); g11 = *(const f32x4*)(gp + 36); }
#pragma unroll
        for (int ai = 0; ai < 2; ++ai)
#pragma unroll
            for (int m = 0; m < 4; ++m) {
                const float r = rowrs ? rowrs[rowb + ai * HALF + m * 16 + fr] : 1.0f;
                const f32x4 a0 = acc[ai][0][m][0], a1 = acc[ai][0][m][1], b0 = acc[ai][1][m][0], b1 = acc[ai][1][m][1];
                float s = sumsq16(a0, a1, b0, b1);
                s += __shfl_xor(s, 16); s += __shfl_xor(s, 32);
                float rs = r * sc * __builtin_amdgcn_rsqf(s * r * r * (1.0f / 64) + eps); rs = plain ? r : rs;
                const f32x2 rs2 = {rs, rs};
                const u32x4 w0 = scale_pack8(a0, a1, rs2, g00, g01), w1 = scale_pack8(b0, b1, rs2, g10, g11);
                u32x4 dA, dB;
                dA.x = DPP_ROR8(w0.x, w1.x, 0xc); dA.y = DPP_ROR8(w0.y, w1.y, 0xc); dA.z = DPP_ROR8(w0.z, w1.z, 0xc); dA.w = DPP_ROR8(w0.w, w1.w, 0xc);
                dB.x = DPP_ROR8(w1.x, w0.x, 0x3); dB.y = DPP_ROR8(w1.y, w0.y, 0x3); dB.z = DPP_ROR8(w1.z, w0.z, 0x3); dB.w = DPP_ROR8(w1.w, w0.w, 0x3);
                bf16_t* p = base + (size_t)(ai * HALF + m * 16) * ldc;
                EPI_STORE16(NT_HEAD, p, dA); EPI_STORE16(NT_HEAD, p + (size_t)8 * ldc, dB); }
    }
};
struct EpiProjNorm {
    static constexpr bool PERM = true;
    bf16_t* O; int ldc; const float* qa; const float* kva; const float* gq; float qscale; PG8_LAS float* xch; float eps;
    __device__ __forceinline__ void operator()(const f32x4 (&acc)[2][2][4][2], const Unit& u, int wr, int wc, int fr, int fq) const {
        const int row0 = u.pm * BM + wr * 64 + fr; const int col0 = u.pn * BM + wc * 32 + 8 * fq;
        if (u.pn >= 4) {
#pragma unroll
            for (int ai = 0; ai < 2; ++ai)
#pragma unroll
                for (int m = 0; m < 4; ++m) { bf16_t* rowp = O + (size_t)(row0 + ai * HALF + m * 16) * ldc + col0;
#pragma unroll
                    for (int bj = 0; bj < 2; ++bj) { const f32x4 v0 = acc[ai][bj][m][0], v1 = acc[ai][bj][m][1];
                        u32x4 w; w.x = pk2(v0[0], v0[1]); w.y = pk2(v0[2], v0[3]); w.z = pk2(v1[0], v1[1]); w.w = pk2(v1[2], v1[3]);
                        EPI_STORE16(NT_PROJ, rowp + bj * HALF, w); } }
            return;
        }
#pragma unroll
        for (int ai = 0; ai < 2; ++ai)
#pragma unroll
            for (int m = 0; m < 4; ++m)
#pragma unroll
                for (int bj = 0; bj < 2; ++bj) { const f32x4 a = acc[ai][bj][m][0], b = acc[ai][bj][m][1];
                    float s = (a[0] * a[0] + a[1] * a[1]) + (a[2] * a[2] + a[3] * a[3]) + (b[0] * b[0] + b[1] * b[1]) + (b[2] * b[2] + b[3] * b[3]);
                    s += __shfl_xor(s, 16); s += __shfl_xor(s, 32);
                    if (fq == 0) xch[((ai * HALF + wr * 64 + m * 16 + fr) * 2 + bj) * 4 + wc] = s; }
        asm volatile("s_waitcnt lgkmcnt(0)" ::: "memory"); __builtin_amdgcn_s_barrier(); asm volatile("" ::: "memory");
#pragma unroll
        for (int bj = 0; bj < 2; ++bj) {
            const int seg = 2 * u.pn + bj; const bool plain = seg >= 7;
            const float* gp = seg < 2 ? qa + 128 * seg + 32 * wc + 8 * fq : (seg == 2 ? kva + 32 * wc + 8 * fq : gq + 32 * (wc & 1) + 8 * fq);
            f32x4 g0 = *(const f32x4*)gp, g1 = *(const f32x4*)(gp + 4);
            if (plain) { g0 = (f32x4){1.f, 1.f, 1.f, 1.f}; g1 = g0; }
            const float sc = (seg >= 3) ? qscale : 1.0f, invn = seg < 2 ? (1.0f / 256) : (seg == 2 ? (1.0f / 128) : (1.0f / 64));
#pragma unroll
            for (int ai = 0; ai < 2; ++ai)
#pragma unroll
                for (int m = 0; m < 4; ++m) { const int r = ai * HALF + wr * 64 + m * 16 + fr;
                    const f32x4 pa = *(const PG8_LAS f32x4*)(xch + (r * 2 + bj) * 4), pb = *(const PG8_LAS f32x4*)(xch + (r * 2 + (bj ^ 1)) * 4);
                    const float pair = (wc & 2) ? (pa[2] + pa[3]) : (pa[0] + pa[1]), quad = (pa[0] + pa[1]) + (pa[2] + pa[3]), all = quad + ((pb[0] + pb[1]) + (pb[2] + pb[3]));
                    const float tot = seg < 2 ? all : (seg == 2 ? quad : pair);
                    float rs = sc / sqrtf(tot * invn + eps); rs = plain ? 1.0f : rs;
                    const f32x4 v0 = acc[ai][bj][m][0], v1 = acc[ai][bj][m][1];
                    u32x4 w; w.x = pk2(v0[0] * rs * g0[0], v0[1] * rs * g0[1]); w.y = pk2(v0[2] * rs * g0[2], v0[3] * rs * g0[3]);
                    w.z = pk2(v1[0] * rs * g1[0], v1[1] * rs * g1[1]); w.w = pk2(v1[2] * rs * g1[2], v1[3] * rs * g1[3]);
                    EPI_STORE16(NT_PROJ, O + (size_t)(row0 + ai * HALF + m * 16) * ldc + col0 + bj * HALF, w); }
        }
        asm volatile("s_waitcnt lgkmcnt(0)" ::: "memory"); __builtin_amdgcn_s_barrier(); asm volatile("" ::: "memory");
    }
};
struct EpiProjNormA {
    static constexpr bool PERM = true; static constexpr bool ADJ = true;
    bf16_t* O; int ldc; const float* qa; const float* kva; const float* gq; float qscale; PG8_LAS float* xch; float eps;
    __device__ __forceinline__ void operator()(const f32x4 (&acc)[2][2][4][2], const Unit& u, int wr, int wc, int fr, int fq) const {
        const int half = fr >> 3, r8 = fr & 7;
        bf16_t* base = O + (size_t)(u.pm * BM + wr * 64 + r8) * ldc + u.pn * BM + wc * 64 + half * 32 + 8 * fq;
        const int mode = u.pn == 0 ? 3 : ((u.pn == 1 && wc < 2) ? 2 : ((u.pn == 4 || (u.pn == 3 && wc >= 2)) ? 0 : 1));
        if (u.pn < 4) {
#pragma unroll
            for (int ai = 0; ai < 2; ++ai)
#pragma unroll
                for (int m = 0; m < 4; ++m) { const f32x4 a0 = acc[ai][0][m][0], a1 = acc[ai][0][m][1], b0 = acc[ai][1][m][0], b1 = acc[ai][1][m][1];
                    float s = sumsq16(a0, a1, b0, b1);
                    s += __shfl_xor(s, 16); s += __shfl_xor(s, 32);
                    if (fq == 0) xch[(ai * HALF + wr * 64 + m * 16 + fr) * 4 + wc] = s; }
            asm volatile("s_waitcnt lgkmcnt(0)" ::: "memory"); __builtin_amdgcn_s_barrier(); asm volatile("" ::: "memory");
        }
        const float* gp = mode == 3 ? qa + 64 * wc + 8 * fq : (mode == 2 ? kva + 64 * wc + 8 * fq : gq + 8 * fq);
        f32x4 g00 = {1.f, 1.f, 1.f, 1.f}, g01 = g00, g10 = g00, g11 = g00;
        if (mode != 0) { g00 = *(const f32x4*)gp; g01 = *(const f32x4*)(gp + 4); g10 = *(const f32x4*)(gp + 32); g11 = *(const f32x4*)(gp + 36); }
        const float sc = mode == 1 ? qscale : 1.0f, invn = mode == 3 ? (1.0f / 256) : (mode == 2 ? (1.0f / 128) : (1.0f / 64));
#pragma unroll
        for (int ai = 0; ai < 2; ++ai)
#pragma unroll
            for (int m = 0; m < 4; ++m) {
                float rs = 1.0f;
                if (u.pn < 4) { const f32x4 pa = *(const PG8_LAS f32x4*)(xch + (ai * HALF + wr * 64 + m * 16 + fr) * 4);
                    const float lo2 = pa[0] + pa[1], hi2 = pa[2] + pa[3];
                    const float own = wc == 0 ? pa[0] : (wc == 1 ? pa[1] : (wc == 2 ? pa[2] : pa[3]));
                    const float tot = mode == 3 ? lo2 + hi2 : (mode == 2 ? (wc < 2 ? lo2 : hi2) : own);
                    rs = mode == 0 ? 1.0f : sc * __builtin_amdgcn_rsqf(tot * invn + eps); }
                const f32x4 a0 = acc[ai][0][m][0], a1 = acc[ai][0][m][1], b0 = acc[ai][1][m][0], b1 = acc[ai][1][m][1];
                const f32x2 rs2 = {rs, rs};
                const u32x4 w0 = scale_pack8(a0, a1, rs2, g00, g01), w1 = scale_pack8(b0, b1, rs2, g10, g11);
                u32x4 dA, dB;
                dA.x = DPP_ROR8(w0.x, w1.x, 0xc); dA.y = DPP_ROR8(w0.y, w1.y, 0xc); dA.z = DPP_ROR8(w0.z, w1.z, 0xc); dA.w = DPP_ROR8(w0.w, w1.w, 0xc);
                dB.x = DPP_ROR8(w1.x, w0.x, 0x3); dB.y = DPP_ROR8(w1.y, w0.y, 0x3); dB.z = DPP_ROR8(w1.z, w0.z, 0x3); dB.w = DPP_ROR8(w1.w, w0.w, 0x3);
                bf16_t* p = base + (size_t)(ai * HALF + m * 16) * ldc;
                EPI_STORE16(NT_PROJ, p, dA); EPI_STORE16(NT_PROJ, p + (size_t)8 * ldc, dB); }
        if (u.pn < 4) { asm volatile("s_waitcnt lgkmcnt(0)" ::: "memory"); __builtin_amdgcn_s_barrier(); asm volatile("" ::: "memory"); }
    }
};
struct EpiKvNorm {
    static constexpr bool PERM = true;
    bf16_t* O; int ldc; const float* kn; PG8_LAS float* xch; float eps;
    __device__ __forceinline__ void operator()(const f32x4 (&acc)[2][2][4][2], const Unit& u, int wr, int wc, int fr, int fq) const {
        const int row0 = u.pm * BM + wr * 64 + fr; const int col0 = u.pn * BM + wc * 32 + 8 * fq;
        float ss[2][4][2];
#pragma unroll
        for (int ai = 0; ai < 2; ++ai)
#pragma unroll
            for (int m = 0; m < 4; ++m)
#pragma unroll
                for (int bj = 0; bj < 2; ++bj) { const f32x4 a = acc[ai][bj][m][0], b = acc[ai][bj][m][1];
                    float s = (a[0] * a[0] + a[1] * a[1]) + (a[2] * a[2] + a[3] * a[3]) + (b[0] * b[0] + b[1] * b[1]) + (b[2] * b[2] + b[3] * b[3]);
                    s += __shfl_xor(s, 16); s += __shfl_xor(s, 32);
                    ss[ai][m][bj] = s;
                    if (fq == 0) xch[((ai * HALF + wr * 64 + m * 16 + fr) * 2 + bj) * 4 + wc] = s; }
        asm volatile("s_waitcnt lgkmcnt(0)" ::: "memory"); __builtin_amdgcn_s_barrier(); asm volatile("" ::: "memory");
        { const bool nw = wc < 2; const float* gp = kn + 32 * (wc & 1) + 8 * fq; f32x4 g0 = *(const f32x4*)gp, g1 = *(const f32x4*)(gp + 4);
          if (!nw) { g0 = (f32x4){1.f, 1.f, 1.f, 1.f}; g1 = g0; }
#pragma unroll
          for (int ai = 0; ai < 2; ++ai)
#pragma unroll
              for (int m = 0; m < 4; ++m) { bf16_t* rowp = O + (size_t)(row0 + ai * HALF + m * 16) * ldc + col0;
#pragma unroll
                  for (int bj = 0; bj < 2; ++bj) { const float tot = ss[ai][m][bj] + xch[((ai * HALF + wr * 64 + m * 16 + fr) * 2 + bj) * 4 + (wc ^ 1)];
                      const float rs = nw ? 1.0f / sqrtf(tot * (1.0f / 64) + eps) : 1.0f;
                      const f32x4 v0 = acc[ai][bj][m][0], v1 = acc[ai][bj][m][1];
                      u32x4 w; w.x = pk2(v0[0] * rs * g0[0], v0[1] * rs * g0[1]); w.y = pk2(v0[2] * rs * g0[2], v0[3] * rs * g0[3]);
                      w.z = pk2(v1[0] * rs * g1[0], v1[1] * rs * g1[1]); w.w = pk2(v1[2] * rs * g1[2], v1[3] * rs * g1[3]);
                      EPI_STORE16(NT_HEAD, rowp + bj * HALF, w); } } }
        asm volatile("s_waitcnt lgkmcnt(0)" ::: "memory"); __builtin_amdgcn_s_barrier(); asm volatile("" ::: "memory");
    }
};
struct EpiSwiGLU {
    static constexpr bool PERM = true;
    bf16_t* O; int ldc; const PG8_LAS float* rowrs;
    __device__ __forceinline__ void operator()(const f32x4 (&acc)[2][2][4][2], const Unit& u, int wr, int wc, int fr, int fq) const {
        const int row0 = u.pm * BM + wr * 64 + fr; const int col0 = u.pn * HALF + wc * 32 + 8 * fq;
#pragma unroll
        for (int ai = 0; ai < 2; ++ai)
#pragma unroll
            for (int m = 0; m < 4; ++m) { bf16_t* rowp = O + (size_t)(row0 + ai * HALF + m * 16) * ldc + col0;
                const float rs = rowrs[u.ui * 256 + ai * HALF + wr * 64 + m * 16 + fr];
                const float kr_ = -rs * 1.4426950408889634f, rs2_ = rs * rs; const f32x2 kr2 = {kr_, kr_}, rq2 = {rs2_, rs2_}, one2 = {1.0f, 1.0f};
                float a[8];
#pragma unroll
                for (int n = 0; n < 2; ++n)
#pragma unroll
                    for (int j = 0; j < 2; ++j) { const f32x2 g = {acc[ai][0][m][n][2 * j], acc[ai][0][m][n][2 * j + 1]}, up = {acc[ai][1][m][n][2 * j], acc[ai][1][m][n][2 * j + 1]};
                        const f32x2 t = g * kr2; f32x2 d; d.x = __builtin_amdgcn_exp2f(t.x); d.y = __builtin_amdgcn_exp2f(t.y); d = d + one2;
                        f32x2 r; r.x = __builtin_amdgcn_rcpf(d.x); r.y = __builtin_amdgcn_rcpf(d.y);
                        const f32x2 o = ((g * up) * rq2) * r; a[n * 4 + 2 * j] = o.x; a[n * 4 + 2 * j + 1] = o.y; }
                u32x4 w; w.x = pk2(a[0], a[1]); w.y = pk2(a[2], a[3]); w.z = pk2(a[4], a[5]); w.w = pk2(a[6], a[7]);
                EPI_STORE16(NT_SWIGLU, rowp, w); }
    }
};

template <class E, class = void> struct epi_adj_t { static constexpr bool v = false; };
template <class E> struct epi_adj_t<E, decltype((void)E::ADJ)> { static constexpr bool v = E::ADJ; };
template <class E> __device__ __forceinline__ constexpr bool epi_adj() { return epi_adj_t<E>::v; }
template <class Epi, class Sched, bool ALIGN_EPI, bool GATHER = false>
__device__ __forceinline__ void gemm_phase(PG8_LAS unsigned char* lds, const Gemm g, const Sched& S, const Epi& E, const PG8_LAS int* rowtok = nullptr) {
    const int tid = threadIdx.x, wid = __builtin_amdgcn_readfirstlane(tid >> 6), lane = tid & 63, wr = wid >> 2, wc = wid & 3, fr = lane & 15, fq = lane >> 4;
    const int K = g.K, nt = K / BK;
    unsigned voffA[2], voffB[2]; int RA[2], CA[2];
#pragma unroll
    for (int i = 0; i < 2; ++i) { int R, C; stage_rc(tid * 16 + i * 8192, R, C); const int Rb = epi_adj<Epi>() ? (64 * (R >> 5) + perm32(R & 31)) : (Epi::PERM ? ((R & ~31) + perm32(R & 31)) : R);
        voffA[i] = (unsigned)(R * g.lda + C) * 2u; voffB[i] = (unsigned)(Rb * g.ldb + C) * 2u; RA[i] = R; CA[i] = C; }
    unsigned gcur[2][2], gnxt[2][2];
#define PG8_GOFF(dst, u_) do { _Pragma("unroll") for (int h_ = 0; h_ < 2; ++h_) _Pragma("unroll") for (int i_ = 0; i_ < 2; ++i_) \
        dst[h_][i_] = (unsigned)(rowtok[(u_) * 256 + h_ * HALF + RA[i_]] * g.lda + CA[i_]) * 2u; } while (0)
    const char* baseA = (const char*)g.A;

    const size_t kstep = (size_t)(BK * 2);
    const size_t hstepA = (size_t)HALF * g.lda * 2, hstepB = (size_t)(epi_adj<Epi>() ? 32 : HALF) * g.ldb * 2;
    const unsigned ldsw = (unsigned)wid * 1024u;
    const int aoff = lds_byte(wr * 64 + fr, fq * 8), boff = lds_byte(wc * 32 + fr, fq * 8);
#define PG8_SA(b, h) (((b) * 2 + (h)) * HTB)
#define PG8_SB(b, h) ((4 + (b) * 2 + (h)) * HTB)
#define PG8_STAGE(bufoff, gbase, voff) do { _Pragma("unroll") for (int _i = 0; _i < 2; ++_i) \
        __builtin_amdgcn_global_load_lds((const unsigned*)((const char*)(gbase) + (voff)[_i]), (PG8_LAS unsigned*)(lds + (bufoff) + ldsw + _i * 8192), 16, 0, 0); } while (0)
#define PG8_LDA(dst, b, h) do { _Pragma("unroll") for (int m = 0; m < 4; ++m) _Pragma("unroll") for (int k = 0; k < 2; ++k) dst[m][k] = *(const PG8_LAS bf16x8*)(lds + PG8_SA(b, h) + aoff + m * 2048 + k * 1024); } while (0)
#define PG8_LDB(dst, b, h) do { _Pragma("unroll") for (int n = 0; n < 2; ++n) _Pragma("unroll") for (int k = 0; k < 2; ++k) dst[n][k] = *(const PG8_LAS bf16x8*)(lds + PG8_SB(b, h) + boff + n * 2048 + k * 1024); } while (0)
#define PG8_MMA(ai, bj, At, Bt) do { __builtin_amdgcn_s_setprio(1); _Pragma("unroll") for (int m = 0; m < 4; ++m) _Pragma("unroll") for (int n = 0; n < 2; ++n) _Pragma("unroll") for (int k = 0; k < 2; ++k) \
        acc[ai][bj][m][n] = __builtin_amdgcn_mfma_f32_16x16x32_bf16(Bt[n][k], At[m][k], acc[ai][bj][m][n], 0, 0, 0); __builtin_amdgcn_s_setprio(0); } while (0)
#define PG8_WAIT_V(n) asm volatile("s_waitcnt vmcnt(" #n ")" ::: "memory")
#define PG8_WAIT_L(n) asm volatile("s_waitcnt lgkmcnt(" #n ")" ::: "memory")
#define PG8_BAR __builtin_amdgcn_s_barrier()
#define PG8_SCHED __builtin_amdgcn_sched_barrier(0)
    Unit cur, nxt; int ui = 0;
    if (!S.next(0, cur)) return;
    f32x4 acc[2][2][4][2];
#pragma unroll
    for (int a = 0; a < 2; ++a)
#pragma unroll
        for (int b = 0; b < 2; ++b)
#pragma unroll
            for (int m = 0; m < 4; ++m)
#pragma unroll
                for (int n = 0; n < 2; ++n) acc[a][b][m][n] = (f32x4){0.f, 0.f, 0.f, 0.f};
    bf16x8 At[4][2], B0[2][2], B1[2][2];
    const char* cA = (const char*)g.A + (size_t)cur.aoff * 2; const char* cB = (const char*)g.Bt + (size_t)cur.boff * 2;
    if constexpr (GATHER) { PG8_GOFF(gcur, 0); }
    PG8_STAGE(PG8_SB(0, 0), cB, voffB); PG8_STAGE(PG8_SB(0, 1), cB + hstepB, voffB);
    if constexpr (GATHER) { PG8_STAGE(PG8_SA(0, 0), baseA, gcur[0]); PG8_STAGE(PG8_SA(0, 1), baseA, gcur[1]); } else { PG8_STAGE(PG8_SA(0, 0), cA, voffA); PG8_STAGE(PG8_SA(0, 1), cA + hstepA, voffA); }
    if (wr == 1) PG8_BAR;
    PG8_WAIT_V(2); PG8_BAR;
    PG8_STAGE(PG8_SB(1, 0), cB + kstep, voffB);
    if constexpr (GATHER) { PG8_STAGE(PG8_SA(1, 0), baseA + kstep, gcur[0]); } else { PG8_STAGE(PG8_SA(1, 0), cA + kstep, voffA); }
    PG8_STAGE(PG8_SB(1, 1), cB + hstepB + kstep, voffB);
    PG8_WAIT_V(6); PG8_BAR;
    for (;;) {
        const bool has_next = S.next(ui + 1, nxt);
        const char* nA = has_next ? (const char*)g.A + (size_t)nxt.aoff * 2 : cA; const char* nB = has_next ? (const char*)g.Bt + (size_t)nxt.boff * 2 : cB;
        if constexpr (GATHER) { if (has_next) { PG8_GOFF(gnxt, ui + 1); } else { _Pragma("unroll") for (int h_ = 0; h_ < 2; ++h_) _Pragma("unroll") for (int i_ = 0; i_ < 2; ++i_) gnxt[h_][i_] = gcur[h_][i_]; } }
        for (int t = 0; t < nt; t += 2) {
            const bool last = (t == nt - 2);
            const char* a1 = cA + (size_t)(t + 1) * kstep;
            const char* a2 = last ? nA : cA + (size_t)(t + 2) * kstep; const char* b2 = last ? nB : cB + (size_t)(t + 2) * kstep;
            const char* a3 = a2 + kstep; const char* b3 = b2 + kstep;
            unsigned gs[2][2]; size_t k2o = 0;
            if constexpr (GATHER) { _Pragma("unroll") for (int h_ = 0; h_ < 2; ++h_) _Pragma("unroll") for (int i_ = 0; i_ < 2; ++i_) gs[h_][i_] = last ? gnxt[h_][i_] : gcur[h_][i_]; k2o = last ? 0 : (size_t)(t + 2) * kstep; }
            PG8_LDB(B0, 0, 0); PG8_LDB(B1, 0, 1); PG8_SCHED; PG8_LDA(At, 0, 0); if constexpr (GATHER) { PG8_STAGE(PG8_SA(1, 1), baseA + (size_t)(t + 1) * kstep, gcur[1]); } else { PG8_STAGE(PG8_SA(1, 1), a1 + hstepA, voffA); }
            PG8_WAIT_V(8); PG8_WAIT_L(0); PG8_BAR; PG8_MMA(0, 0, At, B0); PG8_MMA(0, 1, At, B1); PG8_BAR; PG8_SCHED;
            PG8_LDA(At, 0, 1); PG8_STAGE(PG8_SB(0, 0), b2, voffB); PG8_STAGE(PG8_SB(0, 1), b2 + hstepB, voffB); if constexpr (GATHER) { PG8_STAGE(PG8_SA(0, 0), baseA + k2o, gs[0]); } else { PG8_STAGE(PG8_SA(0, 0), a2, voffA); }
            PG8_WAIT_V(8); PG8_WAIT_L(0); PG8_BAR; PG8_MMA(1, 0, At, B0); PG8_MMA(1, 1, At, B1); PG8_BAR; PG8_SCHED;
            PG8_LDB(B0, 1, 0); PG8_LDB(B1, 1, 1); PG8_SCHED; PG8_LDA(At, 1, 0); if constexpr (GATHER) { PG8_STAGE(PG8_SA(0, 1), baseA + k2o, gs[1]); } else { PG8_STAGE(PG8_SA(0, 1), a2 + hstepA, voffA); }
            PG8_WAIT_V(8); PG8_WAIT_L(0); PG8_BAR; PG8_MMA(0, 0, At, B0); PG8_MMA(0, 1, At, B1); PG8_BAR; PG8_SCHED;
            PG8_LDA(At, 1, 1); PG8_STAGE(PG8_SB(1, 0), b3, voffB); PG8_STAGE(PG8_SB(1, 1), b3 + hstepB, voffB); if constexpr (GATHER) { PG8_STAGE(PG8_SA(1, 0), baseA + k2o + kstep, gs[0]); } else { PG8_STAGE(PG8_SA(1, 0), a3, voffA); }
            PG8_WAIT_V(8); PG8_WAIT_L(0); PG8_BAR; PG8_MMA(1, 0, At, B0); PG8_MMA(1, 1, At, B1); PG8_BAR; PG8_SCHED;
        }
        if constexpr (ALIGN_EPI) { if (wr == 0) PG8_BAR; }
        E(acc, cur, wr, wc, fr, fq);
        if (!has_next) break;
#pragma unroll
        for (int a = 0; a < 2; ++a)
#pragma unroll
            for (int b = 0; b < 2; ++b)
#pragma unroll
                for (int m = 0; m < 4; ++m)
#pragma unroll
                    for (int n = 0; n < 2; ++n) acc[a][b][m][n] = (f32x4){0.f, 0.f, 0.f, 0.f};
        cur = nxt; cA = nA; cB = nB; ++ui;
        if constexpr (GATHER) { _Pragma("unroll") for (int h_ = 0; h_ < 2; ++h_) _Pragma("unroll") for (int i_ = 0; i_ < 2; ++i_) gcur[h_][i_] = gnxt[h_][i_]; }
        if constexpr (ALIGN_EPI) { if (wr == 1) PG8_BAR; }
    }
    PG8_WAIT_V(0);
    if constexpr (!ALIGN_EPI) { if (wr == 0) PG8_BAR; }
    PG8_BAR;
#undef PG8_GOFF
#undef PG8_SA
#undef PG8_SB
#undef PG8_STAGE
#undef PG8_LDA
#undef PG8_LDB
#undef PG8_MMA
#undef PG8_WAIT_V
#undef PG8_WAIT_L
#undef PG8_BAR
#undef PG8_SCHED
}
}
namespace att {
#ifndef ATT_PRIO
#define ATT_PRIO 1
#endif
constexpr int STAGE_KEYS = 128;
#ifndef ATT_PROBE
#define ATT_PROBE 0
#endif
#ifndef ATT_SG_ON
#define ATT_SG_ON 1
#endif
#ifndef ATT_SG_TRANS
#define ATT_SG_TRANS 2
#endif
#ifndef ATT_SG_VALU
#define ATT_SG_VALU 3
#endif
#ifndef ATT_SG_DSR
#define ATT_SG_DSR 2
#endif
constexpr int KVB = 64, STG = 128;
template <int DQK> struct Lay { static constexpr int NQ = DQK / 16, KP = DQK * 2 + 16, KBYTES = STG * KP; };
constexpr int VBYTES = STG * 64 * 2;
constexpr int L_K = 0;
constexpr int L_V = 53248;
constexpr int L_WS = L_V + 2 * VBYTES;
constexpr int L_OST = L_WS + 8 * 64 * 4;
constexpr int L_BT = L_OST + 8 * 4096;
constexpr int L_END = L_BT + 8192;
static_assert(2 * Lay<96>::KBYTES <= L_V && L_END <= RING_BYTES, "attention LDS map");
typedef short v4i16_t __attribute__((ext_vector_type(4)));
typedef __attribute__((address_space(3))) const char* lds_cptr;

__device__ __forceinline__ int crow(int r, int hi) { return (r & 3) + 8 * (r >> 2) + 4 * hi; }
__device__ __forceinline__ int v_st(int k, int c) { return ((k >> 3) * 2 + (c >> 5)) * 512 + ((k & 7) * 32 + (c & 31)) * 2; }
__device__ __forceinline__ int v_rd_base(int lane) { return ((lane & 3) << 3) | (((lane >> 2) & 3) << 6) | (((lane >> 4) & 1) << 5) | (((lane >> 5) & 1) << 8); }
constexpr int v_rd_off(int d0, int ks, int half) { return d0 * 512 + ks * 2048 + half * 1024; }
__device__ __forceinline__ s16x4 vtr(lds_cptr p) { return __builtin_bit_cast(s16x4, __builtin_amdgcn_ds_read_tr16_b64_v4i16((__attribute__((address_space(3))) v4i16_t*)p)); }
#define ATT_PKV(L, H) (bf16x8){L[0], L[1], L[2], L[3], H[0], H[1], H[2], H[3]}
__device__ __forceinline__ void pv_sub(f32x16 (&o)[2], lds_cptr vb, const bf16x8 (&pa)[4]) {
#pragma unroll
    for (int d0 = 0; d0 < 2; ++d0)
#pragma unroll
        for (int ks = 0; ks < 4; ++ks) { const s16x4 l = vtr(vb + v_rd_off(d0, ks, 0)), h = vtr(vb + v_rd_off(d0, ks, 1));
            o[d0] = __builtin_amdgcn_mfma_f32_32x32x16_bf16(pa[ks], ATT_PKV(l, h), o[d0], 0, 0, 0); }
}

constexpr int U16_K = 0, U16_V = 53248, U16_VP = 144, U16_VB = 128 * U16_VP, U16_WS = U16_V + 2 * U16_VB, U16_OST = U16_WS + 2048;
static_assert(U16_OST + 32768 <= RING_BYTES, "16x16 unit LDS map");
template <int DQK>
__device__ __forceinline__ void attn_unit16(const bf16* Qp, const bf16* Qrp  , int ldq, const bf16* Kn, int ldk, const bf16* Kr, int ldkr, const bf16* Vp, int ldv, bf16* Op, int ldo,
                                            int st0, int st1, float negc, char* shm, const float* qrg  , const float* tabcs, int qpos0) {
    constexpr int NKS = DQK / 32, KP = DQK * 2 + 16, KBY = 128 * KP;
    static_assert(2 * KBY <= U16_V, "K ring");
    const int tid = threadIdx.x, lane = tid & 63, i16 = lane & 15, g = lane >> 4; const int wid = __builtin_amdgcn_readfirstlane(tid >> 6);
    char* K_lds = shm + U16_K; char* V_lds = shm + U16_V;
    float* wsf = (float*)(shm + U16_WS) + wid * 64;
    bf16x8 qr[2][NKS];
#pragma unroll
    for (int qb = 0; qb < 2; ++qb) { const size_t ro = (size_t)(wid * 32 + qb * 16 + i16) * ldq + g * 8;
#pragma unroll
        for (int ks = 0; ks < NKS; ++ks) qr[qb][ks] = (DQK == 96 && ks == 2) ? *reinterpret_cast<const bf16x8*>(Qrp + ro) : *reinterpret_cast<const bf16x8*>(Qp + ro + ks * 32); }
    if constexpr (DQK == 96) { if (qrg != nullptr) {
        float gq[8]; { const f32x4 a_ = *(const f32x4*)(qrg + 8 * g), b_ = *(const f32x4*)(qrg + 8 * g + 4); gq[0] = a_[0]; gq[1] = a_[1]; gq[2] = a_[2]; gq[3] = a_[3]; gq[4] = b_[0]; gq[5] = b_[1]; gq[6] = b_[2]; gq[7] = b_[3]; }
        const float sA_ = 0.10206207261596577f * LOG2E; const bool lo_ = g < 2;
#pragma unroll
        for (int qb = 0; qb < 2; ++qb) { const int pos = qpos0 + wid * 32 + qb * 16 + i16;
            const f32x4* tp = (const f32x4*)(tabcs + ((size_t)pos * 16 + 8 * (g & 1)) * 2); const f32x4 t0 = tp[0], t1 = tp[1], t2 = tp[2], t3 = tp[3];
            const float cs[8] = {t0[0], t0[2], t1[0], t1[2], t2[0], t2[2], t3[0], t3[2]}, sn[8] = {t0[1], t0[3], t1[1], t1[3], t2[1], t2[3], t3[1], t3[3]};
            const u32x4 raw = __builtin_bit_cast(u32x4, qr[qb][2]);
            float x[8] = {bf2f(raw.x & 0xffffu), bf2f(raw.x >> 16), bf2f(raw.y & 0xffffu), bf2f(raw.y >> 16), bf2f(raw.z & 0xffffu), bf2f(raw.z >> 16), bf2f(raw.w & 0xffffu), bf2f(raw.w >> 16)};
            float ss = 0.f;
#pragma unroll
            for (int e = 0; e < 8; ++e) ss += x[e] * x[e];
            ss += __shfl_xor(ss, 16); ss += __shfl_xor(ss, 32);
            const float rs = 1.0f / sqrtf(ss * (1.0f / 32) + EPS);
            float o8[8];
#pragma unroll
            for (int e = 0; e < 8; ++e) { const float y = x[e] * rs * gq[e]; const float yp = __shfl_xor(y, 32); o8[e] = (lo_ ? (y * cs[e] - yp * sn[e]) : (y * cs[e] + yp * sn[e])) * sA_; }
            u32x4 w; w.x = pk2(o8[0], o8[1]); w.y = pk2(o8[2], o8[3]); w.z = pk2(o8[4], o8[5]); w.w = pk2(o8[6], o8[7]);
            qr[qb][2] = __builtin_bit_cast(bf16x8, w); } } }
    const int srow = tid >> 3, sc = tid & 7;
    const bf16* kn_src = Kn + (size_t)srow * ldk + sc * 8;
    const bf16* v_src = Vp + (size_t)srow * ldv + sc * 8;
    const bf16* kr_src = (DQK == 96) ? (Kr + (size_t)(tid >> 2) * ldkr + (tid & 3) * 8) : nullptr;
    const int kn_dst = srow * KP + sc * 16, kr_dst = (tid >> 2) * KP + 128 + (tid & 3) * 16, v_dst = srow * U16_VP + sc * 16;
    const char* kfr = K_lds + i16 * KP + g * 16;
    const lds_cptr vfr = (lds_cptr)(V_lds) + (4 * g + (i16 >> 2)) * U16_VP + (i16 & 3) * 8;
    bf16x8 s_kn0, s_kn1, s_kr, s_v0, s_v1;
#define U_LOAD(t) do { const size_t k0_ = (size_t)(t) * 128; s_kn0 = *reinterpret_cast<const bf16x8*>(kn_src + k0_ * ldk); s_kn1 = *reinterpret_cast<const bf16x8*>(kn_src + (k0_ + 64) * ldk); \
        s_v0 = *reinterpret_cast<const bf16x8*>(v_src + k0_ * ldv); s_v1 = *reinterpret_cast<const bf16x8*>(v_src + (k0_ + 64) * ldv); \
        if (DQK == 96) { s_kr = *reinterpret_cast<const bf16x8*>(kr_src + k0_ * ldkr); } } while (0)
#define U_WRITE(b) do { *reinterpret_cast<bf16x8*>(K_lds + (b) * KBY + kn_dst) = s_kn0; *reinterpret_cast<bf16x8*>(K_lds + (b) * KBY + 64 * KP + kn_dst) = s_kn1; \
        *reinterpret_cast<bf16x8*>(V_lds + (b) * U16_VB + v_dst) = s_v0; *reinterpret_cast<bf16x8*>(V_lds + (b) * U16_VB + 64 * U16_VP + v_dst) = s_v1; \
        if (DQK == 96) { *reinterpret_cast<bf16x8*>(K_lds + (b) * KBY + kr_dst) = s_kr; } } while (0)
    f32x4 o[2][4];
#pragma unroll
    for (int qb = 0; qb < 2; ++qb)
#pragma unroll
        for (int d = 0; d < 4; ++d) o[qb][d] = (f32x4){0.f, 0.f, 0.f, 0.f};
    float lsum0 = 0.f, lsum1 = 0.f;
    U_LOAD(st0); U_WRITE(0); __syncthreads();
#if ATT_PRIO
    if (wid >= 4) __builtin_amdgcn_s_setprio(1);
#endif
    for (int t = st0; t < st1; ++t) {
        const int cur = (t - st0) & 1;
        { const int tn_ = (t + 1 < st1) ? t + 1 : t; U_LOAD(tn_); }
#pragma unroll
        for (int sub = 0; sub < 2; ++sub) {
            f32x4 s[2][4];
#pragma unroll
            for (int qb = 0; qb < 2; ++qb)
#pragma unroll
                for (int kb = 0; kb < 4; ++kb) s[qb][kb] = (f32x4){negc, negc, negc, negc};
            { const char* kb_ = kfr + cur * KBY + (sub * 64) * KP;
#pragma unroll
              for (int ks = 0; ks < NKS; ++ks)
#pragma unroll
                  for (int kb = 0; kb < 4; ++kb) { const bf16x8 kf = *reinterpret_cast<const bf16x8*>(kb_ + kb * 16 * KP + ks * 64);
                      s[0][kb] = __builtin_amdgcn_mfma_f32_16x16x32_bf16(kf, qr[0][ks], s[0][kb], 0, 0, 0);
                      s[1][kb] = __builtin_amdgcn_mfma_f32_16x16x32_bf16(kf, qr[1][ks], s[1][kb], 0, 0, 0); } }
#pragma unroll
            for (int qb = 0; qb < 2; ++qb)
#pragma unroll
                for (int kb = 0; kb < 4; ++kb) { s[qb][kb][0] = __builtin_amdgcn_exp2f(s[qb][kb][0]); s[qb][kb][1] = __builtin_amdgcn_exp2f(s[qb][kb][1]);
                    s[qb][kb][2] = __builtin_amdgcn_exp2f(s[qb][kb][2]); s[qb][kb][3] = __builtin_amdgcn_exp2f(s[qb][kb][3]); }
            { float a0 = 0.f, a1 = 0.f;
#pragma unroll
              for (int kb = 0; kb < 4; ++kb) { a0 += (s[0][kb][0] + s[0][kb][1]) + (s[0][kb][2] + s[0][kb][3]); a1 += (s[1][kb][0] + s[1][kb][1]) + (s[1][kb][2] + s[1][kb][3]); }
              lsum0 += a0; lsum1 += a1; }
            bf16x8 pa[2][2];
#pragma unroll
            for (int qb = 0; qb < 2; ++qb)
#pragma unroll
                for (int kp = 0; kp < 2; ++kp) { u32x4 w; w.x = pk2(s[qb][2 * kp][0], s[qb][2 * kp][1]); w.y = pk2(s[qb][2 * kp][2], s[qb][2 * kp][3]);
                    w.z = pk2(s[qb][2 * kp + 1][0], s[qb][2 * kp + 1][1]); w.w = pk2(s[qb][2 * kp + 1][2], s[qb][2 * kp + 1][3]); pa[qb][kp] = *reinterpret_cast<bf16x8*>(&w); }
            { const lds_cptr vb_ = vfr + cur * U16_VB + (sub * 64) * U16_VP;
#pragma unroll
              for (int kp = 0; kp < 2; ++kp)
#pragma unroll
                  for (int d = 0; d < 4; ++d) { const s16x4 l = vtr(vb_ + (2 * kp) * 16 * U16_VP + d * 32), h = vtr(vb_ + (2 * kp + 1) * 16 * U16_VP + d * 32);
                      const bf16x8 vf = ATT_PKV(l, h);
                      o[0][d] = __builtin_amdgcn_mfma_f32_16x16x32_bf16(pa[0][kp], vf, o[0][d], 0, 0, 0);
                      o[1][d] = __builtin_amdgcn_mfma_f32_16x16x32_bf16(pa[1][kp], vf, o[1][d], 0, 0, 0); } }
        }
        U_WRITE(cur ^ 1);
        __syncthreads();
    }
#if ATT_PRIO
    __builtin_amdgcn_s_setprio(0);
#endif
#undef U_LOAD
#undef U_WRITE
    lsum0 += __shfl_xor(lsum0, 16); lsum0 += __shfl_xor(lsum0, 32); lsum1 += __shfl_xor(lsum1, 16); lsum1 += __shfl_xor(lsum1, 32);
    if (g == 0) { wsf[i16] = lsum0; wsf[16 + i16] = lsum1; }
    LDS_WAIT();
    { bf16* stg = (bf16*)(shm + U16_OST) + wid * 2048;
#pragma unroll
      for (int qb = 0; qb < 2; ++qb)
#pragma unroll
          for (int r = 0; r < 4; ++r) { const int q = 16 * qb + 4 * g + r; const float rl = __builtin_amdgcn_rcpf(wsf[q]);
#pragma unroll
              for (int d = 0; d < 4; ++d) stg[q * 64 + 16 * d + i16] = (bf16)f2bf(o[qb][d][r] * rl); }
      LDS_WAIT();
      bf16* Ow = Op + (size_t)(wid * 32) * ldo;
#pragma unroll
      for (int i = 0; i < 4; ++i) { const int row = i * 8 + (lane >> 3), ch = lane & 7; const u32x4 v = *(const u32x4*)(stg + row * 64 + ch * 8); *(u32x4*)(Ow + (size_t)row * ldo + ch * 8) = v; } }
    __syncthreads();
}

constexpr int WBT_OFF = MISC_OFF + 64, WBT_LEN = 480, WBT_ZERO = 240;
static_assert(WBT_OFF + 16 * WBT_LEN * 4 <= LDS_BYTES, "window bias tables");
__device__ __forceinline__ void win_bias_tables(char* shm, const float* gtab, float negc) {
    float* T = (float*)(shm + WBT_OFF);
    for (int i = threadIdx.x; i < 16 * WBT_LEN; i += blockDim.x) { const int hs = i / WBT_LEN, j = i - hs * WBT_LEN, h = hs >> 2, sft = hs & 3;
        T[i] = gtab[h * 512 + (j + sft - WBT_ZERO + 256)] + negc; }
}
#ifndef ATT_MSUM_A
#define ATT_MSUM_A 1
#endif
#ifndef ATT_MSUM
#define ATT_MSUM 1
#endif
#ifndef ATT_NT
#define ATT_NT 1
#endif
template <int DQK, bool WIN = false>
__device__ __forceinline__ void attn_unit16w(const bf16* Qp, const bf16* Qrp, int ldq, const bf16* Kn, int ldk, const bf16* Kr, int ldkr, const bf16* Vp, int ldv, bf16* Op, int ldo, int st0, int st1, float negc, char* shm,
                                             const float* qrg, const float* tabcs, int qpos0, const float* btab = nullptr, const float* sinkp = nullptr) {
    constexpr int NKS = DQK / 32, KP = DQK * 2 + 16, KBY = 128 * KP, NQB = 4;
    const int tid = threadIdx.x, lane = tid & 63, i16 = lane & 15, g = lane >> 4; const int wid = __builtin_amdgcn_readfirstlane(tid >> 6);
    char* K_lds = shm + U16_K; char* V_lds = shm + U16_V;
    float* wsf = (float*)(shm + U16_WS) + wid * 64;
    const int wrow = WIN ? (wid >> 2) * 64 : wid * 64, hcol = WIN ? (wid & 3) * 64 : 0;
    static_assert(!WIN || DQK == 64, "window unit");
    const int qw = qpos0 + wrow;
    const float* wbt = (const float*)(shm + WBT_OFF) + (((wid & 3) * 4 + ((-i16) & 3)) * WBT_LEN) + (4 * g - (qw + i16) + WBT_ZERO - ((-i16) & 3));
    (void)btab;
    bf16x8 qr[NQB][NKS];
#pragma unroll
    for (int qb = 0; qb < NQB; ++qb) { const size_t ro = (size_t)(wrow + qb * 16 + i16) * ldq + hcol + g * 8;
#pragma unroll
        for (int ks = 0; ks < NKS; ++ks) { const bf16x8* qp_ = (DQK == 96 && ks == 2) ? reinterpret_cast<const bf16x8*>(Qrp + ro) : reinterpret_cast<const bf16x8*>(Qp + ro + ks * 32);
            qr[qb][ks] = ATT_NT ? __builtin_nontemporal_load(qp_) : *qp_; } }
    if constexpr (DQK == 96) { if (qrg != nullptr) {
        float gq[8]; { const f32x4 a_ = *(const f32x4*)(qrg + 8 * g), b_ = *(const f32x4*)(qrg + 8 * g + 4); gq[0] = a_[0]; gq[1] = a_[1]; gq[2] = a_[2]; gq[3] = a_[3]; gq[4] = b_[0]; gq[5] = b_[1]; gq[6] = b_[2]; gq[7] = b_[3]; }
        const float sA_ = 0.10206207261596577f * LOG2E; const bool lo_ = g < 2;
#pragma unroll
        for (int qb = 0; qb < NQB; ++qb) { const int pos = qpos0 + wid * 64 + qb * 16 + i16;
            const f32x4* tp = (const f32x4*)(tabcs + ((size_t)pos * 16 + 8 * (g & 1)) * 2); const f32x4 t0 = tp[0], t1 = tp[1], t2 = tp[2], t3 = tp[3];
            const float cs[8] = {t0[0], t0[2], t1[0], t1[2], t2[0], t2[2], t3[0], t3[2]}, sn[8] = {t0[1], t0[3], t1[1], t1[3], t2[1], t2[3], t3[1], t3[3]};
            const u32x4 raw = __builtin_bit_cast(u32x4, qr[qb][2]);
            float x[8] = {bf2f(raw.x & 0xffffu), bf2f(raw.x >> 16), bf2f(raw.y & 0xffffu), bf2f(raw.y >> 16), bf2f(raw.z & 0xffffu), bf2f(raw.z >> 16), bf2f(raw.w & 0xffffu), bf2f(raw.w >> 16)};
            float ss = 0.f;
#pragma unroll
            for (int e = 0; e < 8; ++e) ss += x[e] * x[e];
            ss += __shfl_xor(ss, 16); ss += __shfl_xor(ss, 32);
            const float rs = 1.0f / sqrtf(ss * (1.0f / 32) + EPS);
            float o8[8];
#pragma unroll
            for (int e = 0; e < 8; ++e) { const float y = x[e] * rs * gq[e]; const float yp = __shfl_xor(y, 32); o8[e] = (lo_ ? (y * cs[e] - yp * sn[e]) : (y * cs[e] + yp * sn[e])) * sA_; }
            u32x4 w; w.x = pk2(o8[0], o8[1]); w.y = pk2(o8[2], o8[3]); w.z = pk2(o8[4], o8[5]); w.w = pk2(o8[6], o8[7]);
            qr[qb][2] = __builtin_bit_cast(bf16x8, w); } } }
    if constexpr (DQK == 64 && !WIN) { if (tabcs != nullptr) {
        const bool lo_ = g < 2;
#pragma unroll
        for (int qb = 0; qb < NQB; ++qb) { const int s_ = qpos0 + wid * 64 + qb * 16 + i16;
#pragma unroll
            for (int ks = 0; ks < 2; ++ks) { const int pos = ks ? (s_ & 63) : (s_ >> 6);
                const f32x4* tp = (const f32x4*)(tabcs + ((size_t)pos * 16 + 8 * (g & 1)) * 2); const f32x4 t0 = tp[0], t1 = tp[1], t2 = tp[2], t3 = tp[3];
                const float cs[8] = {t0[0], t0[2], t1[0], t1[2], t2[0], t2[2], t3[0], t3[2]}, sn[8] = {t0[1], t0[3], t1[1], t1[3], t2[1], t2[3], t3[1], t3[3]};
                const u32x4 raw = __builtin_bit_cast(u32x4, qr[qb][ks]);
                const float x[8] = {bf2f(raw.x & 0xffffu), bf2f(raw.x >> 16), bf2f(raw.y & 0xffffu), bf2f(raw.y >> 16), bf2f(raw.z & 0xffffu), bf2f(raw.z >> 16), bf2f(raw.w & 0xffffu), bf2f(raw.w >> 16)};
                float o8[8];
#pragma unroll
                for (int e = 0; e < 8; ++e) { const float yp = __shfl_xor(x[e], 32); o8[e] = lo_ ? (x[e] * cs[e] - yp * sn[e]) : (x[e] * cs[e] + yp * sn[e]); }
                u32x4 w; w.x = pk2(o8[0], o8[1]); w.y = pk2(o8[2], o8[3]); w.z = pk2(o8[4], o8[5]); w.w = pk2(o8[6], o8[7]);
                qr[qb][ks] = __builtin_bit_cast(bf16x8, w); } } } }
    const int srow = tid >> 3, sc = tid & 7;
    const bf16* kn_src = Kn + (size_t)srow * ldk + sc * 8;
    const bf16* v_src = Vp + (size_t)srow * ldv + sc * 8;
    const bf16* kr_src = (DQK == 96) ? (Kr + (size_t)(tid >> 2) * ldkr + (tid & 3) * 8) : nullptr;
    const int kn_dst = srow * KP + sc * 16, kr_dst = (tid >> 2) * KP + 128 + (tid & 3) * 16, v_dst = srow * U16_VP + sc * 16;
    const char* kfr = K_lds + i16 * KP + g * 16;
    const lds_cptr vfr = (lds_cptr)(V_lds) + (4 * g + (i16 >> 2)) * U16_VP + (i16 & 3) * 8;
    bf16x8 s_kn0, s_kr, s_v0;
#define W_LOADA(t) do { const size_t k0_ = (size_t)(t) * 128; s_kn0 = *reinterpret_cast<const bf16x8*>(kn_src + k0_ * ldk); s_v0 = *reinterpret_cast<const bf16x8*>(v_src + k0_ * ldv); \
        if (DQK == 96) { s_kr = *reinterpret_cast<const bf16x8*>(kr_src + k0_ * ldkr); } } while (0)
#define W_WRITEA(b) do { *reinterpret_cast<bf16x8*>(K_lds + (b) * KBY + kn_dst) = s_kn0; *reinterpret_cast<bf16x8*>(V_lds + (b) * U16_VB + v_dst) = s_v0; \
        if (DQK == 96) { *reinterpret_cast<bf16x8*>(K_lds + (b) * KBY + kr_dst) = s_kr; } } while (0)
#define W_LOADB(t) do { const size_t k0_ = (size_t)(t) * 128 + 64; s_kn0 = *reinterpret_cast<const bf16x8*>(kn_src + k0_ * ldk); s_v0 = *reinterpret_cast<const bf16x8*>(v_src + k0_ * ldv); } while (0)
#define W_WRITEB(b) do { *reinterpret_cast<bf16x8*>(K_lds + (b) * KBY + 64 * KP + kn_dst) = s_kn0; *reinterpret_cast<bf16x8*>(V_lds + (b) * U16_VB + 64 * U16_VP + v_dst) = s_v0; } while (0)
    f32x4 o[NQB][4];
#pragma unroll
    for (int qb = 0; qb < NQB; ++qb)
#pragma unroll
        for (int d = 0; d < 4; ++d) o[qb][d] = (f32x4){0.f, 0.f, 0.f, 0.f};
    constexpr bool MSUM = ATT_MSUM && (DQK == 64 || ATT_MSUM_A);
    float lsum[NQB] = {0.f, 0.f, 0.f, 0.f};
    f32x4 ol[NQB];
#pragma unroll
    for (int qb = 0; qb < NQB; ++qb) ol[qb] = (f32x4){0.f, 0.f, 0.f, 0.f};
    const bf16x8 ones8 = {(short)0x3F80, (short)0x3F80, (short)0x3F80, (short)0x3F80, (short)0x3F80, (short)0x3F80, (short)0x3F80, (short)0x3F80};
    W_LOADA(st0); W_WRITEA(0); W_LOADB(st0); W_WRITEB(0); __syncthreads();
#if ATT_PRIO
    if (wid >= 4) __builtin_amdgcn_s_setprio(1);
#endif
    for (int t = st0; t < st1; ++t) {
        const int cur = (t - st0) & 1;
        const int tn_ = (t + 1 < st1) ? t + 1 : t; W_LOADA(tn_);
#pragma unroll
        for (int sub = 0; sub < 2; ++sub) {
            if (sub == 1) { W_WRITEA(cur ^ 1); W_LOADB(tn_); }
            const char* kb_ = kfr + cur * KBY + (sub * 64) * KP; const lds_cptr vb_ = vfr + cur * U16_VB + (sub * 64) * U16_VP;
#pragma unroll
            for (int kp = 0; kp < 2; ++kp) {
                const int k0 = t * 128 + sub * 64 + kp * 32;
                if (WIN && !((k0 + 31 >= qw - 128) && (k0 <= qw + 191))) continue;
                f32x4 s[NQB][2];
#pragma unroll
                for (int qb = 0; qb < NQB; ++qb)
#pragma unroll
                    for (int kl = 0; kl < 2; ++kl) { if constexpr (WIN) s[qb][kl] = *reinterpret_cast<const f32x4*>(wbt + k0 + 16 * kl - 16 * qb); else s[qb][kl] = (f32x4){negc, negc, negc, negc}; }
#pragma unroll
                for (int ks = 0; ks < NKS; ++ks)
#pragma unroll
                    for (int kl = 0; kl < 2; ++kl) { const bf16x8 kf = *reinterpret_cast<const bf16x8*>(kb_ + (2 * kp + kl) * 16 * KP + ks * 64);
#pragma unroll
                        for (int qb = 0; qb < NQB; ++qb) s[qb][kl] = __builtin_amdgcn_mfma_f32_16x16x32_bf16(kf, qr[qb][ks], s[qb][kl], 0, 0, 0); }
                bf16x8 pa[NQB];
#pragma unroll
                for (int qb = 0; qb < NQB; ++qb) {
#pragma unroll
                    for (int kl = 0; kl < 2; ++kl) { s[qb][kl][0] = __builtin_amdgcn_exp2f(s[qb][kl][0]); s[qb][kl][1] = __builtin_amdgcn_exp2f(s[qb][kl][1]);
                        s[qb][kl][2] = __builtin_amdgcn_exp2f(s[qb][kl][2]); s[qb][kl][3] = __builtin_amdgcn_exp2f(s[qb][kl][3]); }
                    if constexpr (!MSUM) lsum[qb] += ((s[qb][0][0] + s[qb][0][1]) + (s[qb][0][2] + s[qb][0][3])) + ((s[qb][1][0] + s[qb][1][1]) + (s[qb][1][2] + s[qb][1][3]));
                    u32x4 w; w.x = pk2(s[qb][0][0], s[qb][0][1]); w.y = pk2(s[qb][0][2], s[qb][0][3]); w.z = pk2(s[qb][1][0], s[qb][1][1]); w.w = pk2(s[qb][1][2], s[qb][1][3]);
                    pa[qb] = *reinterpret_cast<bf16x8*>(&w); }
#pragma unroll
                for (int d = 0; d < 4; ++d) { const s16x4 l = vtr(vb_ + (2 * kp) * 16 * U16_VP + d * 32), h = vtr(vb_ + (2 * kp + 1) * 16 * U16_VP + d * 32);
                    const bf16x8 vf = ATT_PKV(l, h);
#pragma unroll
                    for (int qb = 0; qb < NQB; ++qb) o[qb][d] = __builtin_amdgcn_mfma_f32_16x16x32_bf16(pa[qb], vf, o[qb][d], 0, 0, 0); }
                if constexpr (MSUM) {
#pragma unroll
                    for (int qb = 0; qb < NQB; ++qb) ol[qb] = __builtin_amdgcn_mfma_f32_16x16x32_bf16(pa[qb], ones8, ol[qb], 0, 0, 0); }
            }
        }
        W_WRITEB(cur ^ 1);
        __syncthreads();
    }
#if ATT_PRIO
    __builtin_amdgcn_s_setprio(0);
#endif
#undef W_LOADA
#undef W_WRITEA
#undef W_LOADB
#undef W_WRITEB
    if constexpr (!MSUM) {
#pragma unroll
        for (int qb = 0; qb < NQB; ++qb) { lsum[qb] += __shfl_xor(lsum[qb], 16); lsum[qb] += __shfl_xor(lsum[qb], 32); if constexpr (WIN) lsum[qb] += __builtin_amdgcn_exp2f(sinkp[wid & 3] + negc); }
        if (g == 0) {
#pragma unroll
            for (int qb = 0; qb < NQB; ++qb) wsf[16 * qb + i16] = lsum[qb];
        }
        LDS_WAIT();
    } else if constexpr (WIN) { const float sk_ = __builtin_amdgcn_exp2f(sinkp[wid & 3] + negc);
#pragma unroll
        for (int qb = 0; qb < NQB; ++qb) { ol[qb][0] += sk_; ol[qb][1] += sk_; ol[qb][2] += sk_; ol[qb][3] += sk_; } }
    { bf16* stg = (bf16*)(shm + U16_OST) + wid * 2048;
#pragma unroll
      for (int hb = 0; hb < 2; ++hb) {
#pragma unroll
          for (int qq = 0; qq < 2; ++qq)
#pragma unroll
              for (int r = 0; r < 4; ++r) { const int qb = 2 * hb + qq; const int ql = 16 * qq + 4 * g + r; const float rl = __builtin_amdgcn_rcpf(MSUM ? ol[qb][r] : wsf[32 * hb + ql]);
#pragma unroll
                  for (int d = 0; d < 4; ++d) stg[ql * 64 + 16 * d + i16] = (bf16)f2bf(o[qb][d][r] * rl); }
          LDS_WAIT();
          bf16* Ow = Op + (size_t)(wrow + 32 * hb) * ldo + hcol;
#pragma unroll
          for (int i = 0; i < 4; ++i) { const int row = i * 8 + (lane >> 3), ch = lane & 7; const u32x4 v = *(const u32x4*)(stg + row * 64 + ch * 8); if (ATT_NT) __builtin_nontemporal_store(v, (u32x4*)(Ow + (size_t)row * ldo + ch * 8)); else *(u32x4*)(Ow + (size_t)row * ldo + ch * 8) = v; }
          LDS_WAIT(); asm volatile("" ::: "memory");
      } }
    __syncthreads();
}

template <int DQK, bool WIN>
__device__ __forceinline__ void attn_unit(const bf16* Qp, int ldq, const bf16* Kn, int ldk, const bf16* Kr, int ldkr, const bf16* Vp, int ldv, bf16* Op, int ldo,
                                          int st0, int st1, float negc, int q0, const float* btab, const float* sinkp, char* shm, unsigned long long& tsync) {
    constexpr int NQ = Lay<DQK>::NQ, KP = Lay<DQK>::KP, KBYTES = Lay<DQK>::KBYTES;
    const int tid = threadIdx.x, lane = tid & 63, r32 = lane & 31, hi = lane >> 5; const int wid = __builtin_amdgcn_readfirstlane(tid >> 6);
    char* K_lds = shm + L_K; char* V_lds = shm + L_V;
    float* wsf = (float*)(shm + L_WS) + wid * 64;
    const int wrow = WIN ? (wid >> 2) * 32 : wid * 32, hcol = WIN ? (wid & 3) * 64 : 0;
    const float* bt = (const float*)(shm + L_BT) + (WIN ? (wid & 3) * 512 : 0);
    if constexpr (WIN) { _Pragma("unroll") for (int k_ = 0; k_ < 4; ++k_) ((float*)(shm + L_BT))[tid + 512 * k_] = btab[tid + 512 * k_]; }
    bf16x8 qr[NQ];
    { const bf16* Qw = Qp + (size_t)(wrow + r32) * ldq + hcol + hi * 8;
#pragma unroll
      for (int d0 = 0; d0 < NQ; ++d0) qr[d0] = *reinterpret_cast<const bf16x8*>(Qw + d0 * 16); }
    const int srow = tid >> 3, sc = tid & 7;
    const bf16* kn_src = Kn + (size_t)srow * ldk + sc * 8;
    const bf16* v_src = Vp + (size_t)srow * ldv + sc * 8;
    const bf16* kr_src = (DQK == 96) ? (Kr + (size_t)(tid >> 2) * ldkr + (tid & 3) * 8) : nullptr;
    const int kn_dst = srow * KP + sc * 16, kr_dst = (tid >> 2) * KP + 128 + (tid & 3) * 16, v_dst = v_st(srow, sc * 8);
    const lds_cptr vb0 = (lds_cptr)(V_lds) + v_rd_base(lane);
    bf16x8 s_kn0, s_kn1, s_kr, s_v0, s_v1;
#define ATT_LOAD(t) do { const size_t k0_ = (size_t)(t) * STG; s_kn0 = *reinterpret_cast<const bf16x8*>(kn_src + k0_ * ldk); s_kn1 = *reinterpret_cast<const bf16x8*>(kn_src + (k0_ + 64) * ldk); \
        s_v0 = *reinterpret_cast<const bf16x8*>(v_src + k0_ * ldv); s_v1 = *reinterpret_cast<const bf16x8*>(v_src + (k0_ + 64) * ldv); \
        if (DQK == 96) { s_kr = *reinterpret_cast<const bf16x8*>(kr_src + k0_ * ldkr); } } while (0)
#define ATT_WRITE(b) do { *reinterpret_cast<bf16x8*>(K_lds + (b) * KBYTES + kn_dst) = s_kn0; *reinterpret_cast<bf16x8*>(K_lds + (b) * KBYTES + 64 * KP + kn_dst) = s_kn1; \
        *reinterpret_cast<bf16x8*>(V_lds + (b) * VBYTES + v_dst) = s_v0; *reinterpret_cast<bf16x8*>(V_lds + (b) * VBYTES + 8192 + v_dst) = s_v1; \
        if (DQK == 96) { *reinterpret_cast<bf16x8*>(K_lds + (b) * KBYTES + kr_dst) = s_kr; } } while (0)
    f32x16 o[2]; o[0] = f32x16{}; o[1] = f32x16{};
    float lsum = 0.f;
    const int qw = q0 + wrow;
    ATT_LOAD(st0); ATT_WRITE(0); __syncthreads();
#if ATT_PRIO
    if (wid >= 4) __builtin_amdgcn_s_setprio(1);
#endif
    for (int t = st0; t < st1; ++t) {
        const int cur = (t - st0) & 1;
        { const int tn_ = (t + 1 < st1) ? t + 1 : t; ATT_LOAD(tn_); }
#pragma unroll
        for (int sub = 0; sub < 2; ++sub) {
            bool active = true;
            if constexpr (WIN) { const int k0 = t * STG + sub * KVB; active = (k0 + 63 >= qw - 128) && (k0 <= qw + 159); }
            if (active) {
                f32x16 p0, p1;
#pragma unroll
                for (int r = 0; r < 16; ++r) { p0[r] = negc; p1[r] = negc; }
                { const char* kb = K_lds + cur * KBYTES + (sub * 64 + r32) * KP + hi * 16;
#pragma unroll
                  for (int d0 = 0; d0 < NQ; ++d0) {
                      const bf16x8 b0 = *reinterpret_cast<const bf16x8*>(kb + d0 * 32);
                      const bf16x8 b1 = *reinterpret_cast<const bf16x8*>(kb + 32 * KP + d0 * 32);
                      p0 = __builtin_amdgcn_mfma_f32_32x32x16_bf16(b0, qr[d0], p0, 0, 0, 0);
                      p1 = __builtin_amdgcn_mfma_f32_32x32x16_bf16(b1, qr[d0], p1, 0, 0, 0); } }
                if constexpr (WIN) {
                    const int base = t * STG + sub * KVB - (qw + r32) + 256 + 4 * hi;
#pragma unroll
                    for (int r = 0; r < 16; ++r) { const int ix = base + (r & 3) + 8 * (r >> 2); p0[r] += bt[ix]; p1[r] += bt[ix + 32]; }
                }
#pragma unroll
                for (int r = 0; r < 16; ++r) { p0[r] = __builtin_amdgcn_exp2f(p0[r]); p1[r] = __builtin_amdgcn_exp2f(p1[r]); }
                { float ps = 0.f;
#pragma unroll
                  for (int r = 0; r < 16; ++r) ps += p0[r] + p1[r];
                  lsum += ps; }
                bf16x8 pa[4];
                { u32x4 w;
                  w.x = pk2(p0[0], p0[1]); w.y = pk2(p0[2], p0[3]); w.z = pk2(p0[4], p0[5]); w.w = pk2(p0[6], p0[7]); pa[0] = *reinterpret_cast<bf16x8*>(&w);
                  w.x = pk2(p0[8], p0[9]); w.y = pk2(p0[10], p0[11]); w.z = pk2(p0[12], p0[13]); w.w = pk2(p0[14], p0[15]); pa[1] = *reinterpret_cast<bf16x8*>(&w);
                  w.x = pk2(p1[0], p1[1]); w.y = pk2(p1[2], p1[3]); w.z = pk2(p1[4], p1[5]); w.w = pk2(p1[6], p1[7]); pa[2] = *reinterpret_cast<bf16x8*>(&w);
                  w.x = pk2(p1[8], p1[9]); w.y = pk2(p1[10], p1[11]); w.z = pk2(p1[12], p1[13]); w.w = pk2(p1[14], p1[15]); pa[3] = *reinterpret_cast<bf16x8*>(&w); }
                pv_sub(o, vb0 + cur * VBYTES + sub * 8192, pa);
            }
        }
        if constexpr (!WIN && ATT_SG_ON) {
#pragma unroll
            for (int i_ = 0; i_ < 4 * NQ + 16; ++i_) { __builtin_amdgcn_sched_group_barrier(0x008, 1, 0); __builtin_amdgcn_sched_group_barrier(0x400, ATT_SG_TRANS, 0);
                __builtin_amdgcn_sched_group_barrier(0x002, ATT_SG_VALU, 0); __builtin_amdgcn_sched_group_barrier(0x100, ATT_SG_DSR, 0); }
        }
#if ATT_PROBE
        const unsigned long long tp0_ = __builtin_amdgcn_s_memtime();
#endif
        ATT_WRITE(cur ^ 1);
        __syncthreads();
#if ATT_PROBE
        tsync += __builtin_amdgcn_s_memtime() - tp0_;
#endif
    }
#if ATT_PRIO
    __builtin_amdgcn_s_setprio(0);
#endif
#undef ATT_LOAD
#undef ATT_WRITE
    { auto rr = __builtin_amdgcn_permlane32_swap(__float_as_uint(lsum), __float_as_uint(lsum), false, false); lsum = __uint_as_float(rr[0]) + __uint_as_float(rr[1]); }
    if constexpr (WIN) lsum += __builtin_amdgcn_exp2f(sinkp[wid & 3] + negc);
    if (hi == 0) wsf[r32] = lsum;
    LDS_WAIT();
    float rli[16];
#pragma unroll
    for (int r = 0; r < 16; ++r) rli[r] = __builtin_amdgcn_rcpf(wsf[crow(r, hi)]);
    { bf16* stg = (bf16*)(shm + L_OST) + wid * 2048;
#pragma unroll
      for (int r = 0; r < 16; ++r) { const int orow = crow(r, hi);
#pragma unroll
          for (int d0 = 0; d0 < 2; ++d0) stg[orow * 64 + d0 * 32 + r32] = (bf16)f2bf(o[d0][r] * rli[r]); }
      LDS_WAIT();
      bf16* Ow = Op + (size_t)wrow * ldo + hcol;
#pragma unroll
      for (int i = 0; i < 4; ++i) { const int row = i * 8 + (lane >> 3), ch = lane & 7; const u32x4 v = *(const u32x4*)(stg + row * 64 + ch * 8); *(u32x4*)(Ow + (size_t)row * ldo + ch * 8) = v; } }
    __syncthreads();
}
#undef ATT_PKV
}
struct WaveId { int gw, ngw, lane, wave; };

#ifndef TR_NT
#define TR_NT 1
#endif
struct TrItem { const float* src; bf16* dst; const float* gain; int ldw, ldt; };
template <int MAP>
__device__ __forceinline__ TrItem tr_seg(int it, const float* W, int ldw, int N, bf16* WT, int ldt, int roff, int dk0, const float* gain = nullptr) {
    const int nblk = N / 32, kb = it / nblk, nb = it % nblk, n0 = 32 * nb;
    int drow0;
    if (MAP == 0) drow0 = roff + n0;
    else if (MAP == 1) {
        if (n0 < 384) drow0 = n0;
        else if (n0 < 416) drow0 = PC_KROPE + (n0 - 384);
        else drow0 = n0 - 416 + PC_BQ;
    } else if (MAP == 5) { const int hh = n0 / 128, d0 = n0 % 128; drow0 = roff + (d0 < 64 ? 64 * hh + d0 : 512 + 64 * hh + (d0 - 64)); }
    else if (MAP == 4) { const int hh = n0 / 96, d0 = n0 % 96; drow0 = d0 < 64 ? 64 * hh + d0 : 512 + 32 * hh; }
    else { drow0 = (n0 >> 7) * 256 + (n0 & 127) + (MAP == 3 ? 128 : 0); }
    TrItem t; t.src = W + (size_t)(64 * kb) * ldw + n0; t.dst = WT + (size_t)drow0 * ldt + dk0 + 64 * kb; t.ldw = ldw; t.ldt = ldt; t.gain = gain ? gain + 64 * kb : nullptr; return t;
}
__device__ __forceinline__ void tr_load(const TrItem& t, float (&v)[32], int lane) {
    const float* p = t.src + (size_t)(lane >> 5) * t.ldw + (lane & 31);
#pragma unroll
    for (int i = 0; i < 32; ++i) v[i] = TR_NT ? __builtin_nontemporal_load(p + (size_t)(2 * i) * t.ldw) : p[(size_t)(2 * i) * t.ldw];
}
template <bool GAIN = false>
__device__ __forceinline__ void tr_store(const TrItem& t, const float (&v)[32], LAS float* scr, int lane) {
#pragma unroll
    for (int i = 0; i < 32; ++i) scr[(2 * i + (lane >> 5)) * 33 + (lane & 31)] = v[i];
    LDS_WAIT(); asm volatile("" ::: "memory");
    const int c = lane & 7;
    f32x4 ga = {1.f, 1.f, 1.f, 1.f}, gb = ga;
    if constexpr (GAIN) { ga = *(const f32x4*)(t.gain + 8 * c); gb = *(const f32x4*)(t.gain + 8 * c + 4); }
#pragma unroll
    for (int j = 0; j < 4; ++j) { const int n = (lane >> 3) + 8 * j; const LAS float* s = scr + (8 * c) * 33 + n;
        u32x4 o; o.x = pk2(s[0 * 33] * ga[0], s[1 * 33] * ga[1]); o.y = pk2(s[2 * 33] * ga[2], s[3 * 33] * ga[3]); o.z = pk2(s[4 * 33] * gb[0], s[5 * 33] * gb[1]); o.w = pk2(s[6 * 33] * gb[2], s[7 * 33] * gb[3]);
        if (TR_NT) __builtin_nontemporal_store(o, (u32x4*)(t.dst + (size_t)n * t.ldt + 8 * c)); else *(u32x4*)(t.dst + (size_t)n * t.ldt + 8 * c) = o; }
    LDS_WAIT(); asm volatile("" ::: "memory");
}
__device__ __forceinline__ int ilog2u(unsigned v) { return 31 - __builtin_clz(v); }
__device__ __forceinline__ int t5_bucket_dev(int rel) {
    const int n = rel < 0 ? -rel : rel; int b = rel > 0 ? 16 : 0;
    if (n < 8) return b + n;
    int large = 2 + ilog2u((unsigned)(n * n)); if (large > 15) large = 15;
    return b + large;
}
__device__ __forceinline__ float gain_absmax(const float* g, int n, int lane) { float m = 0.f; for (int i = lane; i < n; i += 64) m = fmaxf(m, fabsf(g[i])); return wave_max(m); }


__device__ __forceinline__ void unpack8(const u32x4 v, float (&x)[8]) {
    x[0] = bf2f(v.x & 0xffffu); x[1] = bf2f(v.x >> 16); x[2] = bf2f(v.y & 0xffffu); x[3] = bf2f(v.y >> 16);
    x[4] = bf2f(v.z & 0xffffu); x[5] = bf2f(v.z >> 16); x[6] = bf2f(v.w & 0xffffu); x[7] = bf2f(v.w >> 16);
}
__device__ __forceinline__ u32x4 pack8(const float (&v)[8]) { u32x4 w; w.x = pk2(v[0], v[1]); w.y = pk2(v[2], v[3]); w.z = pk2(v[4], v[5]); w.w = pk2(v[6], v[7]); return w; }
template <bool ROPE>
__device__ __forceinline__ u32x4 norm_chunk(const u32x4 raw, const float (&g)[8], int nred, float invn, float scale, bool rope, bool lo, const f32x4 (&t)[4]) {
    float x[8]; unpack8(raw, x);
    float ss = 0.f;
#pragma unroll
    for (int e = 0; e < 8; ++e) ss += x[e] * x[e];
    ss += __shfl_xor(ss, 1); ss += __shfl_xor(ss, 2);
    { const float t4 = __shfl_xor(ss, 4); ss += (nred >= 3) ? t4 : 0.f; }
    { const float t8 = __shfl_xor(ss, 8); ss += (nred >= 4) ? t8 : 0.f; }
    { const float t16 = __shfl_xor(ss, 16); ss += (nred >= 5) ? t16 : 0.f; }
    const float rstd = 1.0f / sqrtf(ss * invn + EPS);
    float o[8];
#pragma unroll
    for (int e = 0; e < 8; ++e) { const float y = x[e] * rstd * g[e];
        if (ROPE) { const float yp = __shfl_xor(y, 2); const float c = t[e >> 1][(e & 1) * 2], s = t[e >> 1][(e & 1) * 2 + 1];
            const float r = lo ? (y * c - yp * s) : (y * c + yp * s); o[e] = (rope ? r : y) * scale; }
        else o[e] = y * scale; }
    return pack8(o);
}
__device__ __forceinline__ void load8f(const float* p, float (&g)[8]) { const f32x4 a = *(const f32x4*)p, b = *(const f32x4*)(p + 4); g[0] = a.x; g[1] = a.y; g[2] = a.z; g[3] = a.w; g[4] = b.x; g[5] = b.y; g[6] = b.z; g[7] = b.w; }

__device__ __forceinline__ void ph_rmsnorm(const float* X, const float* g, bf16* H, const WaveId& w) {
    f32x4 gv[4];
#pragma unroll
    for (int j = 0; j < 4; ++j) gv[j] = ((const f32x4*)g)[w.lane + 64 * j];
    int m = w.gw; if (m >= NT) return;
    f32x4 v[4];
#pragma unroll
    for (int j = 0; j < 4; ++j) v[j] = ((const f32x4*)(X + (size_t)m * DM) + w.lane)[64 * j];
    for (; m < NT; m += w.ngw) {
        const int mn = (m + w.ngw < NT) ? m + w.ngw : m; f32x4 nv[4];
#pragma unroll
        for (int j = 0; j < 4; ++j) nv[j] = ((const f32x4*)(X + (size_t)mn * DM) + w.lane)[64 * j];
        float ss = 0.f;
#pragma unroll
        for (int j = 0; j < 4; ++j) ss += (v[j].x * v[j].x + v[j].y * v[j].y) + (v[j].z * v[j].z + v[j].w * v[j].w);
        const float rstd = 1.0f / sqrtf(wave_sum(ss) * (1.0f / DM) + EPS);
        u32x2* o = (u32x2*)(H + (size_t)m * DM) + w.lane;
#pragma unroll
        for (int j = 0; j < 4; ++j) { u32x2 q; q.x = pk2(v[j].x * rstd * gv[j].x, v[j].y * rstd * gv[j].y); q.y = pk2(v[j].z * rstd * gv[j].z, v[j].w * rstd * gv[j].w); o[64 * j] = q; }
#pragma unroll
        for (int j = 0; j < 4; ++j) v[j] = nv[j];
    }
}

__device__ __forceinline__ void ph_prep1(const bf16* PROJ, bf16* OUT, const float* qa_g, const float* kva_g, const float* gq_g, const float* gk_g, const float* kr_g, const float* tabcs  , const WaveId& w) {
    const int lane = w.lane; const float sB = 0.125f * LOG2E;
    float g0[8], g1[8], g2[8];
    load8f(lane < 32 ? qa_g + 8 * lane : (lane < 48 ? kva_g + 8 * (lane - 32) : gq_g + 8 * (lane & 7)), g0);
    load8f(lane < 48 ? gq_g + 8 * (lane & 7) : gk_g + 8 * (lane & 7), g1);
    load8f(kr_g + 8 * (lane & 3), g2);
    const int nred0 = lane < 32 ? 5 : (lane < 48 ? 4 : 3); const float invn0 = lane < 32 ? (1.0f / 256) : (lane < 48 ? (1.0f / 128) : (1.0f / 64));
    const float sc0 = lane >= 48 ? sB : 1.0f, sc1 = lane < 48 ? sB : 1.0f;
    const bool rope0 = lane >= 48, lo = !(lane & 2), k2 = (lane >= 16 && lane < 20);
    const int fi = (lane & 1) * 8, blk = (lane >> 2) & 1;
#define P1_LOAD(R, mm) do { const bf16* row_ = PROJ + (size_t)(mm) * PROJ_LD; const int s_ = (mm) & (SEQ - 1); const int pax_ = blk ? (s_ & 63) : (s_ >> 6); \
        R##c0 = *(const u32x4*)(row_ + 8 * lane); R##c1 = *(const u32x4*)(row_ + 8 * (64 + lane)); R##c2 = *(const u32x4*)(row_ + 8 * (128 + (lane & 31))); \
        const f32x4* ta_ = (const f32x4*)(tabcs + ((size_t)(k2 ? s_ : pax_) * 16 + fi) * 2); const f32x4* tb_ = (const f32x4*)(tabcs + ((size_t)pax_ * 16 + fi) * 2); \
        _Pragma("unroll") for (int k_ = 0; k_ < 4; ++k_) { R##ta[k_] = ta_[k_]; R##tb[k_] = tb_[k_]; } } while (0)
    int m = w.gw; if (m >= NT) return;
    u32x4 Cc0, Cc1, Cc2; f32x4 Cta[4], Ctb[4];
    P1_LOAD(C, m);
    for (; m < NT; m += w.ngw) {
        const int mn = (m + w.ngw < NT) ? m + w.ngw : m;
        u32x4 Nc0, Nc1, Nc2; f32x4 Nta[4], Ntb[4];
        P1_LOAD(N, mn);
        bf16* row = OUT + (size_t)m * PROJ_LD;
        const u32x4 o0 = norm_chunk<true>(Cc0, g0, nred0, invn0, sc0, rope0, lo, Cta);
        const u32x4 o1 = norm_chunk<true>(Cc1, g1, 3, 1.0f / 64, sc1, true, lo, Ctb);
        const u32x4 o2 = norm_chunk<true>(Cc2, g2, 2, 1.0f / 32, 1.0f, true, lo, Cta);
        *(u32x4*)(row + 8 * lane) = o0; *(u32x4*)(row + 8 * (64 + lane)) = o1;
        if (k2) *(u32x4*)(row + 8 * (128 + lane)) = o2;
        Cc0 = Nc0; Cc1 = Nc1; Cc2 = Nc2;
#pragma unroll
        for (int k = 0; k < 4; ++k) { Cta[k] = Nta[k]; Ctb[k] = Ntb[k]; }
    }
#undef P1_LOAD
}
__device__ __forceinline__ void ph_kside(bf16* PROJ, const float* gk_g, const float* kr_g, const float* tabcs, const WaveId& w) {
    const int lane = w.lane, l = lane & 31, hf = lane >> 5;
    const bool isk = l < 16, act = l < 20;
    float g[8]; load8f(isk ? gk_g + 8 * (l & 7) : kr_g + 8 * (l & 3), g);
    const int col = isk ? PC_BK + 8 * l : PC_KROPE + 8 * (l & 3);
    const int nred = isk ? 3 : 2; const float invn = isk ? (1.0f / 64) : (1.0f / 32);
    const bool lo = !(l & 2); const int fi = (l & 1) * 8, blk = (l >> 2) & 1;
    const int step = 2 * w.ngw;
    for (int m0 = 2 * w.gw + hf; m0 < NT; m0 += 4 * step) {
        u32x4 c[4]; f32x4 t[4][4];
#pragma unroll
        for (int j = 0; j < 4; ++j) { const int m = (m0 + j * step < NT) ? m0 + j * step : m0; const int s_ = m & (SEQ - 1); const int pos = isk ? (blk ? (s_ & 63) : (s_ >> 6)) : s_;
            c[j] = *(const u32x4*)(PROJ + (size_t)m * PROJ_LD + col);
            const f32x4* tp = (const f32x4*)(tabcs + ((size_t)pos * 16 + fi) * 2);
#pragma unroll
            for (int k = 0; k < 4; ++k) t[j][k] = tp[k]; }
#pragma unroll
        for (int j = 0; j < 4; ++j) { const int m = m0 + j * step;
            const u32x4 o = norm_chunk<true>(c[j], g, nred, invn, 1.0f, true, lo, t[j]);
            if (act && m < NT) *(u32x4*)(PROJ + (size_t)m * PROJ_LD + col) = o; }
    }
}
__device__ __forceinline__ void ph_prep2(const bf16* UPO, bf16* OUT, const float* qn_g, const float* qr_g, const float* kn_g, const float* tabcs, const WaveId& w) {
    const int lane = w.lane; const float sA = 0.10206207261596577f * LOG2E;
    float ga[8], gb[8], gc[8];
    load8f(qn_g + 8 * (lane & 7), ga); load8f(qr_g + 8 * (lane & 3), gb); load8f(kn_g + 8 * (lane & 7), gc);
    const bool lo = !(lane & 2); const int fi = (lane & 1) * 8;
    const int ca = 12 * (lane >> 3) + (lane & 7), cb = 12 * ((lane >> 2) & 7) + 8 + (lane & 3), cc = 96 + 16 * (lane >> 3) + (lane & 7);
#define P2_LOAD(R, mm) do { const bf16* row_ = UPO + (size_t)(mm) * UP_LD; const int s_ = (mm) & (SEQ - 1); \
        R##c0 = *(const u32x4*)(row_ + 8 * ca); R##c1 = *(const u32x4*)(row_ + 8 * cb); R##c2 = *(const u32x4*)(row_ + 8 * cc); \
        const f32x4* ta_ = (const f32x4*)(tabcs + ((size_t)s_ * 16 + fi) * 2); \
        _Pragma("unroll") for (int k_ = 0; k_ < 4; ++k_) R##ta[k_] = ta_[k_]; } while (0)
    int m = w.gw; if (m >= NT) return;
    u32x4 Cc0, Cc1, Cc2; f32x4 Cta[4];
    P2_LOAD(C, m);
    for (; m < NT; m += w.ngw) {
        const int mn = (m + w.ngw < NT) ? m + w.ngw : m;
        u32x4 Nc0, Nc1, Nc2; f32x4 Nta[4];
        P2_LOAD(N, mn);
        bf16* row = OUT + (size_t)m * UP_LD;
        const u32x4 o0 = norm_chunk<false>(Cc0, ga, 3, 1.0f / 64, sA, false, lo, Cta);
        const u32x4 o1 = norm_chunk<true>(Cc1, gb, 2, 1.0f / 32, sA, true, lo, Cta);
        const u32x4 o2 = norm_chunk<false>(Cc2, gc, 3, 1.0f / 64, 1.0f, false, lo, Cta);
        *(u32x4*)(row + 8 * ca) = o0; if (lane < 32) *(u32x4*)(row + 8 * cb) = o1; *(u32x4*)(row + 8 * cc) = o2;
        Cc0 = Nc0; Cc1 = Nc1; Cc2 = Nc2;
#pragma unroll
        for (int k = 0; k < 4; ++k) Cta[k] = Nta[k];
    }
#undef P2_LOAD
}
__device__ __forceinline__ void ph_prepc(const bf16* PC, bf16* OUT, const float* q_g, const float* k_g, const WaveId& w) {
    const int lane = w.lane; const float sC = 0.125f * LOG2E;
    float gq[8], gk[8]; load8f(q_g + 8 * (lane & 7), gq); load8f(k_g + 8 * (lane & 7), gk);
    const f32x4 dummy[4] = {};
#define PC_LOAD(R, mm) do { const bf16* row_ = PC + (size_t)(mm) * PC_LD; \
        R##c0 = *(const u32x4*)(row_ + 8 * lane); R##c1 = *(const u32x4*)(row_ + 8 * (64 + lane)); R##c2 = *(const u32x4*)(row_ + 8 * (128 + (lane & 31))); } while (0)
    int m = w.gw; if (m >= NT) return;
    u32x4 Cc0, Cc1, Cc2;
    PC_LOAD(C, m);
    for (; m < NT; m += w.ngw) {
        const int mn = (m + w.ngw < NT) ? m + w.ngw : m;
        u32x4 Nc0, Nc1, Nc2;
        PC_LOAD(N, mn);
        bf16* row = OUT + (size_t)m * PC_LD;
        const u32x4 o0 = norm_chunk<false>(Cc0, gq, 3, 1.0f / 64, sC, false, false, dummy);
        const u32x4 o1 = norm_chunk<false>(Cc1, gq, 3, 1.0f / 64, sC, false, false, dummy);
        const u32x4 o2 = norm_chunk<false>(Cc2, gk, 3, 1.0f / 64, 1.0f, false, false, dummy);
        *(u32x4*)(row + 8 * lane) = o0; *(u32x4*)(row + 8 * (64 + lane)) = o1; if (lane < 32) *(u32x4*)(row + 8 * (128 + lane)) = o2;
        Cc0 = Nc0; Cc1 = Nc1; Cc2 = Nc2;
    }
#undef PC_LOAD
}

__device__ __forceinline__ void build_rtab(const float* g, const float* w_group, const float* w_router, bf16* tab, int idx  ) {
    const int lane = idx & 63, ct = (idx >> 6) & 1, kk = idx >> 7, c = lane & 15, k0 = 32 * kk + 8 * (lane >> 4);
    float hi[8], lo[8];
#pragma unroll
    for (int j = 0; j < 8; ++j) { const int k = k0 + j; const float wv = (ct == 0) ? w_router[k * 16 + c] : (c < 4 ? w_group[k * 4 + c] : 0.f); const float x = wv * g[k];
        const float h = bf2f(f2bf(x)); hi[j] = h; lo[j] = x - h; }
    *(u32x4*)(tab + ((size_t)((kk * 2 + ct) * 2 + 0) * 64 + lane) * 8) = pack8(hi);
    *(u32x4*)(tab + ((size_t)((kk * 2 + ct) * 2 + 1) * 64 + lane) * 8) = pack8(lo);
}
__device__ __forceinline__ void ph_router(const bf16* XR, float* rsv, const LAS unsigned char* rtab, LAS float* scr  ,
                                          const float* b_group, const float* b_router, int* eidx, float* wts, int* rank, int* list, unsigned* cnt,
                                          LAS int* tinfo  , const WaveId& w) {
    const int lane = w.lane, tok = lane & 15, ks = lane >> 4;
    float bg[4];
#pragma unroll
    for (int i = 0; i < 4; ++i) bg[i] = b_group[i];
    int it = 0;
    for (int gi = w.gw; gi < NT / 16; gi += w.ngw, ++it) {
        const int m0 = gi * 16;
        const bf16* arow = XR + (size_t)(m0 + tok) * DM + ks * 8;
        f32x4 acc0 = {0.f, 0.f, 0.f, 0.f}, acc1 = {0.f, 0.f, 0.f, 0.f}, gram = {0.f, 0.f, 0.f, 0.f};
        bf16x8 a[8];
#pragma unroll
        for (int i = 0; i < 8; ++i) a[i] = *(const bf16x8*)(arow + 32 * i);
#pragma unroll
        for (int bt = 0; bt < 4; ++bt) {
            bf16x8 na[8];
            if (bt < 3) {
#pragma unroll
                for (int i = 0; i < 8; ++i) na[i] = *(const bf16x8*)(arow + 32 * (8 * (bt + 1) + i));
            }
#pragma unroll
            for (int i = 0; i < 8; ++i) { const int kk = 8 * bt + i; const LAS unsigned char* tb = rtab + (size_t)kk * 4096 + lane * 16;
                const bf16x8 b0h = *(const LAS bf16x8*)(tb), b0l = *(const LAS bf16x8*)(tb + 1024), b1h = *(const LAS bf16x8*)(tb + 2048), b1l = *(const LAS bf16x8*)(tb + 3072);
                acc0 = __builtin_amdgcn_mfma_f32_16x16x32_bf16(a[i], b0h, acc0, 0, 0, 0); acc0 = __builtin_amdgcn_mfma_f32_16x16x32_bf16(a[i], b0l, acc0, 0, 0, 0);
                acc1 = __builtin_amdgcn_mfma_f32_16x16x32_bf16(a[i], b1h, acc1, 0, 0, 0); acc1 = __builtin_amdgcn_mfma_f32_16x16x32_bf16(a[i], b1l, acc1, 0, 0, 0);
                gram = __builtin_amdgcn_mfma_f32_16x16x32_bf16(a[i], a[i], gram, 0, 0, 0); }
            if (bt < 3) {
#pragma unroll
                for (int i = 0; i < 8; ++i) a[i] = na[i];
            }
        }
#pragma unroll
        for (int r = 0; r < 4; ++r) { scr[(4 * ks + r) * 36 + tok] = acc0[r]; scr[(4 * ks + r) * 36 + 16 + tok] = acc1[r]; }
        if ((tok >> 2) == ks) { const int r = tok & 3; const float d = r == 0 ? gram[0] : (r == 1 ? gram[1] : (r == 2 ? gram[2] : gram[3])); scr[tok * 36 + 32] = d; }
        LDS_WAIT(); asm volatile("" ::: "memory");
        const LAS float* my = scr + tok * 36;
        const float rstd = 1.0f / sqrtf(my[32] * (1.0f / DM) + EPS);
        const float g0 = my[16] * rstd + bg[0], g1 = my[17] * rstd + bg[1], g2 = my[18] * rstd + bg[2], g3 = my[19] * rstd + bg[3];
        int gsel = 0; float gm = g0; if (g1 > gm) { gm = g1; gsel = 1; } if (g2 > gm) { gm = g2; gsel = 2; } if (g3 > gm) { gm = g3; gsel = 3; }
        const float gp = 1.0f / (expf(g0 - gm) + expf(g1 - gm) + expf(g2 - gm) + expf(g3 - gm));
        const LAS float* ml = my + 4 * gsel;
        float e0 = ml[0] * rstd, e1 = ml[1] * rstd, e2 = ml[2] * rstd, e3 = ml[3] * rstd;
        { const f32x4 bv = *(const f32x4*)(b_router + 4 * gsel); e0 += bv.x; e1 += bv.y; e2 += bv.z; e3 += bv.w; }
        int i1 = 0; float m1 = e0; if (e1 > m1) { m1 = e1; i1 = 1; } if (e2 > m1) { m1 = e2; i1 = 2; } if (e3 > m1) { m1 = e3; i1 = 3; }
        int i2 = -1; float m2 = -3.0e38f;
        if (i1 != 0 && e0 > m2) { m2 = e0; i2 = 0; } if (i1 != 1 && e1 > m2) { m2 = e1; i2 = 1; } if (i1 != 2 && e2 > m2) { m2 = e2; i2 = 2; } if (i1 != 3 && e3 > m2) { m2 = e3; i2 = 3; }
        const float t2 = expf(m2 - m1); const float w1 = gp / (1.0f + t2), w2 = gp * t2 / (1.0f + t2);
        if (lane < 16) {
            const int m = m0 + lane, ea = gsel * 4 + i1, eb = gsel * 4 + i2;
            const int la = __hip_atomic_fetch_add(tinfo + ea, 1, __ATOMIC_RELAXED, __HIP_MEMORY_SCOPE_WORKGROUP);
            const int lb = __hip_atomic_fetch_add(tinfo + eb, 1, __ATOMIC_RELAXED, __HIP_MEMORY_SCOPE_WORKGROUP);
            eidx[2 * m] = ea; eidx[2 * m + 1] = eb; wts[2 * m] = w1; wts[2 * m + 1] = w2;
            LAS int* ti = tinfo + 32 + 4 * ((it * 8 + w.wave) * 16 + lane); ti[0] = m; ti[1] = ea | (eb << 8); ti[2] = la; ti[3] = lb;
            rsv[m] = rstd;
        }
        LDS_WAIT(); asm volatile("" ::: "memory");
        LDS_WAIT(); asm volatile("" ::: "memory");
    }
    __syncthreads();
    if (threadIdx.x < 16) tinfo[16 + threadIdx.x] = (int)__hip_atomic_fetch_add(cnt + 64 * threadIdx.x, (unsigned)tinfo[threadIdx.x], __ATOMIC_RELAXED, __HIP_MEMORY_SCOPE_AGENT);
    __syncthreads();
    { const int niter = (NT / 16 - (int)blockIdx.x * 8 + w.ngw - 1) / w.ngw;
      for (int k = threadIdx.x; k < niter * 128; k += 512) { const LAS int* ti = tinfo + 32 + 4 * k; const int mm = ti[0];
          if (mm >= 0) { const int ea = ti[1] & 255, eb = ti[1] >> 8; const int ra = tinfo[16 + ea] + ti[2], rb = tinfo[16 + eb] + ti[3];
              rank[2 * mm] = ra; rank[2 * mm + 1] = rb; list[(size_t)ea * NT + ra] = mm; list[(size_t)eb * NT + rb] = mm; } } }
}
__device__ __forceinline__ int moe_offsets(const unsigned* cnt, int (&off)[17]) {
    int a = 0;
#pragma unroll
    for (int e = 0; e < 16; ++e) { off[e] = a; a += ((int)cnt[64 * e] + 255) & ~255; }
    off[16] = a; return a >> 8;
}
template <bool FINAL>
__device__ __forceinline__ void ph_combine(bf16* XR, float* OUT, const bf16* Y, const int* eidx, const int* rank, const float* wts, const unsigned* cnt, float* RS, const WaveId& w) {
    const int lane = w.lane;
    int off[17]; moe_offsets(cnt, off);
#define CB_LOAD(R, mm) do { const int e0_ = eidx[2 * (mm)], e1_ = eidx[2 * (mm) + 1]; int b0_ = 0, b1_ = 0; \
        _Pragma("unroll") for (int q_ = 0; q_ < 16; ++q_) { b0_ = (q_ == e0_) ? off[q_] : b0_; b1_ = (q_ == e1_) ? off[q_] : b1_; } \
        const int s0_ = b0_ + rank[2 * (mm)], s1_ = b1_ + rank[2 * (mm) + 1]; R##w0 = wts[2 * (mm)]; R##w1 = wts[2 * (mm) + 1]; \
        const u32x4* xr_ = (const u32x4*)(XR + (size_t)(mm) * DM) + lane; const u32x4* y0_ = (const u32x4*)(Y + (size_t)s0_ * DM) + lane; const u32x4* y1_ = (const u32x4*)(Y + (size_t)s1_ * DM) + lane; \
        _Pragma("unroll") for (int j_ = 0; j_ < 2; ++j_) { R##x[j_] = xr_[64 * j_]; R##a[j_] = y0_[64 * j_]; R##b[j_] = y1_[64 * j_]; } } while (0)
    int m = w.gw; if (m >= NT) return;
    u32x4 Cx[2], Ca[2], Cb[2]; float Cw0, Cw1;
    CB_LOAD(C, m);
    for (; m < NT; m += w.ngw) {
        const int mn = (m + w.ngw < NT) ? m + w.ngw : m;
        u32x4 Nx[2], Na[2], Nb[2]; float Nw0, Nw1;
        CB_LOAD(N, mn);
        float v[2][8]; float ss = 0.f;
#pragma unroll
        for (int j = 0; j < 2; ++j) { float x[8], a[8], b[8]; unpack8(Cx[j], x); unpack8(Ca[j], a); unpack8(Cb[j], b);
#pragma unroll
            for (int e = 0; e < 8; ++e) { v[j][e] = x[e] + Cw0 * a[e] + Cw1 * b[e]; ss += v[j][e] * v[j][e]; } }
        if (FINAL) {
#pragma unroll
            for (int j = 0; j < 2; ++j) { f32x4* o = (f32x4*)(OUT + (size_t)m * DM + 8 * (lane + 64 * j)); o[0] = (f32x4){v[j][0], v[j][1], v[j][2], v[j][3]}; o[1] = (f32x4){v[j][4], v[j][5], v[j][6], v[j][7]}; }
        } else {
            const float rstd = 1.0f / sqrtf(wave_sum(ss) * (1.0f / DM) + EPS);
#pragma unroll
            for (int j = 0; j < 2; ++j) *((u32x4*)(XR + (size_t)m * DM) + lane + 64 * j) = pack8(v[j]);
            if (lane == 0) RS[m] = rstd;
        }
#pragma unroll
        for (int j = 0; j < 2; ++j) { Cx[j] = Nx[j]; Ca[j] = Na[j]; Cb[j] = Nb[j]; }
        Cw0 = Nw0; Cw1 = Nw1;
    }
#undef CB_LOAD
}

template <int DQK, bool WIN>
__device__ __forceinline__ void naive_attn_row(const bf16* qrow, const bf16* Kn, int ldk, const bf16* Kr, int ldkr, const bf16* Vp, int ldv, bf16* orow,
                                               int qpos, const float* btab, float sinkl2, LAS float* qf  , int lane) {
    for (int d = lane; d < DQK; d += 64) qf[d] = bf2f(qrow[d]);
    LDS_WAIT(); asm volatile("" ::: "memory");
    float m = -1.0e30f, l = 0.f, o = 0.f;
    const int kbeg = WIN ? qpos - 128 : 0, nch = WIN ? 5 : SEQ / 64;
    for (int ci = 0; ci < nch; ++ci) {
        const int key = kbeg + ci * 64 + lane; const bool valid = !WIN || (key >= 0 && key < SEQ && key - qpos <= 128);
        const int kc = valid ? key : 0;
        float s = 0.f;
        { const bf16* kp = Kn + (size_t)kc * ldk;
#pragma unroll
          for (int c = 0; c < 8; ++c) { const u32x4 kv = *(const u32x4*)(kp + c * 8); const LAS float* q = qf + c * 8;
              s += q[0] * bf2f(kv.x & 0xffffu) + q[1] * bf2f(kv.x >> 16) + q[2] * bf2f(kv.y & 0xffffu) + q[3] * bf2f(kv.y >> 16) + q[4] * bf2f(kv.z & 0xffffu) + q[5] * bf2f(kv.z >> 16) + q[6] * bf2f(kv.w & 0xffffu) + q[7] * bf2f(kv.w >> 16); }
          if (DQK == 96) { const bf16* rp = Kr + (size_t)kc * ldkr;
#pragma unroll
              for (int c = 0; c < 4; ++c) { const u32x4 kv = *(const u32x4*)(rp + c * 8); const LAS float* q = qf + 64 + c * 8;
                  s += q[0] * bf2f(kv.x & 0xffffu) + q[1] * bf2f(kv.x >> 16) + q[2] * bf2f(kv.y & 0xffffu) + q[3] * bf2f(kv.y >> 16) + q[4] * bf2f(kv.z & 0xffffu) + q[5] * bf2f(kv.z >> 16) + q[6] * bf2f(kv.w & 0xffffu) + q[7] * bf2f(kv.w >> 16); } } }
        if (WIN) s = valid ? s + btab[key - qpos + 256] : -INFINITY;
        const float mn = fmaxf(m, wave_max(s)); const float p = exp2f(s - mn), al = exp2f(m - mn);
        l = l * al + wave_sum(p); o *= al; m = mn;
        const int kb = kbeg + ci * 64;
        for (int j = 0; j < 64; ++j) { const float pj = __shfl(p, j); int kk = kb + j; if (WIN) kk = (kk < 0 || kk >= SEQ) ? 0 : kk; o += pj * bf2f(Vp[(size_t)kk * ldv + lane]); }
    }
    if (WIN) { const float mn = fmaxf(m, sinkl2); const float al = exp2f(m - mn); l = l * al + exp2f(sinkl2 - mn); o *= al; }
    orow[lane] = (bf16)f2bf(o / l);
    LDS_WAIT(); asm volatile("" ::: "memory");
}
constexpr int NPHASE = 19;
#ifndef CV_BATCH
#define CV_BATCH 1
#endif
#ifndef CV_DEPHASE
#define CV_DEPHASE 1
#endif
#ifndef CV_REP
#define CV_REP 1
#endif
#ifndef UP_KV_K128
#define UP_KV_K128 1
#endif
#ifndef EPI_ALIGN
#define EPI_ALIGN false
#endif
#ifndef MK_FUSE_PREP1
#define MK_FUSE_PREP1 1
#endif
#ifndef MK_FUSE_PREP2
#define MK_FUSE_PREP2 1
#endif
#ifndef MK_FUSE_PREPC
#define MK_FUSE_PREPC 1
#endif
#ifndef ATT_WIDE_C
#define ATT_WIDE_C 1
#endif
#ifndef ATT_WIDE_A
#define ATT_WIDE_A 1
#endif
#ifndef ATT_WIDE_B
#define ATT_WIDE_B 1
#endif
#ifndef ATT_MAP
#define ATT_MAP vcu
#endif
struct Args { const float* in[28]; float* out; unsigned char* ws; int ph_lo, ph_hi; };
enum { I_X = 0, I_MIXN, I_FFNN, I_WINAB, I_QAN, I_WQUP, I_KVAN, I_WKVUP, I_QNG, I_KNG, I_QRG, I_KRG, I_GQG, I_GKG, I_WOUTAB, I_WINC, I_WQG, I_WKG, I_SINK, I_WOUTC,
       I_RELB, I_WGRP, I_BGRP, I_WRTR, I_BRTR, I_WGATE, I_WUP, I_WDOWN };

__global__ void __launch_bounds__(512, 2) mk_fwd(Args args) {
    extern __shared__ __attribute__((aligned(16))) unsigned char lds[];
    LAS unsigned char* L = (LAS unsigned char*)lds;
    const int tid = threadIdx.x, lane = tid & 63, wave = __builtin_amdgcn_readfirstlane(tid >> 6);
    const int G = gridDim.x, bx = blockIdx.x;
    const int vcu = (G % 8 == 0) ? (bx % 8) * (G / 8) + bx / 8 : bx;
    WaveId W; W.gw = bx * 8 + wave; W.ngw = G * 8; W.lane = lane; W.wave = wave;
    const __attribute__((address_space(4))) Args* argp_ = (const __attribute__((address_space(4))) Args*)__builtin_amdgcn_kernarg_segment_ptr();
#define INP(i) ({ const __attribute__((address_space(4))) Args* a_ = argp_; asm volatile("" : "+s"(a_)); (const float*)a_->in[i]; })
    unsigned char* ws = args.ws;
    unsigned* ctl = (unsigned*)(ws + WS_CTL);
    float* tab = (float*)(ws + WS_TAB);
    int* r_eidx = (int*)(ws + WS_ROUTE); float* r_wts = (float*)(ws + WS_ROUTE + 512 * 1024); int* r_slot = (int*)(ws + WS_ROUTE + 1024 * 1024);
    bf16* WT_AB = (bf16*)(ws + WS_WAB); bf16* WT_UP = (bf16*)(ws + WS_WUP); bf16* WT_OAB = (bf16*)(ws + WS_WOAB); bf16* WT_C = (bf16*)(ws + WS_WC); bf16* WT_OC = (bf16*)(ws + WS_WOC);
    bf16* WT_GU = (bf16*)(ws + WS_WGU); bf16* WT_D = (bf16*)(ws + WS_WD);
    bf16* HB = (bf16*)(ws + WS_H); bf16* PROJ = (bf16*)(ws + WS_PROJ); bf16* UPO = (bf16*)(ws + WS_UPO); bf16* PROJC = (bf16*)(ws + WS_PROJC);
    bf16* ACT = (bf16*)(ws + WS_ACT); bf16* DUMMY = (bf16*)(ws + WS_END);
    bf16* XRB = (bf16*)(ws + WS_XR);
    bf16* RTAB = (bf16*)(ws + WS_RTAB);
    volatile LAS unsigned* MISC = (volatile LAS unsigned*)(L + MISC_OFF);
    if (tid < 16) MISC[tid] = 0u;
    __syncthreads();
    const int lo = args.ph_lo, hi = args.ph_hi;
    XcdBarrier bar; bar.bar = ctl + CW_BAR; bar.x = 0; bar.st = nullptr;
    if (hi - lo > 1) bar = xcd_barrier_post(ctl + CW_BAR, MISC + 8);
#define IN(k) (lo <= (k) && (k) < hi)
#define SEAM(k) do { if (IN(k) && IN((k) + 1)) xcd_barrier(bar); } while (0)
#ifndef MK_REP_MASK
#define MK_REP_MASK 0
#endif
#ifndef MK_REP_N
#define MK_REP_N 1
#endif
#define REPS(k) (((MK_REP_MASK >> (k)) & 1) ? MK_REP_N : 1)
#define PH_BEGIN(k) if (IN(k)) { for (int rep_ = 0; rep_ < REPS(k); ++rep_) { if (rep_) xcd_barrier(bar);
#define PH_END(k) } } SEAM(k);

    constexpr int I_E5 = 256, MOE_ONLY = 3 * 32 * I_E5, I_O5 = 16 * 32, I_C5 = 16 * 48, MOE_ITEMS = MOE_ONLY + 2 * I_O5 + I_C5;
#define CV_DECODE(T, r_) do { if ((r_) >= MOE_ONLY) { const int rr = (r_) - MOE_ONLY; \
                    if (rr < I_O5) T = tr_seg<0>(rr, INP(I_WOUTAB), 1024, 1024, WT_OAB, 1024, 0, 0); \
                    else if (rr < I_O5 + I_C5) T = tr_seg<0>(rr - I_O5, INP(I_WINC), 1536, 1536, WT_C, 1024, 0, 0, INP(I_MIXN) + DM); \
                    else T = tr_seg<0>(rr - I_O5 - I_C5, INP(I_WOUTC), 1024, 1024, WT_OC, 1024, 0, 0); break; } \
                const int le = (r_) / (3 * I_E5), qq = (r_) % (3 * I_E5); \
                if (qq < I_E5) T = tr_seg<2>(qq, INP(I_WGATE) + (size_t)le * 1024 * 512, 512, 512, WT_GU + (size_t)le * 1024 * 1024, 1024, 0, 0, INP(I_FFNN) + (le >> 4) * DM); \
                else if (qq < 2 * I_E5) T = tr_seg<3>(qq - I_E5, INP(I_WUP) + (size_t)le * 1024 * 512, 512, 512, WT_GU + (size_t)le * 1024 * 1024, 1024, 0, 0, INP(I_FFNN) + (le >> 4) * DM); \
                else T = tr_seg<0>(qq - 2 * I_E5, INP(I_WDOWN) + (size_t)le * 512 * 1024, 1024, 1024, WT_D + (size_t)le * 1024 * 512, 512, 0, 0); } while (0)
#define CV_RUN(base_, cnt_, wi_, nw_) do { LAS float* scr5 = (LAS float*)(L + wave * 16384); int k_ = (wi_); const int end_ = (cnt_), st_ = (nw_); \
        for (; k_ + st_ < end_; k_ += 2 * st_) { float va_[32], vb_[32]; const int ra_ = (base_) + k_, rb_ = ra_ + st_; \
            { TrItem ti_; CV_DECODE(ti_, ra_); tr_load(ti_, va_, lane); } { TrItem ti_; CV_DECODE(ti_, rb_); tr_load(ti_, vb_, lane); } \
            { TrItem ti_; CV_DECODE(ti_, ra_); if (ti_.gain != nullptr) tr_store<true>(ti_, va_, scr5, lane); else tr_store<false>(ti_, va_, scr5, lane); } \
            { TrItem ti_; CV_DECODE(ti_, rb_); if (ti_.gain != nullptr) tr_store<true>(ti_, vb_, scr5, lane); else tr_store<false>(ti_, vb_, scr5, lane); } } \
        if (k_ < end_) { float va_[32]; const int ra_ = (base_) + k_; TrItem ti_; CV_DECODE(ti_, ra_); tr_load(ti_, va_, lane); \
            if (ti_.gain != nullptr) tr_store<true>(ti_, va_, scr5, lane); else tr_store<false>(ti_, va_, scr5, lane); } } while (0)
#define CV_TAIL(units_, c_, base_, cnt_) do { const int rem_ = (units_) % G, S_ = rem_ ? G - rem_ : 0; \
        if (2 * S_ >= G) { if ((c_) >= rem_) { CV_RUN(base_, cnt_, ((c_) - rem_) * 8 + wave, S_ * 8); } } else { CV_RUN(base_, cnt_, (c_) * 8 + wave, G * 8); } } while (0)
#ifndef CV_T1
#define CV_T1 0
#endif
#ifndef CV_T1N
#define CV_T1N 4096
#endif
#ifndef CV_T8
#define CV_T8 1
#endif
    constexpr int CV1_BASE = 0, CV1_CNT = CV_T1 ? CV_T1N : 0, CV8_BASE = MOE_ONLY / 2, CV8_CNT = MOE_ONLY / 2;
    constexpr int CV5_BASE = CV1_CNT, CV5_CNT = (CV_T8 ? MOE_ONLY / 2 : MOE_ONLY) - CV1_CNT;
    constexpr int CV5D_BASE = MOE_ONLY, CV5D_CNT = MOE_ITEMS - MOE_ONLY;

    PH_BEGIN(0) {
        LAS float* scr = (LAS float*)(L + wave * 16384);
        constexpr int I_AB = 16 * 37, I_QU = 4 * 24, I_KU = 2 * 32, I_O = 16 * 32, I_C = 16 * 48, I_E = 256;
        constexpr int NIT = I_AB + I_QU + I_KU;
#define P0_DECODE(T, it_) do { int r = (it_); \
            if (r < I_AB) { T = tr_seg<1>(r, INP(I_WINAB), 1184, 1184, WT_AB, 1024, 0, 0); break; } r -= I_AB; \
            if (r < I_QU) { T = tr_seg<MK_FUSE_PREP2 ? 4 : 0>(r, INP(I_WQUP), 768, 768, WT_UP, UP_K, 0, 0); break; } r -= I_QU; \
            if (r < I_KU) { T = tr_seg<MK_FUSE_PREP2 ? 5 : 0>(r, INP(I_WKVUP), 1024, 1024, WT_UP, UP_K, 768, 128); break; } r -= I_KU; \
            if (r < I_O) { T = tr_seg<0>(r, INP(I_WOUTAB), 1024, 1024, WT_OAB, 1024, 0, 0); break; } r -= I_O; \
            if (r < I_C) { T = tr_seg<0>(r, INP(I_WINC), 1536, 1536, WT_C, 1024, 0, 0, INP(I_MIXN) + DM); break; } r -= I_C; \
            if (r < I_O) { T = tr_seg<0>(r, INP(I_WOUTC), 1024, 1024, WT_OC, 1024, 0, 0); break; } r -= I_O; \
            const int le = r / (3 * I_E), q = r % (3 * I_E);            \
            if (q < I_E) T = tr_seg<2>(q, INP(I_WGATE) + (size_t)le * 1024 * 512, 512, 512, WT_GU + (size_t)le * 1024 * 1024, 1024, 0, 0); \
            else if (q < 2 * I_E) T = tr_seg<3>(q - I_E, INP(I_WUP) + (size_t)le * 1024 * 512, 512, 512, WT_GU + (size_t)le * 1024 * 1024, 1024, 0, 0); \
            else T = tr_seg<0>(q - 2 * I_E, INP(I_WDOWN) + (size_t)le * 512 * 1024, 1024, 1024, WT_D + (size_t)le * 1024 * 512, 512, 0, 0); } while (0)
        if (W.gw < NIT) {
            TrItem cur; P0_DECODE(cur, W.gw); float v[32]; tr_load(cur, v, lane);
            for (int it = W.gw; it < NIT; it += W.ngw) {
                const int itn = (it + W.ngw < NIT) ? it + W.ngw : it; TrItem nxt; P0_DECODE(nxt, itn); float nv[32]; tr_load(nxt, nv, lane);
                if (cur.gain != nullptr) tr_store<true>(cur, v, scr, lane); else tr_store<false>(cur, v, scr, lane);
                cur = nxt;
#pragma unroll
                for (int i = 0; i < 32; ++i) v[i] = nv[i];
            }
        }
        { const int gt = W.gw * 64 + lane, ngt = W.ngw * 64; const u32x4 z = {0u, 0u, 0u, 0u};
          for (int i = gt; i < 96 * 128; i += ngt) *(u32x4*)(WT_AB + (size_t)(1184 + i / 128) * 1024 + (i % 128) * 8) = z;
          for (int i = gt; i < 1024 * 16; i += ngt) *(u32x4*)(WT_UP + (size_t)(768 + i / 16) * UP_K + (i % 16) * 8) = z;
          for (int i = gt; i < 4096 * 16; i += ngt) { const float ang = (float)(i >> 4) * powf(10000.0f, -(float)(i & 15) * (1.0f / 16.0f)); tab[TB_CS + 2 * i] = cosf(ang); tab[TB_CS + 2 * i + 1] = sinf(ang); }
          const float* relb = INP(I_RELB);
          for (int i = gt; i < 16 * 512; i += ngt) { const int h = i >> 9, rel = (i & 511) - 256; tab[TB_BIAS + i] = (rel >= -128 && rel <= 128) ? relb[t5_bucket_dev(rel) * 16 + h] * LOG2E : -1.0e30f; } }
        { const int gt = W.gw * 64 + lane, ngt = W.ngw * 64;
          for (int i = gt; i < 2 * 4096; i += ngt) { const int ly = i >> 12; build_rtab(INP(I_FFNN) + ly * DM, INP(I_WGRP) + (size_t)ly * 1024 * 4, INP(I_WRTR) + (size_t)ly * 1024 * 16, RTAB + (size_t)ly * 65536, i & 4095); } }
        if (W.gw == 0) {
            const float gqn = gain_absmax(INP(I_QNG), 64, lane), gkn = gain_absmax(INP(I_KNG), 64, lane), gqr = gain_absmax(INP(I_QRG), 32, lane), gkr = gain_absmax(INP(I_KRG), 32, lane);
            const float gbq = gain_absmax(INP(I_GQG), 64, lane), gbk = gain_absmax(INP(I_GKG), 64, lane), gcq = gain_absmax(INP(I_WQG), 64, lane), gck = gain_absmax(INP(I_WKG), 64, lane);
            float bm = 0.f; for (int i = lane; i < 512; i += 64) bm = fmaxf(bm, INP(I_RELB)[i]); bm = wave_max(bm);
            if (lane == 0) { tab[TB_CONST + 0] = -(0.10206207261596577f * LOG2E * (64.f * gqn * gkn + 32.f * gqr * gkr));
                             tab[TB_CONST + 1] = -(0.125f * LOG2E * 64.f * gbq * gbk);
                             tab[TB_CONST + 2] = -(0.125f * LOG2E * 64.f * gcq * gck + bm * LOG2E); }
            if (lane < 16) tab[TB_CONST + 16 + lane] = INP(I_SINK)[lane] * LOG2E;
        }
        ph_rmsnorm(INP(I_X), INP(I_MIXN), HB, W);
    }
    PH_END(0)
#ifdef MK_EXTRA_BAR
    if (IN(0) && IN(1)) { for (int xb_ = 0; xb_ < MK_EXTRA_BAR; ++xb_) xcd_barrier(bar); }
#endif


        PH_BEGIN(1) {
#if MK_GEMM
            pg8::Gemm g{HB, WT_AB, 1024, 1024, 1024}; pg8::StaticOrder S; S.init(NT, PROJ_LD, 1024, 1024, G, bx);
#if MK_FUSE_PREP1
            pg8::EpiProjNormA E{PROJ, PROJ_LD, INP(I_QAN), INP(I_KVAN), INP(I_GQG), 0.125f * LOG2E, (LAS float*)(L + MISC_OFF + 16384), EPS};
            pg8::gemm_phase<pg8::EpiProjNormA, pg8::StaticOrder, true>(L, g, S, E);
#if CV_T1
            CV_TAIL((NT / 256) * (PROJ_LD / 256), bx, CV1_BASE, CV1_CNT);
#endif
#else
            pg8::EpiStoreBf16 E{PROJ, PROJ_LD};
            pg8::gemm_phase<pg8::EpiStoreBf16, pg8::StaticOrder, true>(L, g, S, E);
#endif
#else
            naive_gemm<0>(HB, 1024, WT_AB, 1024, NT, PROJ_LD, 1024, PROJ, nullptr, nullptr, PROJ_LD, W);
#endif
        }
        PH_END(1)
#if !MK_FUSE_PREP1
        PH_BEGIN(2) ph_prep1(PROJ, rep_ ? DUMMY : PROJ, INP(I_QAN), INP(I_KVAN), INP(I_GQG), INP(I_GKG), INP(I_KRG), tab + TB_CS, W);
        PH_END(2)
#endif
        PH_BEGIN(3) {
#if MK_FUSE_PREP1
            if (!rep_) { const int kfirst = (G > 192 && G < 384) ? 384 - G : 0;
                if (bx >= kfirst) { WaveId Wk = W; Wk.gw = (bx - kfirst) * 8 + wave; Wk.ngw = (G - kfirst) * 8;
                    ph_kside(PROJ, INP(I_GKG), INP(I_KRG), tab + TB_CS, Wk); } }
#endif
#if MK_GEMM
            pg8::Gemm g{PROJ, WT_UP, PROJ_LD, UP_K, UP_K}; pg8::StaticOrder S; S.init(NT, UP_LD, PROJ_LD, UP_K, G, bx, 3);
#if MK_FUSE_PREP2
            { pg8::StaticOrder Sq; Sq.init(NT, 768, PROJ_LD, UP_K, G, bx);
              pg8::EpiHeadNormA Eq{UPO, UP_LD, INP(I_QNG), INP(I_QNG), 0.10206207261596577f * LOG2E, EPS, 2, 2, nullptr};
              pg8::gemm_phase<pg8::EpiHeadNormA, pg8::StaticOrder, EPI_ALIGN>(L, g, Sq, Eq); }
#if UP_KV_K128
            { int kk_ = 128; asm volatile("" : "+s"(kk_));
              pg8::Gemm gk{PROJ + 256, WT_UP + (size_t)768 * UP_K + 128, PROJ_LD, UP_K, kk_}; pg8::StaticOrder Sk; Sk.init(NT, 1024, PROJ_LD, UP_K, G, bx);
#else
            { pg8::Gemm gk{PROJ + 128, WT_UP + (size_t)768 * UP_K, PROJ_LD, UP_K, UP_K}; pg8::StaticOrder Sk; Sk.init(NT, 1024, PROJ_LD, UP_K, G, bx);
#endif
              pg8::EpiHeadNormA Ek{UPO + 768, UP_LD, INP(I_KNG), INP(I_KNG), 1.0f, EPS, 0, 2, nullptr};
              pg8::gemm_phase<pg8::EpiHeadNormA, pg8::StaticOrder, EPI_ALIGN>(L, gk, Sk, Ek); }
#else
            pg8::EpiStoreBf16 E{UPO, UP_LD};
            pg8::gemm_phase<pg8::EpiStoreBf16, pg8::StaticOrder, true>(L, g, S, E);
#endif
#else
            naive_gemm<0>(PROJ, PROJ_LD, WT_UP, UP_K, NT, UP_LD, UP_K, UPO, nullptr, nullptr, UP_LD, W);
#endif
        }
        PH_END(3)
#if !MK_FUSE_PREP2
        PH_BEGIN(4) ph_prep2(UPO, rep_ ? DUMMY : UPO, INP(I_QNG), INP(I_QRG), INP(I_KNG), tab + TB_CS, W);
        PH_END(4)
#endif
        PH_BEGIN(5) {
            const float negcA = tab[TB_CONST + 0], negcB = tab[TB_CONST + 1];
#if MK_ATTN
            unsigned long long tsync = 0ull;
#ifdef MK_CLKPROBE
            const unsigned long long cp0_ = __builtin_amdgcn_s_memtime();
#endif
            int pos_ = 0; const int grp_ = bx % 5; bool cvdone_ = false;
#define P5_CVALL() do { if (CV5_CNT > 0) { CV_RUN(CV5_BASE, CV5_CNT, W.gw, W.ngw); } CV_RUN(CV5D_BASE, CV5D_CNT, W.gw, W.ngw); __syncthreads(); } while (0)
#define P5_SLOT() do { if (pos_ == grp_) { P5_CVALL(); cvdone_ = true; } ++pos_; } while (0)
#if ATT_WIDE_A
            for (int u = ATT_MAP; u < 512; u += G) { const int b = u >> 6, h = (u >> 3) & 7, qb = u & 7; const size_t r0 = (size_t)b * SEQ, rq = r0 + qb * 512;
                P5_SLOT();
                att::attn_unit16w<96>(UPO + rq * UP_LD + (MK_FUSE_PREP2 ? 64 : 96) * h, UPO + rq * UP_LD + (MK_FUSE_PREP2 ? 512 + 32 * h : 96 * h + 64), UP_LD, UPO + r0 * UP_LD + 768 + (MK_FUSE_PREP2 ? 64 : 128) * h, UP_LD, PROJ + r0 * PROJ_LD + PC_KROPE, PROJ_LD,
                                      UPO + r0 * UP_LD + (MK_FUSE_PREP2 ? 1280 + 64 * h : 768 + 128 * h + 64), UP_LD, HB + rq * DM + 64 * h, DM, 0, SEQ / 128, negcA, (char*)lds, MK_FUSE_PREP2 ? INP(I_QRG) : nullptr, tab + TB_CS, qb * 512); }
#else
            for (int u = ATT_MAP; u < 1024; u += G) { const int b = u >> 7, h = (u >> 4) & 7, qb = u & 15; const size_t r0 = (size_t)b * SEQ, rq = r0 + qb * 256;
                P5_SLOT();
                att::attn_unit16<96>(UPO + rq * UP_LD + (MK_FUSE_PREP2 ? 64 : 96) * h, UPO + rq * UP_LD + (MK_FUSE_PREP2 ? 512 + 32 * h : 96 * h + 64), UP_LD, UPO + r0 * UP_LD + 768 + (MK_FUSE_PREP2 ? 64 : 128) * h, UP_LD, PROJ + r0 * PROJ_LD + PC_KROPE, PROJ_LD,
                                          UPO + r0 * UP_LD + (MK_FUSE_PREP2 ? 1280 + 64 * h : 768 + 128 * h + 64), UP_LD, HB + rq * DM + 64 * h, DM, 0, SEQ / 128, negcA, (char*)lds, MK_FUSE_PREP2 ? INP(I_QRG) : nullptr, tab + TB_CS, qb * 256); }
#endif
#if ATT_WIDE_B
            for (int u = ATT_MAP; u < 512; u += G) { const int b = u >> 6, h = (u >> 3) & 7, qb = u & 7; const size_t r0 = (size_t)b * SEQ, rq = r0 + qb * 512;
                P5_SLOT();
                att::attn_unit16w<64>(PROJ + rq * PROJ_LD + PC_BQ + 64 * h, nullptr, PROJ_LD, PROJ + r0 * PROJ_LD + PC_BK + 64 * (h >> 2), PROJ_LD, nullptr, 0,
                                  PROJ + r0 * PROJ_LD + PC_BV + 64 * (h >> 2), PROJ_LD, HB + rq * DM + 512 + 64 * h, DM, 0, SEQ / 128, negcB, (char*)lds, nullptr, MK_FUSE_PREP1 ? tab + TB_CS : nullptr, qb * 512); }
#else
            for (int u = ATT_MAP; u < 1024; u += G) { const int b = u >> 7, h = (u >> 4) & 7, qb = u & 15; const size_t r0 = (size_t)b * SEQ, rq = r0 + qb * 256;
                P5_SLOT();
                att::attn_unit16<64>(PROJ + rq * PROJ_LD + PC_BQ + 64 * h, nullptr, PROJ_LD, PROJ + r0 * PROJ_LD + PC_BK + 64 * (h >> 2), PROJ_LD, nullptr, 0,
                                          PROJ + r0 * PROJ_LD + PC_BV + 64 * (h >> 2), PROJ_LD, HB + rq * DM + 512 + 64 * h, DM, 0, SEQ / 128, negcB, (char*)lds, nullptr, nullptr, 0); }
#endif
            if (!cvdone_) { P5_CVALL(); }
#if ATT_PROBE
            { const unsigned long long ts0_ = __builtin_amdgcn_s_memtime(); while (__builtin_amdgcn_s_memtime() - ts0_ < tsync) __builtin_amdgcn_s_sleep(8); }
#endif
#ifdef MK_CLKPROBE
            { const unsigned long long cyc_ = __builtin_amdgcn_s_memtime() - cp0_; const unsigned long long r0_ = __builtin_amdgcn_s_memrealtime(); while (__builtin_amdgcn_s_memrealtime() - r0_ < cyc_ / 21ull) __builtin_amdgcn_s_sleep(8); }
#endif
#else
            LAS float* qf = (LAS float*)(L + wave * 512);
            for (long it = W.gw; it < (long)NT * 8; it += W.ngw) { const int m = (int)(it >> 3), h = (int)(it & 7); const size_t r0 = (size_t)(m / SEQ) * SEQ;
                naive_attn_row<96, false>(UPO + (size_t)m * UP_LD + 96 * h, UPO + r0 * UP_LD + 768 + (MK_FUSE_PREP2 ? 64 : 128) * h, UP_LD, PROJ + r0 * PROJ_LD + PC_KROPE, PROJ_LD,
                                          UPO + r0 * UP_LD + (MK_FUSE_PREP2 ? 1280 + 64 * h : 768 + 128 * h + 64), UP_LD, HB + (size_t)m * DM + 64 * h, 0, nullptr, 0.f, qf, lane); }
            for (long it = W.gw; it < (long)NT * 8; it += W.ngw) { const int m = (int)(it >> 3), h = (int)(it & 7); const size_t r0 = (size_t)(m / SEQ) * SEQ;
                naive_attn_row<64, false>(PROJ + (size_t)m * PROJ_LD + PC_BQ + 64 * h, PROJ + r0 * PROJ_LD + PC_BK + 64 * (h >> 2), PROJ_LD, nullptr, 0,
                                          PROJ + r0 * PROJ_LD + PC_BV + 64 * (h >> 2), PROJ_LD, HB + (size_t)m * DM + 512 + 64 * h, 0, nullptr, 0.f, qf, lane); }
            (void)negcA; (void)negcB;
#endif
        }
        PH_END(5)
        PH_BEGIN(6) {
#if MK_GEMM
            pg8::Gemm g{HB, WT_OAB, 1024, 1024, 1024}; pg8::StaticOrder S; S.init(NT, DM, 1024, 1024, G, bx); pg8::EpiResXBA E{INP(I_X), XRB, DM};
            pg8::gemm_phase<pg8::EpiResXBA, pg8::StaticOrder, EPI_ALIGN>(L, g, S, E);
#else

#endif
        }
        PH_END(6)

    { constexpr int LAYER_ = 0;
    constexpr int layer = LAYER_; constexpr int pb = 8 * layer;
    unsigned* cnt = ctl + CW_CNT + 1024 * layer;
    int* eidx = r_eidx + (size_t)layer * NT * 2; float* wts = r_wts + (size_t)layer * NT * 2; int* rank = r_slot + (size_t)layer * NT * 2;
    int* list = (int*)(ws + WS_LIST);
    bf16* YB = (bf16*)(ws + WS_Y);
    PH_BEGIN(7 + pb) {
        { const u32x4* src = (const u32x4*)(RTAB + (size_t)layer * 65536); LAS u32x4* dst = (LAS u32x4*)L;
          for (int i = tid; i < 8192; i += 512) dst[i] = src[i]; }
        LAS int* tinfo = (LAS int*)(L + MISC_OFF + 2048);
        { const int niter = (NT / 16 - bx * 8 + W.ngw - 1) / W.ngw;
          for (int i = tid; i < 32 + 4 * niter * 128; i += 512) tinfo[i] = (i < 32) ? 0 : -1; }
        __syncthreads();
        ph_router(XRB, (float*)(ws + WS_RS) + (size_t)layer * NT, L, (LAS float*)(L + MISC_OFF + 8192 + wave * 2304), INP(I_BGRP) + layer * 4, INP(I_BRTR) + layer * 16, eidx, wts, rank, list, cnt, tinfo, W);
    }
    PH_END(7 + pb)
    PH_BEGIN(8 + pb) {
        LAS unsigned char* tile_e = L + MISC_OFF + 1024; LAS int* rowtok = (LAS int*)(L + MISC_OFF + 2048); LAS float* rowrs = (LAS float*)(L + MISC_OFF + 16384);
        const float* rsv = (const float*)(ws + WS_RS) + (size_t)layer * NT;
        if (tid < 64) { int off[17]; const int ntile = moe_offsets(cnt, off);
            for (int t = lane; t < ntile; t += 64) { const int row = t * 256; int e = 0;
#pragma unroll
                for (int q = 1; q < 16; ++q) e = (row >= off[q]) ? q : e;
                tile_e[t] = (unsigned char)e; }
            if (lane == 0) MISC[4] = (unsigned)ntile; }
        __syncthreads();
        const int ntile = (int)MISC[4];
        { int off[17]; moe_offsets(cnt, off);
          for (int idx = tid; idx < 13 * 256; idx += 512) { const int ui = idx >> 8, r = idx & 255; const long Lu = (long)ui * G + vcu;
              if (Lu < (long)ntile * 4) { const int pm = (int)(Lu >> 2); const int e = tile_e[pm]; int base = 0, ce = 0;
#pragma unroll
                  for (int q = 0; q < 16; ++q) { base = (q == e) ? off[q] : base; ce = (q == e) ? (int)cnt[64 * q] : ce; }
                  const int lr = pm * 256 - base + r; const int tk = (lr < ce) ? list[(size_t)e * NT + lr] : 0; rowtok[idx] = tk; rowrs[idx] = (lr < ce) ? rsv[tk] : 0.f; } } }
        __syncthreads();
        pg8::Gemm g{XRB, WT_GU + (size_t)layer * 16 * 1024 * 1024, 1024, 1024, 1024};
        pg8::MoeOrder S{tile_e, ntile, 4, G, vcu, 1024, 1024, (long)1024 * 1024}; pg8::EpiSwiGLU E{ACT, DEXP, rowrs};
        pg8::gemm_phase<pg8::EpiSwiGLU, pg8::MoeOrder, EPI_ALIGN, true>(L, g, S, E, rowtok);
#if CV_T8
        if (layer == 0) { CV_TAIL(ntile * 4, vcu, CV8_BASE, CV8_CNT); }
#endif
    }
    PH_END(8 + pb)
    PH_BEGIN(9 + pb) {
        LAS unsigned char* tile_e = L + MISC_OFF + 1024;
        if (tid < 64) { int off[17]; const int ntile = moe_offsets(cnt, off);
            for (int t = lane; t < ntile; t += 64) { const int row = t * 256; int e = 0;
#pragma unroll
                for (int q = 1; q < 16; ++q) e = (row >= off[q]) ? q : e;
                tile_e[t] = (unsigned char)e; }
            if (lane == 0) MISC[4] = (unsigned)ntile; }
        __syncthreads();
        const int ntile = (int)MISC[4];
        pg8::Gemm g{ACT, WT_D + (size_t)layer * 16 * 1024 * 512, DEXP, DEXP, DEXP};
        pg8::MoeOrder S{tile_e, ntile, 4, G, vcu, DEXP, DEXP, (long)1024 * 512}; pg8::EpiStoreAdj E{YB, DM};
        pg8::gemm_phase<pg8::EpiStoreAdj, pg8::MoeOrder, EPI_ALIGN>(L, g, S, E);
    }
    PH_END(9 + pb)
    PH_BEGIN(10 + pb) {
        if (layer == 0) ph_combine<false>(XRB, nullptr, YB, eidx, rank, wts, cnt, (float*)(ws + WS_RS) + 2 * (size_t)NT, W);
        else ph_combine<true>(XRB, args.out, YB, eidx, rank, wts, cnt, nullptr, W);
    } } } if (layer == 0) SEAM(10);

    }

        PH_BEGIN(11) {
#if MK_GEMM
            pg8::Gemm g{XRB, WT_C, 1024, 1024, 1024}; pg8::StaticOrder S; S.init(NT, PC_LD, 1024, 1024, G, bx);
#if MK_FUSE_PREPC
            pg8::EpiHeadNormA E{PROJC, PC_LD, INP(I_WQG), INP(I_WKG), 0.125f * LOG2E, EPS, 4, 5, (const float*)(ws + WS_RS) + 2 * (size_t)NT};
            pg8::gemm_phase<pg8::EpiHeadNormA, pg8::StaticOrder, EPI_ALIGN>(L, g, S, E);
#else
            pg8::EpiStoreBf16 E{PROJC, PC_LD};
            pg8::gemm_phase<pg8::EpiStoreBf16, pg8::StaticOrder, true>(L, g, S, E);
#endif
#else
            naive_gemm<0>(HB, 1024, WT_C, 1024, NT, PC_LD, 1024, PROJC, nullptr, nullptr, PC_LD, W);
#endif
        }
        PH_END(11)
#if !MK_FUSE_PREPC
        PH_BEGIN(12) ph_prepc(PROJC, rep_ ? DUMMY : PROJC, INP(I_WQG), INP(I_WKG), W);
        PH_END(12)
#endif
        PH_BEGIN(13) {
            const float negcC = tab[TB_CONST + 2];
#if MK_ATTN
            unsigned long long tsync = 0ull;
#if ATT_WIDE_C
            int wkvh_ = -1;
            for (int u = ATT_MAP; u < 1024; u += G) { const int b = u >> 7, kvh = (u >> 5) & 3, qb = u & 31;
                if (kvh != wkvh_) { __syncthreads(); att::win_bias_tables((char*)lds, tab + TB_BIAS + 2048 * kvh, negcC); wkvh_ = kvh; __syncthreads(); } const size_t r0 = (size_t)b * SEQ, rq = r0 + qb * 128;
                const int q0 = qb * 128; const int lo = q0 >= 128 ? q0 - 128 : 0, hi_ = q0 + 256 < SEQ ? q0 + 256 : SEQ; const int kt0 = lo / 128, kt1 = (hi_ + 127) / 128;
                att::attn_unit16w<64, true>(PROJC + rq * PC_LD + 256 * kvh, nullptr, PC_LD, PROJC + r0 * PC_LD + 1024 + 64 * kvh, PC_LD, nullptr, 0,
                                            PROJC + r0 * PC_LD + 1280 + 64 * kvh, PC_LD, HB + rq * DM + 256 * kvh, DM, kt0, kt1, negcC, (char*)lds, nullptr, nullptr, q0, tab + TB_BIAS + 2048 * kvh, tab + TB_CONST + 16 + 4 * kvh); }
#else
            for (int u = ATT_MAP; u < 2048; u += G) { const int b = u >> 8, kvh = (u >> 6) & 3, qb = u & 63; const size_t r0 = (size_t)b * SEQ, rq = r0 + qb * 64;
                const int q0 = qb * 64; const int lo = q0 >= 128 ? q0 - 128 : 0, hi_ = q0 + 192 < SEQ ? q0 + 192 : SEQ; const int kt0 = lo / att::STAGE_KEYS, kt1 = (hi_ + att::STAGE_KEYS - 1) / att::STAGE_KEYS;
                att::attn_unit<64, true>(PROJC + rq * PC_LD + 256 * kvh, PC_LD, PROJC + r0 * PC_LD + 1024 + 64 * kvh, PC_LD, nullptr, 0,
                                         PROJC + r0 * PC_LD + 1280 + 64 * kvh, PC_LD, HB + rq * DM + 256 * kvh, DM, kt0, kt1, negcC, q0, tab + TB_BIAS + 2048 * kvh, tab + TB_CONST + 16 + 4 * kvh, (char*)lds, tsync); }
#endif
#else
            LAS float* qf = (LAS float*)(L + wave * 512);
            for (long it = W.gw; it < (long)NT * 16; it += W.ngw) { const int m = (int)(it >> 4), h = (int)(it & 15); const size_t r0 = (size_t)(m / SEQ) * SEQ;
                naive_attn_row<64, true>(PROJC + (size_t)m * PC_LD + 64 * h, PROJC + r0 * PC_LD + 1024 + 64 * (h >> 2), PC_LD, nullptr, 0,
                                         PROJC + r0 * PC_LD + 1280 + 64 * (h >> 2), PC_LD, HB + (size_t)m * DM + 64 * h, m & (SEQ - 1), tab + TB_BIAS + 512 * h, tab[TB_CONST + 16 + h], qf, lane); }
            (void)negcC;
#endif
        }
        PH_END(13)
        PH_BEGIN(14) {
#if MK_GEMM
            pg8::Gemm g{HB, WT_OC, 1024, 1024, 1024}; pg8::StaticOrder S; S.init(NT, DM, 1024, 1024, G, bx); pg8::EpiResBBA E{XRB, DM};
            pg8::gemm_phase<pg8::EpiResBBA, pg8::StaticOrder, EPI_ALIGN>(L, g, S, E);
#else

#endif
        }
        PH_END(14)

    { constexpr int LAYER_ = 1;
    constexpr int layer = LAYER_; constexpr int pb = 8 * layer;
    unsigned* cnt = ctl + CW_CNT + 1024 * layer;
    int* eidx = r_eidx + (size_t)layer * NT * 2; float* wts = r_wts + (size_t)layer * NT * 2; int* rank = r_slot + (size_t)layer * NT * 2;
    int* list = (int*)(ws + WS_LIST);
    bf16* YB = (bf16*)(ws + WS_Y);
    PH_BEGIN(7 + pb) {
        { const u32x4* src = (const u32x4*)(RTAB + (size_t)layer * 65536); LAS u32x4* dst = (LAS u32x4*)L;
          for (int i = tid; i < 8192; i += 512) dst[i] = src[i]; }
        LAS int* tinfo = (LAS int*)(L + MISC_OFF + 2048);
        { const int niter = (NT / 16 - bx * 8 + W.ngw - 1) / W.ngw;
          for (int i = tid; i < 32 + 4 * niter * 128; i += 512) tinfo[i] = (i < 32) ? 0 : -1; }
        __syncthreads();
        ph_router(XRB, (float*)(ws + WS_RS) + (size_t)layer * NT, L, (LAS float*)(L + MISC_OFF + 8192 + wave * 2304), INP(I_BGRP) + layer * 4, INP(I_BRTR) + layer * 16, eidx, wts, rank, list, cnt, tinfo, W);
    }
    PH_END(7 + pb)
    PH_BEGIN(8 + pb) {
        LAS unsigned char* tile_e = L + MISC_OFF + 1024; LAS int* rowtok = (LAS int*)(L + MISC_OFF + 2048); LAS float* rowrs = (LAS float*)(L + MISC_OFF + 16384);
        const float* rsv = (const float*)(ws + WS_RS) + (size_t)layer * NT;
        if (tid < 64) { int off[17]; const int ntile = moe_offsets(cnt, off);
            for (int t = lane; t < ntile; t += 64) { const int row = t * 256; int e = 0;
#pragma unroll
                for (int q = 1; q < 16; ++q) e = (row >= off[q]) ? q : e;
                tile_e[t] = (unsigned char)e; }
            if (lane == 0) MISC[4] = (unsigned)ntile; }
        __syncthreads();
        const int ntile = (int)MISC[4];
        { int off[17]; moe_offsets(cnt, off);
          for (int idx = tid; idx < 13 * 256; idx += 512) { const int ui = idx >> 8, r = idx & 255; const long Lu = (long)ui * G + vcu;
              if (Lu < (long)ntile * 4) { const int pm = (int)(Lu >> 2); const int e = tile_e[pm]; int base = 0, ce = 0;
#pragma unroll
                  for (int q = 0; q < 16; ++q) { base = (q == e) ? off[q] : base; ce = (q == e) ? (int)cnt[64 * q] : ce; }
                  const int lr = pm * 256 - base + r; const int tk = (lr < ce) ? list[(size_t)e * NT + lr] : 0; rowtok[idx] = tk; rowrs[idx] = (lr < ce) ? rsv[tk] : 0.f; } } }
        __syncthreads();
        pg8::Gemm g{XRB, WT_GU + (size_t)layer * 16 * 1024 * 1024, 1024, 1024, 1024};
        pg8::MoeOrder S{tile_e, ntile, 4, G, vcu, 1024, 1024, (long)1024 * 1024}; pg8::EpiSwiGLU E{ACT, DEXP, rowrs};
        pg8::gemm_phase<pg8::EpiSwiGLU, pg8::MoeOrder, EPI_ALIGN, true>(L, g, S, E, rowtok);
#if CV_T8
        if (layer == 0) { CV_TAIL(ntile * 4, vcu, CV8_BASE, CV8_CNT); }
#endif
    }
    PH_END(8 + pb)
    PH_BEGIN(9 + pb) {
        LAS unsigned char* tile_e = L + MISC_OFF + 1024;
        if (tid < 64) { int off[17]; const int ntile = moe_offsets(cnt, off);
            for (int t = lane; t < ntile; t += 64) { const int row = t * 256; int e = 0;
#pragma unroll
                for (int q = 1; q < 16; ++q) e = (row >= off[q]) ? q : e;
                tile_e[t] = (unsigned char)e; }
            if (lane == 0) MISC[4] = (unsigned)ntile; }
        __syncthreads();
        const int ntile = (int)MISC[4];
        pg8::Gemm g{ACT, WT_D + (size_t)layer * 16 * 1024 * 512, DEXP, DEXP, DEXP};
        pg8::MoeOrder S{tile_e, ntile, 4, G, vcu, DEXP, DEXP, (long)1024 * 512}; pg8::EpiStoreAdj E{YB, DM};
        pg8::gemm_phase<pg8::EpiStoreAdj, pg8::MoeOrder, EPI_ALIGN>(L, g, S, E);
    }
    PH_END(9 + pb)
    PH_BEGIN(10 + pb) {
        if (layer == 0) ph_combine<false>(XRB, nullptr, YB, eidx, rank, wts, cnt, (float*)(ws + WS_RS) + 2 * (size_t)NT, W);
        else ph_combine<true>(XRB, args.out, YB, eidx, rank, wts, cnt, nullptr, W);
    } } } if (layer == 0) SEAM(10);

    }
#undef IN
#undef INP
#undef SEAM
#undef PH_BEGIN
#undef PH_END
}

extern "C" void kernel_launch(void* const* d_in, const int* in_sizes, int n_in, void* d_out, int out_size, void* d_ws, size_t ws_size, hipStream_t stream) {
    static int grid = 0;
    if (grid == 0) {
        if (n_in != 28 || in_sizes[0] != NT * DM || out_size != NT * DM || ws_size < WS_END) {
            fprintf(stderr, "kernel_launch: shape mismatch: n_in %d in0 %d out %d ws %zu (need >= %zu); nothing launched\n", n_in, n_in > 0 ? in_sizes[0] : -1, out_size, ws_size, (size_t)WS_END); grid = -1; return; }
        int dev = 0, cus = 0, per_cu = 0;
        if (hipGetDevice(&dev) != hipSuccess || hipDeviceGetAttribute(&cus, hipDeviceAttributeMultiprocessorCount, dev) != hipSuccess) { fprintf(stderr, "kernel_launch: device query failed\n"); grid = -1; return; }
        if (hipFuncSetAttribute((const void*)mk_fwd, hipFuncAttributeMaxDynamicSharedMemorySize, LDS_BYTES) != hipSuccess) { fprintf(stderr, "kernel_launch: hipFuncSetAttribute failed\n"); grid = -1; return; }
        if (hipOccupancyMaxActiveBlocksPerMultiprocessor(&per_cu, (const void*)mk_fwd, 512, LDS_BYTES) != hipSuccess || per_cu < 1)
            fprintf(stderr, "kernel_launch: note: occupancy query reports %d workgroups per CU\n", per_cu);
        (void)hipGetLastError();
        grid = cus;
    }
    if (grid < 0) return;
    if (hipMemsetAsync((char*)d_ws + WS_CTL, 0, CTL_ZERO_BYTES, stream) != hipSuccess) { fprintf(stderr, "kernel_launch: memset failed\n"); return; }
    Args a{};
    for (int i = 0; i < 28; ++i) a.in[i] = (const float*)d_in[i];
    a.out = (float*)d_out; a.ws = (unsigned char*)d_ws;
#if MK_ONE_LAUNCH
    a.ph_lo = 0; a.ph_hi = NPHASE;
    hipLaunchKernelGGL(mk_fwd, dim3(grid), dim3(512), LDS_BYTES, stream, a);
#else
    for (int p = 0; p < NPHASE; ++p) { a.ph_lo = p; a.ph_hi = p + 1; hipLaunchKernelGGL(mk_fwd, dim3(grid), dim3(512), LDS_BYTES, stream, a); }
#endif
    const hipError_t le = hipPeekAtLastError();
    if (le != hipSuccess) fprintf(stderr, "kernel_launch: launch failed: %s\n", hipGetErrorName(le));
}
```

```cpp
#define MK_ONE_LAUNCH 1
#define MK_GEMM 1
#define MK_ATTN 1
#define ATT_SG_ON 0
#include <hip/hip_runtime.h>
#include <cstdio>
#include <cstdint>

#ifndef MK_ONE_LAUNCH
#define MK_ONE_LAUNCH 1
#endif
#ifndef MK_GEMM
#define MK_GEMM 1
#endif
#ifndef MK_ATTN
#define MK_ATTN 1
#endif

#define GAS __attribute__((address_space(1)))
#define LAS __attribute__((address_space(3)))
typedef unsigned short bf16;
typedef short bf16x8 __attribute__((ext_vector_type(8)));
typedef short s16x4 __attribute__((ext_vector_type(4)));
typedef float f32x2 __attribute__((ext_vector_type(2)));
typedef float f32x4 __attribute__((ext_vector_type(4)));
typedef float f32x16 __attribute__((ext_vector_type(16)));
typedef unsigned u32x2 __attribute__((ext_vector_type(2)));
typedef unsigned u32x4 __attribute__((ext_vector_type(4)));

constexpr int NBATCH = 8, SEQ = 4096, NT = NBATCH * SEQ, DM = 1024;
constexpr float EPS = 1e-6f;
constexpr float LOG2E = 1.4426950408889634f;
constexpr int PROJ_LD = 1280;
constexpr int UP_LD = 1792, UP_K = 256;
constexpr int PC_LD = 1536;
constexpr int PC_QLAT = 0, PC_KVLAT = 256, PC_BQ = 384, PC_BK = 896, PC_BV = 1024, PC_KROPE = 1152;
constexpr int NEXP = 16, DEXP = 512;
constexpr int MOE_ROWS = 2 * NT + NEXP * 256;

constexpr size_t MiB = 1u << 20;
constexpr size_t WS_CTL = 0, CTL_ZERO_BYTES = 64 * 1024;
constexpr size_t WS_TAB = 1 * MiB;
constexpr size_t WS_ROUTE = 2 * MiB;
constexpr size_t WS_RS = WS_ROUTE + 1536 * 1024;
constexpr size_t WS_WAB = 4 * MiB, WS_WUP = 7 * MiB, WS_WOAB = 9 * MiB, WS_WC = 11 * MiB, WS_WOC = 14 * MiB;
constexpr size_t WS_WGU = 16 * MiB;
constexpr size_t WS_WD = 80 * MiB;
constexpr size_t WS_H = 112 * MiB;
constexpr size_t WS_R = 176 * MiB;
constexpr size_t WS_PROJ = WS_R;
constexpr size_t WS_UPO = WS_R + 80 * MiB;
constexpr size_t WS_PROJC = WS_R;
constexpr size_t WS_Y = WS_R;
constexpr size_t WS_ACT = WS_R + 136 * MiB;
constexpr size_t WS_LIST = WS_R + 204 * MiB;
constexpr size_t WS_XR = WS_R + 206 * MiB;
constexpr size_t WS_RTAB = WS_R + 270 * MiB;
constexpr size_t WS_END = WS_R + 271 * MiB;
static_assert((size_t)MOE_ROWS * 1024 * 2 <= 136 * MiB && (size_t)MOE_ROWS * 512 * 2 <= 68 * MiB, "moe buffers");
constexpr int CW_CNT = 1024;
constexpr int CW_BAR = 4096;
constexpr int TB_BIAS = 0;
constexpr int TB_CONST = 8192;
constexpr int TB_CS = 32768;

constexpr int RING_BYTES = 131072;
constexpr int MISC_OFF = RING_BYTES;
constexpr int LDS_BYTES = 163840;

__device__ __forceinline__ float bf2f(unsigned b) { return __uint_as_float(b << 16); }
__device__ __forceinline__ unsigned f2bf(float f) { unsigned u = __float_as_uint(f); return (u + 0x7fffu + ((u >> 16) & 1u)) >> 16; }
__device__ __forceinline__ unsigned pk2(float lo, float hi) { unsigned r; asm volatile("v_cvt_pk_bf16_f32 %0, %1, %2" : "=v"(r) : "v"(lo), "v"(hi)); return r; }
__device__ __forceinline__ float wave_sum(float v) {
#pragma unroll
    for (int o = 1; o < 64; o <<= 1) v += __shfl_xor(v, o);
    return v;
}
__device__ __forceinline__ float wave_max(float v) {
#pragma unroll
    for (int o = 1; o < 64; o <<= 1) v = fmaxf(v, __shfl_xor(v, o));
    return v;
}
#define LDS_WAIT() asm volatile("s_waitcnt lgkmcnt(0)" ::: "memory")

#define XB_TMO      128
#define XB_XCNT(j)  (256  + 64 * (j))
#define XB_XSUB(j)  (1280 + 64 * (j))
#define XB_XGEN(j)  (2304 + 64 * (j))
#define XB_TOP      3328
#define XB_TOPGEN   3392
#define XCD_BAR_WORDS 3456
#define XB_SPIN_CAP (1u << 18)
__device__ __forceinline__ unsigned xb_ld(unsigned* p)              { return __hip_atomic_load(p, __ATOMIC_RELAXED, __HIP_MEMORY_SCOPE_AGENT); }
__device__ __forceinline__ unsigned xb_add(unsigned* p, unsigned v) { return __hip_atomic_fetch_add(p, v, __ATOMIC_RELAXED, __HIP_MEMORY_SCOPE_AGENT); }
__device__ __forceinline__ unsigned xb_xcc_id() { return (unsigned)__builtin_amdgcn_s_getreg((3 << 11) | 20) & 0xFu; }
#define XB_SPIN(cond, bar) do { unsigned _sp = 0; while (cond) { __builtin_amdgcn_s_sleep(1); \
    if ((++_sp & 255u) == 0u) { if (xb_ld(&(bar)[XB_TMO])) break; if (_sp > XB_SPIN_CAP) { atomicAdd(&(bar)[XB_TMO], 1u); break; } } } } while (0)
struct XcdBarrier { unsigned* bar; unsigned x; volatile LAS unsigned* st; };
__device__ __forceinline__ XcdBarrier xcd_barrier_post(unsigned* bar, volatile LAS unsigned* st) {
    XcdBarrier b; b.bar = bar; b.x = xb_xcc_id(); b.st = st;
    if (threadIdx.x == 0) (void)xb_add(&bar[XB_XCNT(b.x)], 1u);
    return b;
}
__device__ __forceinline__ void xcd_barrier_complete(unsigned* bar, unsigned x, unsigned& nloc, unsigned& nx) {
    const unsigned G = gridDim.x * gridDim.y * gridDim.z;
    unsigned sum, cnt, mine, sp = 0u;
    for (;;) {
        sum = 0u; cnt = 0u; mine = 0u;
#pragma unroll
        for (unsigned j = 0; j < 16; ++j) { const unsigned c = xb_ld(&bar[XB_XCNT(j)]); sum += c; cnt += (c > 0u) ? 1u : 0u; mine = (j == x) ? c : mine; }
        if (sum == G) break;
        __builtin_amdgcn_s_sleep(1);
        if ((++sp & 255u) == 0u) { if (xb_ld(&bar[XB_TMO])) break; if (sp > XB_SPIN_CAP) { atomicAdd(&bar[XB_TMO], 1u); break; } }
    }
    nloc = mine > 0u ? mine : 1u; nx = cnt > 0u ? cnt : 1u;
}
__device__ __forceinline__ void xcd_barrier(const XcdBarrier& b) {
    asm volatile("s_waitcnt vmcnt(0)" ::: "memory");
    __syncthreads();
    if (threadIdx.x == 0) {
        unsigned* bar = b.bar;
        __builtin_amdgcn_s_waitcnt(0);
        unsigned nloc = b.st[0], nx = b.st[1];
        if (nloc == 0u) { xcd_barrier_complete(bar, b.x, nloc, nx); b.st[0] = nloc; b.st[1] = nx; }
        const unsigned old = xb_add(&bar[XB_XSUB(b.x)], 1u);
        const unsigned gen = old / nloc;
        if (old + 1u == (gen + 1u) * nloc) {
            __builtin_amdgcn_fence(__ATOMIC_RELEASE, "agent");
            asm volatile("s_waitcnt vmcnt(0)" ::: "memory");
            const unsigned og = xb_add(&bar[XB_TOP], 1u);
            const unsigned tg = og / nx;
            if (og + 1u == (tg + 1u) * nx) xb_add(&bar[XB_TOPGEN], 1u);
            else XB_SPIN(xb_ld(&bar[XB_TOPGEN]) == tg, bar);
            __builtin_amdgcn_fence(__ATOMIC_ACQUIRE, "agent");
            xb_add(&bar[XB_XGEN(b.x)], 1u);
            asm volatile("s_waitcnt vmcnt(0)" ::: "memory");
        } else {
            XB_SPIN(xb_ld(&bar[XB_XGEN(b.x)]) == gen, bar);
            __builtin_amdgcn_fence(__ATOMIC_ACQUIRE, "agent");
            asm volatile("s_waitcnt vmcnt(0)" ::: "memory");
        }
    }
    __syncthreads();
}
namespace pg8 {
#define PG8_LAS __attribute__((address_space(3)))
typedef unsigned short bf16_t;
constexpr int BM = 256, BK = 64, HALF = 128, HTB = HALF * BK * 2, STAGE_BYTES = 8 * HTB, NXCD = 8, WGM = 8;

__host__ __device__ __forceinline__ int lds_byte(int r, int c) { const int st = (r >> 4) * 2 + (c >> 5), rr = r & 15, cc = c & 31, ob = rr * 64 + cc * 2; return st * 1024 + (ob ^ (((ob >> 9) & 1) << 5)); }
__host__ __device__ __forceinline__ void stage_rc(int b, int& R, int& C) { const int st = b / 1024, sb = b % 1024, swz = sb ^ (((sb >> 9) & 1) << 5); R = (st >> 1) * 16 + swz / 64; C = (st & 1) * 32 + (swz % 64) / 2; }
__host__ __device__ __forceinline__ int perm32(int rho) { const int n = rho >> 4, i = rho & 15; return 8 * (i >> 2) + 4 * n + (i & 3); }

struct Unit { int pm, pn, ui; long aoff, boff; };
struct Gemm { const bf16_t* A; const bf16_t* Bt; int lda, ldb, K; };

struct StaticOrder {
    int nM, nN, nwg, G, c, lda, ldb, asplit;
    __device__ void init(int M, int N, int lda_, int ldb_, int G_, int c_, int asplit_ = 1 << 20) { nM = M / BM; nN = N / BM; nwg = nM * nN; G = G_; c = c_; lda = lda_; ldb = ldb_; asplit = asplit_; }
    __device__ bool next(int i, Unit& u) const {
        const long L = (long)i * G + c; if (L >= nwg) return false;
        int wgid = (int)L; { const int q = nwg / NXCD, r = nwg % NXCD, xcd = wgid % NXCD, off = wgid / NXCD; wgid = (xcd < r ? xcd * (q + 1) : r * (q + 1) + (xcd - r) * q) + off; }
        const int nig = WGM * nN, gid = wgid / nig, fm = gid * WGM, gsz = (nM - fm) < WGM ? (nM - fm) : WGM;
        u.pm = fm + ((wgid % nig) % gsz); u.pn = (wgid % nig) / gsz;
        u.aoff = (long)u.pm * BM * lda + (u.pn >= asplit ? 128 : 0); u.boff = (long)u.pn * BM * ldb; u.ui = i; return true;
    }
};
struct MoeOrder {
    const PG8_LAS unsigned char* tile_e; int ntile, nN, G, vc, lda, ldb; long estride;
    __device__ bool next(int i, Unit& u) const {
        const long L = (long)i * G + vc; if (L >= (long)ntile * nN) return false;
        u.pm = (int)(L / nN); u.pn = (int)(L % nN);
        const int e = tile_e[u.pm];
        u.aoff = (long)u.pm * BM * lda; u.boff = (long)e * estride + (long)u.pn * BM * ldb; u.ui = i; return true;
    }
};

#ifndef NT_STORE
#define NT_STORE 1
#endif
#ifndef NT_RES
#define NT_RES 0
#endif
#ifndef NT_HEAD
#define NT_HEAD 0
#endif
#ifndef NT_PROJ
#define NT_PROJ 0
#endif
#ifndef NT_SWIGLU
#define NT_SWIGLU 0
#endif
#define EPI_STORE16(nt_, p_, w_) do { if (nt_) __builtin_nontemporal_store((w_), (u32x4*)(p_)); else *(u32x4*)(p_) = (w_); } while (0)
struct EpiStoreBf16 {
    static constexpr bool PERM = true;
    bf16_t* O; int ldc;
    __device__ __forceinline__ void operator()(const f32x4 (&acc)[2][2][4][2], const Unit& u, int wr, int wc, int fr, int fq) const {
        const int row0 = u.pm * BM + wr * 64 + fr; const int col0 = u.pn * BM + wc * 32 + 8 * fq;
#pragma unroll
        for (int ai = 0; ai < 2; ++ai)
#pragma unroll
            for (int m = 0; m < 4; ++m) { bf16_t* rowp = O + (size_t)(row0 + ai * HALF + m * 16) * ldc + col0;
#pragma unroll
                for (int bj = 0; bj < 2; ++bj) { const f32x4 v0 = acc[ai][bj][m][0], v1 = acc[ai][bj][m][1];
                    u32x4 w; w.x = pk2(v0[0], v0[1]); w.y = pk2(v0[2], v0[3]); w.z = pk2(v1[0], v1[1]); w.w = pk2(v1[2], v1[3]);
                    EPI_STORE16(NT_STORE, rowp + bj * HALF, w); } }
    }
};
#define LO2(v_) ((f32x2){(v_)[0], (v_)[1]})
#define HI2(v_) ((f32x2){(v_)[2], (v_)[3]})
__device__ __forceinline__ float sumsq16(const f32x4 a0, const f32x4 a1, const f32x4 b0, const f32x4 b1) {
    f32x2 q = LO2(a0) * LO2(a0); q = HI2(a0) * HI2(a0) + q; q = LO2(a1) * LO2(a1) + q; q = HI2(a1) * HI2(a1) + q;
    f32x2 p = LO2(b0) * LO2(b0); p = HI2(b0) * HI2(b0) + p; p = LO2(b1) * LO2(b1) + p; p = HI2(b1) * HI2(b1) + p;
    q = q + p; return q.x + q.y;
}
__device__ __forceinline__ u32x4 scale_pack8(const f32x4 v0, const f32x4 v1, const f32x2 rs2, const f32x4 g0, const f32x4 g1) {
    const f32x2 a = (LO2(v0) * rs2) * LO2(g0), b = (HI2(v0) * rs2) * HI2(g0), c = (LO2(v1) * rs2) * LO2(g1), d = (HI2(v1) * rs2) * HI2(g1);
    u32x4 w; w.x = pk2(a.x, a.y); w.y = pk2(b.x, b.y); w.z = pk2(c.x, c.y); w.w = pk2(d.x, d.y); return w;
}
#define DPP_ROR8(old_, src_, bank_) __builtin_amdgcn_update_dpp((int)(old_), (int)(src_), 0x128, 0xf, (bank_), false)
struct EpiStoreAdj {
    static constexpr bool PERM = true; static constexpr bool ADJ = true;
    bf16_t* O; int ldc;
    __device__ __forceinline__ void operator()(const f32x4 (&acc)[2][2][4][2], const Unit& u, int wr, int wc, int fr, int fq) const {
        const int half = fr >> 3, r8 = fr & 7;
        bf16_t* base = O + (size_t)(u.pm * BM + wr * 64 + r8) * ldc + u.pn * BM + wc * 64 + half * 32 + 8 * fq;
#pragma unroll
        for (int ai = 0; ai < 2; ++ai)
#pragma unroll
            for (int m = 0; m < 4; ++m) {
                u32x4 w0, w1;
                { const f32x4 v0 = acc[ai][0][m][0], v1 = acc[ai][0][m][1]; w0.x = pk2(v0[0], v0[1]); w0.y = pk2(v0[2], v0[3]); w0.z = pk2(v1[0], v1[1]); w0.w = pk2(v1[2], v1[3]); }
                { const f32x4 v0 = acc[ai][1][m][0], v1 = acc[ai][1][m][1]; w1.x = pk2(v0[0], v0[1]); w1.y = pk2(v0[2], v0[3]); w1.z = pk2(v1[0], v1[1]); w1.w = pk2(v1[2], v1[3]); }
                u32x4 dA, dB;
                dA.x = DPP_ROR8(w0.x, w1.x, 0xc); dA.y = DPP_ROR8(w0.y, w1.y, 0xc); dA.z = DPP_ROR8(w0.z, w1.z, 0xc); dA.w = DPP_ROR8(w0.w, w1.w, 0xc);
                dB.x = DPP_ROR8(w1.x, w0.x, 0x3); dB.y = DPP_ROR8(w1.y, w0.y, 0x3); dB.z = DPP_ROR8(w1.z, w0.z, 0x3); dB.w = DPP_ROR8(w1.w, w0.w, 0x3);
                bf16_t* p = base + (size_t)(ai * HALF + m * 16) * ldc;
                EPI_STORE16(NT_STORE, p, dA); EPI_STORE16(NT_STORE, p + (size_t)8 * ldc, dB); }
    }
};
struct EpiResXB {
    static constexpr bool PERM = true;
    const float* base; bf16_t* out; int ldc;
    __device__ __forceinline__ void operator()(const f32x4 (&acc)[2][2][4][2], const Unit& u, int wr, int wc, int fr, int fq) const {
        const int row0 = u.pm * BM + wr * 64 + fr; const int col0 = u.pn * BM + wc * 32 + 8 * fq;
#pragma unroll
        for (int ai = 0; ai < 2; ++ai)
#pragma unroll
            for (int mp = 0; mp < 2; ++mp) {
                f32x4 b[2][2][2];
#pragma unroll
                for (int mm = 0; mm < 2; ++mm) { const size_t off = (size_t)(row0 + ai * HALF + (2 * mp + mm) * 16) * ldc + col0;
#pragma unroll
                    for (int bj = 0; bj < 2; ++bj) { b[mm][bj][0] = *(const f32x4*)(base + off + bj * HALF); b[mm][bj][1] = *(const f32x4*)(base + off + bj * HALF + 4); } }
                asm volatile("" ::: "memory");
#pragma unroll
                for (int mm = 0; mm < 2; ++mm) { const size_t off = (size_t)(row0 + ai * HALF + (2 * mp + mm) * 16) * ldc + col0;
#pragma unroll
                    for (int bj = 0; bj < 2; ++bj) { const f32x4 v0 = b[mm][bj][0] + acc[ai][bj][2 * mp + mm][0], v1 = b[mm][bj][1] + acc[ai][bj][2 * mp + mm][1];
                        u32x4 w; w.x = pk2(v0[0], v0[1]); w.y = pk2(v0[2], v0[3]); w.z = pk2(v1[0], v1[1]); w.w = pk2(v1[2], v1[3]);
                        EPI_STORE16(NT_RES, out + off + bj * HALF, w); } }
                asm volatile("" ::: "memory");
            }
    }
};
struct EpiResBB {
    static constexpr bool PERM = true;
    bf16_t* io; int ldc;
    __device__ __forceinline__ void operator()(const f32x4 (&acc)[2][2][4][2], const Unit& u, int wr, int wc, int fr, int fq) const {
        const int row0 = u.pm * BM + wr * 64 + fr; const int col0 = u.pn * BM + wc * 32 + 8 * fq;
#pragma unroll
        for (int ai = 0; ai < 2; ++ai) {
            u32x4 b[4][2];
#pragma unroll
            for (int m = 0; m < 4; ++m) { const size_t off = (size_t)(row0 + ai * HALF + m * 16) * ldc + col0;
#pragma unroll
                for (int bj = 0; bj < 2; ++bj) b[m][bj] = *(const u32x4*)(io + off + bj * HALF); }
            asm volatile("" ::: "memory");
#pragma unroll
            for (int m = 0; m < 4; ++m) { const size_t off = (size_t)(row0 + ai * HALF + m * 16) * ldc + col0;
#pragma unroll
                for (int bj = 0; bj < 2; ++bj) { const u32x4 x = b[m][bj]; const f32x4 a0 = acc[ai][bj][m][0], a1 = acc[ai][bj][m][1];
                    u32x4 w; w.x = pk2(bf2f(x.x & 0xffffu) + a0[0], bf2f(x.x >> 16) + a0[1]); w.y = pk2(bf2f(x.y & 0xffffu) + a0[2], bf2f(x.y >> 16) + a0[3]);
                    w.z = pk2(bf2f(x.z & 0xffffu) + a1[0], bf2f(x.z >> 16) + a1[1]); w.w = pk2(bf2f(x.w & 0xffffu) + a1[2], bf2f(x.w >> 16) + a1[3]);
                    EPI_STORE16(NT_RES, io + off + bj * HALF, w); } }
            asm volatile("" ::: "memory");
        }
    }
};
struct EpiResXBA {
    static constexpr bool PERM = true; static constexpr bool ADJ = true;
    const float* base; bf16_t* out; int ldc;
    __device__ __forceinline__ void operator()(const f32x4 (&acc)[2][2][4][2], const Unit& u, int wr, int wc, int fr, int fq) const {
        const int half = fr >> 3, r8 = fr & 7;
        const size_t lo = (size_t)(u.pm * BM + wr * 64 + fr) * ldc + u.pn * BM + wc * 64 + 8 * fq;
        const size_t so = (size_t)(u.pm * BM + wr * 64 + r8) * ldc + u.pn * BM + wc * 64 + half * 32 + 8 * fq;
#pragma unroll
        for (int ai = 0; ai < 2; ++ai)
#pragma unroll
            for (int mp = 0; mp < 2; ++mp) {
                f32x4 b[2][2][2];
#pragma unroll
                for (int mm = 0; mm < 2; ++mm) { const size_t off = lo + (size_t)(ai * HALF + (2 * mp + mm) * 16) * ldc;
#pragma unroll
                    for (int bj = 0; bj < 2; ++bj) { b[mm][bj][0] = *(const f32x4*)(base + off + bj * 32); b[mm][bj][1] = *(const f32x4*)(base + off + bj * 32 + 4); } }
                asm volatile("" ::: "memory");
#pragma unroll
                for (int mm = 0; mm < 2; ++mm) { const int m = 2 * mp + mm; u32x4 w[2];
#pragma unroll
                    for (int bj = 0; bj < 2; ++bj) { const f32x4 v0 = b[mm][bj][0] + acc[ai][bj][m][0], v1 = b[mm][bj][1] + acc[ai][bj][m][1];
                        w[bj].x = pk2(v0[0], v0[1]); w[bj].y = pk2(v0[2], v0[3]); w[bj].z = pk2(v1[0], v1[1]); w[bj].w = pk2(v1[2], v1[3]); }
                    u32x4 dA, dB;
                    dA.x = DPP_ROR8(w[0].x, w[1].x, 0xc); dA.y = DPP_ROR8(w[0].y, w[1].y, 0xc); dA.z = DPP_ROR8(w[0].z, w[1].z, 0xc); dA.w = DPP_ROR8(w[0].w, w[1].w, 0xc);
                    dB.x = DPP_ROR8(w[1].x, w[0].x, 0x3); dB.y = DPP_ROR8(w[1].y, w[0].y, 0x3); dB.z = DPP_ROR8(w[1].z, w[0].z, 0x3); dB.w = DPP_ROR8(w[1].w, w[0].w, 0x3);
                    bf16_t* p = out + so + (size_t)(ai * HALF + m * 16) * ldc;
                    EPI_STORE16(NT_RES, p, dA); EPI_STORE16(NT_RES, p + (size_t)8 * ldc, dB); }
                asm volatile("" ::: "memory");
            }
    }
};
struct EpiResBBA {
    static constexpr bool PERM = true; static constexpr bool ADJ = true;
    bf16_t* io; int ldc;
    __device__ __forceinline__ void operator()(const f32x4 (&acc)[2][2][4][2], const Unit& u, int wr, int wc, int fr, int fq) const {
        const int half = fr >> 3, r8 = fr & 7;
        const size_t lo = (size_t)(u.pm * BM + wr * 64 + fr) * ldc + u.pn * BM + wc * 64 + 8 * fq;
        const size_t so = (size_t)(u.pm * BM + wr * 64 + r8) * ldc + u.pn * BM + wc * 64 + half * 32 + 8 * fq;
#pragma unroll
        for (int ai = 0; ai < 2; ++ai) {
            u32x4 b[4][2];
#pragma unroll
            for (int m = 0; m < 4; ++m) { const size_t off = lo + (size_t)(ai * HALF + m * 16) * ldc;
#pragma unroll
                for (int bj = 0; bj < 2; ++bj) b[m][bj] = *(const u32x4*)(io + off + bj * 32); }
            asm volatile("s_waitcnt vmcnt(0)" ::: "memory");
#pragma unroll
            for (int m = 0; m < 4; ++m) { u32x4 w[2];
#pragma unroll
                for (int bj = 0; bj < 2; ++bj) { const u32x4 x = b[m][bj]; const f32x4 a0 = acc[ai][bj][m][0], a1 = acc[ai][bj][m][1];
                    w[bj].x = pk2(bf2f(x.x & 0xffffu) + a0[0], bf2f(x.x >> 16) + a0[1]); w[bj].y = pk2(bf2f(x.y & 0xffffu) + a0[2], bf2f(x.y >> 16) + a0[3]);
                    w[bj].z = pk2(bf2f(x.z & 0xffffu) + a1[0], bf2f(x.z >> 16) + a1[1]); w[bj].w = pk2(bf2f(x.w & 0xffffu) + a1[2], bf2f(x.w >> 16) + a1[3]); }
                u32x4 dA, dB;
                dA.x = DPP_ROR8(w[0].x, w[1].x, 0xc); dA.y = DPP_ROR8(w[0].y, w[1].y, 0xc); dA.z = DPP_ROR8(w[0].z, w[1].z, 0xc); dA.w = DPP_ROR8(w[0].w, w[1].w, 0xc);
                dB.x = DPP_ROR8(w[1].x, w[0].x, 0x3); dB.y = DPP_ROR8(w[1].y, w[0].y, 0x3); dB.z = DPP_ROR8(w[1].z, w[0].z, 0x3); dB.w = DPP_ROR8(w[1].w, w[0].w, 0x3);
                bf16_t* p = io + so + (size_t)(ai * HALF + m * 16) * ldc;
                EPI_STORE16(NT_RES, p, dA); EPI_STORE16(NT_RES, p + (size_t)8 * ldc, dB); }
            asm volatile("" ::: "memory");
        }
    }
};
struct EpiHeadNorm {
    static constexpr bool PERM = true;
    bf16_t* O; int ldc; const float* qg; const float* kg; float qscale; PG8_LAS float* xch; float eps; int nq, nk;
    const float* rowrs;
    __device__ __forceinline__ void operator()(const f32x4 (&acc)[2][2][4][2], const Unit& u, int wr, int wc, int fr, int fq) const {
        const int row0 = u.pm * BM + wr * 64 + fr; const int col0 = u.pn * BM + wc * 32 + 8 * fq;
        if (u.pn >= nk) {
#pragma unroll
            for (int ai = 0; ai < 2; ++ai)
#pragma unroll
                for (int m = 0; m < 4; ++m) { bf16_t* rowp = O + (size_t)(row0 + ai * HALF + m * 16) * ldc + col0; const float r = rowrs ? rowrs[row0 + ai * HALF + m * 16] : 1.0f;
#pragma unroll
                    for (int bj = 0; bj < 2; ++bj) { const f32x4 v0 = acc[ai][bj][m][0], v1 = acc[ai][bj][m][1];
                        u32x4 w; w.x = pk2(v0[0] * r, v0[1] * r); w.y = pk2(v0[2] * r, v0[3] * r); w.z = pk2(v1[0] * r, v1[1] * r); w.w = pk2(v1[2] * r, v1[3] * r);
                        EPI_STORE16(NT_HEAD, rowp + bj * HALF, w); } }
            return;
        }
        const float* gp = (u.pn < nq ? qg : kg) + 32 * (wc & 1) + 8 * fq; const float sc = u.pn < nq ? qscale : 1.0f;
        const f32x4 g0 = *(const f32x4*)gp, g1 = *(const f32x4*)(gp + 4);
        float ss[2][4][2];
#pragma unroll
        for (int ai = 0; ai < 2; ++ai)
#pragma unroll
            for (int m = 0; m < 4; ++m) { const float r = rowrs ? rowrs[row0 + ai * HALF + m * 16] : 1.0f;
#pragma unroll
                for (int bj = 0; bj < 2; ++bj) { const f32x4 a = acc[ai][bj][m][0], b = acc[ai][bj][m][1];
                    float s = (a[0] * a[0] + a[1] * a[1]) + (a[2] * a[2] + a[3] * a[3]) + (b[0] * b[0] + b[1] * b[1]) + (b[2] * b[2] + b[3] * b[3]);
                    s += __shfl_xor(s, 16); s += __shfl_xor(s, 32);
                    s *= r * r;
                    ss[ai][m][bj] = s;
                    if (fq == 0) xch[((ai * HALF + wr * 64 + m * 16 + fr) * 2 + bj) * 4 + wc] = s; } }
        asm volatile("s_waitcnt lgkmcnt(0)" ::: "memory"); __builtin_amdgcn_s_barrier(); asm volatile("" ::: "memory");
#pragma unroll
        for (int ai = 0; ai < 2; ++ai)
#pragma unroll
            for (int m = 0; m < 4; ++m) { bf16_t* rowp = O + (size_t)(row0 + ai * HALF + m * 16) * ldc + col0; const float r = rowrs ? rowrs[row0 + ai * HALF + m * 16] : 1.0f;
#pragma unroll
                for (int bj = 0; bj < 2; ++bj) { const float tot = ss[ai][m][bj] + xch[((ai * HALF + wr * 64 + m * 16 + fr) * 2 + bj) * 4 + (wc ^ 1)];
                    const float rs = r * sc / sqrtf(tot * (1.0f / 64) + eps);
                    const f32x4 v0 = acc[ai][bj][m][0], v1 = acc[ai][bj][m][1];
                    u32x4 w; w.x = pk2(v0[0] * rs * g0[0], v0[1] * rs * g0[1]); w.y = pk2(v0[2] * rs * g0[2], v0[3] * rs * g0[3]);
                    w.z = pk2(v1[0] * rs * g1[0], v1[1] * rs * g1[1]); w.w = pk2(v1[2] * rs * g1[2], v1[3] * rs * g1[3]);
                    EPI_STORE16(NT_HEAD, rowp + bj * HALF, w); } }
        asm volatile("s_waitcnt lgkmcnt(0)" ::: "memory"); __builtin_amdgcn_s_barrier(); asm volatile("" ::: "memory");
    }
};
struct EpiHeadNormA {
    static constexpr bool PERM = true; static constexpr bool ADJ = true;
    bf16_t* O; int ldc; const float* qg; const float* kg; float qscale; float eps; int nq, nk;
    const float* rowrs;
    __device__ __forceinline__ void operator()(const f32x4 (&acc)[2][2][4][2], const Unit& u, int wr, int wc, int fr, int fq) const {
        const int half = fr >> 3, r8 = fr & 7; const int rowb = u.pm * BM + wr * 64;
        bf16_t* base = O + (size_t)(rowb + r8) * ldc + u.pn * BM + wc * 64 + half * 32 + 8 * fq;
        const bool plain = u.pn >= nk;
        const float* gp = (u.pn < nq ? qg : kg) + 8 * fq; const float sc = u.pn < nq ? qscale : 1.0f;
        f32x4 g00 = {1.f, 1.f, 1.f, 1.f}, g01 = g00, g10 = g00, g11 = g00;
        if (!plain) { g00 = *(const f32x4*)gp; g01 = *(const f32x4*)(gp + 4); g10 = *(const f32x4*)(gp + 32); g11 = *(const f32x4*)(gp + 36); }
#pragma unroll
        for (int ai = 0; ai < 2; ++ai)
#pragma unroll
            for (int m = 0; m < 4; ++m) {
                const float r = rowrs ? rowrs[rowb + ai * HALF + m * 16 + fr] : 1.0f;
                const f32x4 a0 = acc[ai][0][m][0], a1 = acc[ai][0][m][1], b0 = acc[ai][1][m][0], b1 = acc[ai][1][m][1];
                float s = sumsq16(a0, a1, b0, b1);
                s += __shfl_xor(s, 16); s += __shfl_xor(s, 32);
                float rs = r * sc * __builtin_amdgcn_rsqf(s * r * r * (1.0f / 64) + eps); rs = plain ? r : rs;
                const f32x2 rs2 = {rs, rs};
                const u32x4 w0 = scale_pack8(a0, a1, rs2, g00, g01), w1 = scale_pack8(b0, b1, rs2, g10, g11);
                u32x4 dA, dB;
                dA.x = DPP_ROR8(w0.x, w1.x, 0xc); dA.y = DPP_ROR8(w0.y, w1.y, 0xc); dA.z = DPP_ROR8(w0.z, w1.z, 0xc); dA.w = DPP_ROR8(w0.w, w1.w, 0xc);
                dB.x = DPP_ROR8(w1.x, w0.x, 0x3); dB.y = DPP_ROR8(w1.y, w0.y, 0x3); dB.z = DPP_ROR8(w1.z, w0.z, 0x3); dB.w = DPP_ROR8(w1.w, w0.w, 0x3);
                bf16_t* p = base + (size_t)(ai * HALF + m * 16) * ldc;
                EPI_STORE16(NT_HEAD, p, dA); EPI_STORE16(NT_HEAD, p + (size_t)8 * ldc, dB); }
    }
};
struct EpiProjNorm {
    static constexpr bool PERM = true;
    bf16_t* O; int ldc; const float* qa; const float* kva; const float* gq; float qscale; PG8_LAS float* xch; float eps;
    __device__ __forceinline__ void operator()(const f32x4 (&acc)[2][2][4][2], const Unit& u, int wr, int wc, int fr, int fq) const {
        const int row0 = u.pm * BM + wr * 64 + fr; const int col0 = u.pn * BM + wc * 32 + 8 * fq;
        if (u.pn >= 4) {
#pragma unroll
            for (int ai = 0; ai < 2; ++ai)
#pragma unroll
                for (int m = 0; m < 4; ++m) { bf16_t* rowp = O + (size_t)(row0 + ai * HALF + m * 16) * ldc + col0;
#pragma unroll
                    for (int bj = 0; bj < 2; ++bj) { const f32x4 v0 = acc[ai][bj][m][0], v1 = acc[ai][bj][m][1];
                        u32x4 w; w.x = pk2(v0[0], v0[1]); w.y = pk2(v0[2], v0[3]); w.z = pk2(v1[0], v1[1]); w.w = pk2(v1[2], v1[3]);
                        EPI_STORE16(NT_PROJ, rowp + bj * HALF, w); } }
            return;
        }
#pragma unroll
        for (int ai = 0; ai < 2; ++ai)
#pragma unroll
            for (int m = 0; m < 4; ++m)
#pragma unroll
                for (int bj = 0; bj < 2; ++bj) { const f32x4 a = acc[ai][bj][m][0], b = acc[ai][bj][m][1];
                    float s = (a[0] * a[0] + a[1] * a[1]) + (a[2] * a[2] + a[3] * a[3]) + (b[0] * b[0] + b[1] * b[1]) + (b[2] * b[2] + b[3] * b[3]);
                    s += __shfl_xor(s, 16); s += __shfl_xor(s, 32);
                    if (fq == 0) xch[((ai * HALF + wr * 64 + m * 16 + fr) * 2 + bj) * 4 + wc] = s; }
        asm volatile("s_waitcnt lgkmcnt(0)" ::: "memory"); __builtin_amdgcn_s_barrier(); asm volatile("" ::: "memory");
#pragma unroll
        for (int bj = 0; bj < 2; ++bj) {
            const int seg = 2 * u.pn + bj; const bool plain = seg >= 7;
            const float* gp = seg < 2 ? qa + 128 * seg + 32 * wc + 8 * fq : (seg == 2 ? kva + 32 * wc + 8 * fq : gq + 32 * (wc & 1) + 8 * fq);
            f32x4 g0 = *(const f32x4*)gp, g1 = *(const f32x4*)(gp + 4);
            if (plain) { g0 = (f32x4){1.f, 1.f, 1.f, 1.f}; g1 = g0; }
            const float sc = (seg >= 3) ? qscale : 1.0f, invn = seg < 2 ? (1.0f / 256) : (seg == 2 ? (1.0f / 128) : (1.0f / 64));
#pragma unroll
            for (int ai = 0; ai < 2; ++ai)
#pragma unroll
                for (int m = 0; m < 4; ++m) { const int r = ai * HALF + wr * 64 + m * 16 + fr;
                    const f32x4 pa = *(const PG8_LAS f32x4*)(xch + (r * 2 + bj) * 4), pb = *(const PG8_LAS f32x4*)(xch + (r * 2 + (bj ^ 1)) * 4);
                    const float pair = (wc & 2) ? (pa[2] + pa[3]) : (pa[0] + pa[1]), quad = (pa[0] + pa[1]) + (pa[2] + pa[3]), all = quad + ((pb[0] + pb[1]) + (pb[2] + pb[3]));
                    const float tot = seg < 2 ? all : (seg == 2 ? quad : pair);
                    float rs = sc / sqrtf(tot * invn + eps); rs = plain ? 1.0f : rs;
                    const f32x4 v0 = acc[ai][bj][m][0], v1 = acc[ai][bj][m][1];
                    u32x4 w; w.x = pk2(v0[0] * rs * g0[0], v0[1] * rs * g0[1]); w.y = pk2(v0[2] * rs * g0[2], v0[3] * rs * g0[3]);
                    w.z = pk2(v1[0] * rs * g1[0], v1[1] * rs * g1[1]); w.w = pk2(v1[2] * rs * g1[2], v1[3] * rs * g1[3]);
                    EPI_STORE16(NT_PROJ, O + (size_t)(row0 + ai * HALF + m * 16) * ldc + col0 + bj * HALF, w); }
        }
        asm volatile("s_waitcnt lgkmcnt(0)" ::: "memory"); __builtin_amdgcn_s_barrier(); asm volatile("" ::: "memory");
    }
};
struct EpiProjNormA {
    static constexpr bool PERM = true; static constexpr bool ADJ = true;
    bf16_t* O; int ldc; const float* qa; const float* kva; const float* gq; float qscale; PG8_LAS float* xch; float eps;
    __device__ __forceinline__ void operator()(const f32x4 (&acc)[2][2][4][2], const Unit& u, int wr, int wc, int fr, int fq) const {
        const int half = fr >> 3, r8 = fr & 7;
        bf16_t* base = O + (size_t)(u.pm * BM + wr * 64 + r8) * ldc + u.pn * BM + wc * 64 + half * 32 + 8 * fq;
        const int mode = u.pn == 0 ? 3 : ((u.pn == 1 && wc < 2) ? 2 : ((u.pn == 4 || (u.pn == 3 && wc >= 2)) ? 0 : 1));
        if (u.pn < 4) {
#pragma unroll
            for (int ai = 0; ai < 2; ++ai)
#pragma unroll
                for (int m = 0; m < 4; ++m) { const f32x4 a0 = acc[ai][0][m][0], a1 = acc[ai][0][m][1], b0 = acc[ai][1][m][0], b1 = acc[ai][1][m][1];
                    float s = sumsq16(a0, a1, b0, b1);
                    s += __shfl_xor(s, 16); s += __shfl_xor(s, 32);
                    if (fq == 0) xch[(ai * HALF + wr * 64 + m * 16 + fr) * 4 + wc] = s; }
            asm volatile("s_waitcnt lgkmcnt(0)" ::: "memory"); __builtin_amdgcn_s_barrier(); asm volatile("" ::: "memory");
        }
        const float* gp = mode == 3 ? qa + 64 * wc + 8 * fq : (mode == 2 ? kva + 64 * wc + 8 * fq : gq + 8 * fq);
        f32x4 g00 = {1.f, 1.f, 1.f, 1.f}, g01 = g00, g10 = g00, g11 = g00;
        if (mode != 0) { g00 = *(const f32x4*)gp; g01 = *(const f32x4*)(gp + 4); g10 = *(const f32x4*)(gp + 32); g11 = *(const f32x4*)(gp + 36); }
        const float sc = mode == 1 ? qscale : 1.0f, invn = mode == 3 ? (1.0f / 256) : (mode == 2 ? (1.0f / 128) : (1.0f / 64));
#pragma unroll
        for (int ai = 0; ai < 2; ++ai)
#pragma unroll
            for (int m = 0; m < 4; ++m) {
                float rs = 1.0f;
                if (u.pn < 4) { const f32x4 pa = *(const PG8_LAS f32x4*)(xch + (ai * HALF + wr * 64 + m * 16 + fr) * 4);
                    const float lo2 = pa[0] + pa[1], hi2 = pa[2] + pa[3];
                    const float own = wc == 0 ? pa[0] : (wc == 1 ? pa[1] : (wc == 2 ? pa[2] : pa[3]));
                    const float tot = mode == 3 ? lo2 + hi2 : (mode == 2 ? (wc < 2 ? lo2 : hi2) : own);
                    rs = mode == 0 ? 1.0f : sc * __builtin_amdgcn_rsqf(tot * invn + eps); }
                const f32x4 a0 = acc[ai][0][m][0], a1 = acc[ai][0][m][1], b0 = acc[ai][1][m][0], b1 = acc[ai][1][m][1];
                const f32x2 rs2 = {rs, rs};
                const u32x4 w0 = scale_pack8(a0, a1, rs2, g00, g01), w1 = scale_pack8(b0, b1, rs2, g10, g11);
                u32x4 dA, dB;
                dA.x = DPP_ROR8(w0.x, w1.x, 0xc); dA.y = DPP_ROR8(w0.y, w1.y, 0xc); dA.z = DPP_ROR8(w0.z, w1.z, 0xc); dA.w = DPP_ROR8(w0.w, w1.w, 0xc);
                dB.x = DPP_ROR8(w1.x, w0.x, 0x3); dB.y = DPP_ROR8(w1.y, w0.y, 0x3); dB.z = DPP_ROR8(w1.z, w0.z, 0x3); dB.w = DPP_ROR8(w1.w, w0.w, 0x3);
                bf16_t* p = base + (size_t)(ai * HALF + m * 16) * ldc;
                EPI_STORE16(NT_PROJ, p, dA); EPI_STORE16(NT_PROJ, p + (size_t)8 * ldc, dB); }
        if (u.pn < 4) { asm volatile("s_waitcnt lgkmcnt(0)" ::: "memory"); __builtin_amdgcn_s_barrier(); asm volatile("" ::: "memory"); }
    }
};
struct EpiKvNorm {
    static constexpr bool PERM = true;
    bf16_t* O; int ldc; const float* kn; PG8_LAS float* xch; float eps;
    __device__ __forceinline__ void operator()(const f32x4 (&acc)[2][2][4][2], const Unit& u, int wr, int wc, int fr, int fq) const {
        const int row0 = u.pm * BM + wr * 64 + fr; const int col0 = u.pn * BM + wc * 32 + 8 * fq;
        float ss[2][4][2];
#pragma unroll
        for (int ai = 0; ai < 2; ++ai)
#pragma unroll
            for (int m = 0; m < 4; ++m)
#pragma unroll
                for (int bj = 0; bj < 2; ++bj) { const f32x4 a = acc[ai][bj][m][0], b = acc[ai][bj][m][1];
                    float s = (a[0] * a[0] + a[1] * a[1]) + (a[2] * a[2] + a[3] * a[3]) + (b[0] * b[0] + b[1] * b[1]) + (b[2] * b[2] + b[3] * b[3]);
                    s += __shfl_xor(s, 16); s += __shfl_xor(s, 32);
                    ss[ai][m][bj] = s;
                    if (fq == 0) xch[((ai * HALF + wr * 64 + m * 16 + fr) * 2 + bj) * 4 + wc] = s; }
        asm volatile("s_waitcnt lgkmcnt(0)" ::: "memory"); __builtin_amdgcn_s_barrier(); asm volatile("" ::: "memory");
        { const bool nw = wc < 2; const float* gp = kn + 32 * (wc & 1) + 8 * fq; f32x4 g0 = *(const f32x4*)gp, g1 = *(const f32x4*)(gp + 4);
          if (!nw) { g0 = (f32x4){1.f, 1.f, 1.f, 1.f}; g1 = g0; }
#pragma unroll
          for (int ai = 0; ai < 2; ++ai)
#pragma unroll
              for (int m = 0; m < 4; ++m) { bf16_t* rowp = O + (size_t)(row0 + ai * HALF + m * 16) * ldc + col0;
#pragma unroll
                  for (int bj = 0; bj < 2; ++bj) { const float tot = ss[ai][m][bj] + xch[((ai * HALF + wr * 64 + m * 16 + fr) * 2 + bj) * 4 + (wc ^ 1)];
                      const float rs = nw ? 1.0f / sqrtf(tot * (1.0f / 64) + eps) : 1.0f;
                      const f32x4 v0 = acc[ai][bj][m][0], v1 = acc[ai][bj][m][1];
                      u32x4 w; w.x = pk2(v0[0] * rs * g0[0], v0[1] * rs * g0[1]); w.y = pk2(v0[2] * rs * g0[2], v0[3] * rs * g0[3]);
                      w.z = pk2(v1[0] * rs * g1[0], v1[1] * rs * g1[1]); w.w = pk2(v1[2] * rs * g1[2], v1[3] * rs * g1[3]);
                      EPI_STORE16(NT_HEAD, rowp + bj * HALF, w); } } }
        asm volatile("s_waitcnt lgkmcnt(0)" ::: "memory"); __builtin_amdgcn_s_barrier(); asm volatile("" ::: "memory");
    }
};
struct EpiSwiGLU {
    static constexpr bool PERM = true;
    bf16_t* O; int ldc; const PG8_LAS float* rowrs;
    __device__ __forceinline__ void operator()(const f32x4 (&acc)[2][2][4][2], const Unit& u, int wr, int wc, int fr, int fq) const {
        const int row0 = u.pm * BM + wr * 64 + fr; const int col0 = u.pn * HALF + wc * 32 + 8 * fq;
#pragma unroll
        for (int ai = 0; ai < 2; ++ai)
#pragma unroll
            for (int m = 0; m < 4; ++m) { bf16_t* rowp = O + (size_t)(row0 + ai * HALF + m * 16) * ldc + col0;
                const float rs = rowrs[u.ui * 256 + ai * HALF + wr * 64 + m * 16 + fr];
                const float kr_ = -rs * 1.4426950408889634f, rs2_ = rs * rs; const f32x2 kr2 = {kr_, kr_}, rq2 = {rs2_, rs2_}, one2 = {1.0f, 1.0f};
                float a[8];
#pragma unroll
                for (int n = 0; n < 2; ++n)
#pragma unroll
                    for (int j = 0; j < 2; ++j) { const f32x2 g = {acc[ai][0][m][n][2 * j], acc[ai][0][m][n][2 * j + 1]}, up = {acc[ai][1][m][n][2 * j], acc[ai][1][m][n][2 * j + 1]};
                        const f32x2 t = g * kr2; f32x2 d; d.x = __builtin_amdgcn_exp2f(t.x); d.y = __builtin_amdgcn_exp2f(t.y); d = d + one2;
                        f32x2 r; r.x = __builtin_amdgcn_rcpf(d.x); r.y = __builtin_amdgcn_rcpf(d.y);
                        const f32x2 o = ((g * up) * rq2) * r; a[n * 4 + 2 * j] = o.x; a[n * 4 + 2 * j + 1] = o.y; }
                u32x4 w; w.x = pk2(a[0], a[1]); w.y = pk2(a[2], a[3]); w.z = pk2(a[4], a[5]); w.w = pk2(a[6], a[7]);
                EPI_STORE16(NT_SWIGLU, rowp, w); }
    }
};

template <class E, class = void> struct epi_adj_t { static constexpr bool v = false; };
template <class E> struct epi_adj_t<E, decltype((void)E::ADJ)> { static constexpr bool v = E::ADJ; };
template <class E> __device__ __forceinline__ constexpr bool epi_adj() { return epi_adj_t<E>::v; }
template <class Epi, class Sched, bool ALIGN_EPI, bool GATHER = false>
__device__ __forceinline__ void gemm_phase(PG8_LAS unsigned char* lds, const Gemm g, const Sched& S, const Epi& E, const PG8_LAS int* rowtok = nullptr) {
    const int tid = threadIdx.x, wid = __builtin_amdgcn_readfirstlane(tid >> 6), lane = tid & 63, wr = wid >> 2, wc = wid & 3, fr = lane & 15, fq = lane >> 4;
    const int K = g.K, nt = K / BK;
    unsigned voffA[2], voffB[2]; int RA[2], CA[2];
#pragma unroll
    for (int i = 0; i < 2; ++i) { int R, C; stage_rc(tid * 16 + i * 8192, R, C); const int Rb = epi_adj<Epi>() ? (64 * (R >> 5) + perm32(R & 31)) : (Epi::PERM ? ((R & ~31) + perm32(R & 31)) : R);
        voffA[i] = (unsigned)(R * g.lda + C) * 2u; voffB[i] = (unsigned)(Rb * g.ldb + C) * 2u; RA[i] = R; CA[i] = C; }
    unsigned gcur[2][2], gnxt[2][2];
#define PG8_GOFF(dst, u_) do { _Pragma("unroll") for (int h_ = 0; h_ < 2; ++h_) _Pragma("unroll") for (int i_ = 0; i_ < 2; ++i_) \
        dst[h_][i_] = (unsigned)(rowtok[(u_) * 256 + h_ * HALF + RA[i_]] * g.lda + CA[i_]) * 2u; } while (0)
    const char* baseA = (const char*)g.A;

    const size_t kstep = (size_t)(BK * 2);
    const size_t hstepA = (size_t)HALF * g.lda * 2, hstepB = (size_t)(epi_adj<Epi>() ? 32 : HALF) * g.ldb * 2;
    const unsigned ldsw = (unsigned)wid * 1024u;
    const int aoff = lds_byte(wr * 64 + fr, fq * 8), boff = lds_byte(wc * 32 + fr, fq * 8);
#define PG8_SA(b, h) (((b) * 2 + (h)) * HTB)
#define PG8_SB(b, h) ((4 + (b) * 2 + (h)) * HTB)
#define PG8_STAGE(bufoff, gbase, voff) do { _Pragma("unroll") for (int _i = 0; _i < 2; ++_i) \
        __builtin_amdgcn_global_load_lds((const unsigned*)((const char*)(gbase) + (voff)[_i]), (PG8_LAS unsigned*)(lds + (bufoff) + ldsw + _i * 8192), 16, 0, 0); } while (0)
#define PG8_LDA(dst, b, h) do { _Pragma("unroll") for (int m = 0; m < 4; ++m) _Pragma("unroll") for (int k = 0; k < 2; ++k) dst[m][k] = *(const PG8_LAS bf16x8*)(lds + PG8_SA(b, h) + aoff + m * 2048 + k * 1024); } while (0)
#define PG8_LDB(dst, b, h) do { _Pragma("unroll") for (int n = 0; n < 2; ++n) _Pragma("unroll") for (int k = 0; k < 2; ++k) dst[n][k] = *(const PG8_LAS bf16x8*)(lds + PG8_SB(b, h) + boff + n * 2048 + k * 1024); } while (0)
#define PG8_MMA(ai, bj, At, Bt) do { __builtin_amdgcn_s_setprio(1); _Pragma("unroll") for (int m = 0; m < 4; ++m) _Pragma("unroll") for (int n = 0; n < 2; ++n) _Pragma("unroll") for (int k = 0; k < 2; ++k) \
        acc[ai][bj][m][n] = __builtin_amdgcn_mfma_f32_16x16x32_bf16(Bt[n][k], At[m][k], acc[ai][bj][m][n], 0, 0, 0); __builtin_amdgcn_s_setprio(0); } while (0)
#define PG8_WAIT_V(n) asm volatile("s_waitcnt vmcnt(" #n ")" ::: "memory")
#define PG8_WAIT_L(n) asm volatile("s_waitcnt lgkmcnt(" #n ")" ::: "memory")
#define PG8_BAR __builtin_amdgcn_s_barrier()
#define PG8_SCHED __builtin_amdgcn_sched_barrier(0)
    Unit cur, nxt; int ui = 0;
    if (!S.next(0, cur)) return;
    f32x4 acc[2][2][4][2];
#pragma unroll
    for (int a = 0; a < 2; ++a)
#pragma unroll
        for (int b = 0; b < 2; ++b)
#pragma unroll
            for (int m = 0; m < 4; ++m)
#pragma unroll
                for (int n = 0; n < 2; ++n) acc[a][b][m][n] = (f32x4){0.f, 0.f, 0.f, 0.f};
    bf16x8 At[4][2], B0[2][2], B1[2][2];
    const char* cA = (const char*)g.A + (size_t)cur.aoff * 2; const char* cB = (const char*)g.Bt + (size_t)cur.boff * 2;
    if constexpr (GATHER) { PG8_GOFF(gcur, 0); }
    PG8_STAGE(PG8_SB(0, 0), cB, voffB); PG8_STAGE(PG8_SB(0, 1), cB + hstepB, voffB);
    if constexpr (GATHER) { PG8_STAGE(PG8_SA(0, 0), baseA, gcur[0]); PG8_STAGE(PG8_SA(0, 1), baseA, gcur[1]); } else { PG8_STAGE(PG8_SA(0, 0), cA, voffA); PG8_STAGE(PG8_SA(0, 1), cA + hstepA, voffA); }
    if (wr == 1) PG8_BAR;
    PG8_WAIT_V(2); PG8_BAR;
    PG8_STAGE(PG8_SB(1, 0), cB + kstep, voffB);
    if constexpr (GATHER) { PG8_STAGE(PG8_SA(1, 0), baseA + kstep, gcur[0]); } else { PG8_STAGE(PG8_SA(1, 0), cA + kstep, voffA); }
    PG8_STAGE(PG8_SB(1, 1), cB + hstepB + kstep, voffB);
    PG8_WAIT_V(6); PG8_BAR;
    for (;;) {
        const bool has_next = S.next(ui + 1, nxt);
        const char* nA = has_next ? (const char*)g.A + (size_t)nxt.aoff * 2 : cA; const char* nB = has_next ? (const char*)g.Bt + (size_t)nxt.boff * 2 : cB;
        if constexpr (GATHER) { if (has_next) { PG8_GOFF(gnxt, ui + 1); } else { _Pragma("unroll") for (int h_ = 0; h_ < 2; ++h_) _Pragma("unroll") for (int i_ = 0; i_ < 2; ++i_) gnxt[h_][i_] = gcur[h_][i_]; } }
        for (int t = 0; t < nt; t += 2) {
            const bool last = (t == nt - 2);
            const char* a1 = cA + (size_t)(t + 1) * kstep;
            const char* a2 = last ? nA : cA + (size_t)(t + 2) * kstep; const char* b2 = last ? nB : cB + (size_t)(t + 2) * kstep;
            const char* a3 = a2 + kstep; const char* b3 = b2 + kstep;
            unsigned gs[2][2]; size_t k2o = 0;
            if constexpr (GATHER) { _Pragma("unroll") for (int h_ = 0; h_ < 2; ++h_) _Pragma("unroll") for (int i_ = 0; i_ < 2; ++i_) gs[h_][i_] = last ? gnxt[h_][i_] : gcur[h_][i_]; k2o = last ? 0 : (size_t)(t + 2) * kstep; }
            PG8_LDB(B0, 0, 0); PG8_LDB(B1, 0, 1); PG8_SCHED; PG8_LDA(At, 0, 0); if constexpr (GATHER) { PG8_STAGE(PG8_SA(1, 1), baseA + (size_t)(t + 1) * kstep, gcur[1]); } else { PG8_STAGE(PG8_SA(1, 1), a1 + hstepA, voffA); }
            PG8_WAIT_V(8); PG8_WAIT_L(0); PG8_BAR; PG8_MMA(0, 0, At, B0); PG8_MMA(0, 1, At, B1); PG8_BAR; PG8_SCHED;
            PG8_LDA(At, 0, 1); PG8_STAGE(PG8_SB(0, 0), b2, voffB); PG8_STAGE(PG8_SB(0, 1), b2 + hstepB, voffB); if constexpr (GATHER) { PG8_STAGE(PG8_SA(0, 0), baseA + k2o, gs[0]); } else { PG8_STAGE(PG8_SA(0, 0), a2, voffA); }
            PG8_WAIT_V(8); PG8_WAIT_L(0); PG8_BAR; PG8_MMA(1, 0, At, B0); PG8_MMA(1, 1, At, B1); PG8_BAR; PG8_SCHED;
            PG8_LDB(B0, 1, 0); PG8_LDB(B1, 1, 1); PG8_SCHED; PG8_LDA(At, 1, 0); if constexpr (GATHER) { PG8_STAGE(PG8_SA(0, 1), baseA + k2o, gs[1]); } else { PG8_STAGE(PG8_SA(0, 1), a2 + hstepA, voffA); }
            PG8_WAIT_V(8); PG8_WAIT_L(0); PG8_BAR; PG8_MMA(0, 0, At, B0); PG8_MMA(0, 1, At, B1); PG8_BAR; PG8_SCHED;
            PG8_LDA(At, 1, 1); PG8_STAGE(PG8_SB(1, 0), b3, voffB); PG8_STAGE(PG8_SB(1, 1), b3 + hstepB, voffB); if constexpr (GATHER) { PG8_STAGE(PG8_SA(1, 0), baseA + k2o + kstep, gs[0]); } else { PG8_STAGE(PG8_SA(1, 0), a3, voffA); }
            PG8_WAIT_V(8); PG8_WAIT_L(0); PG8_BAR; PG8_MMA(1, 0, At, B0); PG8_MMA(1, 1, At, B1); PG8_BAR; PG8_SCHED;
        }
        if constexpr (ALIGN_EPI) { if (wr == 0) PG8_BAR; }
        E(acc, cur, wr, wc, fr, fq);
        if (!has_next) break;
#pragma unroll
        for (int a = 0; a < 2; ++a)
#pragma unroll
            for (int b = 0; b < 2; ++b)
#pragma unroll
                for (int m = 0; m < 4; ++m)
#pragma unroll
                    for (int n = 0; n < 2; ++n) acc[a][b][m][n] = (f32x4){0.f, 0.f, 0.f, 0.f};
        cur = nxt; cA = nA; cB = nB; ++ui;
        if constexpr (GATHER) { _Pragma("unroll") for (int h_ = 0; h_ < 2; ++h_) _Pragma("unroll") for (int i_ = 0; i_ < 2; ++i_) gcur[h_][i_] = gnxt[h_][i_]; }
        if constexpr (ALIGN_EPI) { if (wr == 1) PG8_BAR; }
    }
    PG8_WAIT_V(0);
    if constexpr (!ALIGN_EPI) { if (wr == 0) PG8_BAR; }
    PG8_BAR;
#undef PG8_GOFF
#undef PG8_SA
#undef PG8_SB
#undef PG8_STAGE
#undef PG8_LDA
#undef PG8_LDB
#undef PG8_MMA
#undef PG8_WAIT_V
#undef PG8_WAIT_L
#undef PG8_BAR
#undef PG8_SCHED
}
}
namespace att {
#ifndef ATT_PRIO
#define ATT_PRIO 1
#endif
constexpr int STAGE_KEYS = 128;
#ifndef ATT_PROBE
#define ATT_PROBE 0
#endif
#ifndef ATT_SG_ON
#define ATT_SG_ON 1
#endif
#ifndef ATT_SG_TRANS
#define ATT_SG_TRANS 2
#endif
#ifndef ATT_SG_VALU
#define ATT_SG_VALU 3
#endif
#ifndef ATT_SG_DSR
#define ATT_SG_DSR 2
#endif
constexpr int KVB = 64, STG = 128;
template <int DQK> struct Lay { static constexpr int NQ = DQK / 16, KP = DQK * 2 + 16, KBYTES = STG * KP; };
constexpr int VBYTES = STG * 64 * 2;
constexpr int L_K = 0;
constexpr int L_V = 53248;
constexpr int L_WS = L_V + 2 * VBYTES;
constexpr int L_OST = L_WS + 8 * 64 * 4;
constexpr int L_BT = L_OST + 8 * 4096;
constexpr int L_END = L_BT + 8192;
static_assert(2 * Lay<96>::KBYTES <= L_V && L_END <= RING_BYTES, "attention LDS map");
typedef short v4i16_t __attribute__((ext_vector_type(4)));
typedef __attribute__((address_space(3))) const char* lds_cptr;

__device__ __forceinline__ int crow(int r, int hi) { return (r & 3) + 8 * (r >> 2) + 4 * hi; }
__device__ __forceinline__ int v_st(int k, int c) { return ((k >> 3) * 2 + (c >> 5)) * 512 + ((k & 7) * 32 + (c & 31)) * 2; }
__device__ __forceinline__ int v_rd_base(int lane) { return ((lane & 3) << 3) | (((lane >> 2) & 3) << 6) | (((lane >> 4) & 1) << 5) | (((lane >> 5) & 1) << 8); }
constexpr int v_rd_off(int d0, int ks, int half) { return d0 * 512 + ks * 2048 + half * 1024; }
__device__ __forceinline__ s16x4 vtr(lds_cptr p) { return __builtin_bit_cast(s16x4, __builtin_amdgcn_ds_read_tr16_b64_v4i16((__attribute__((address_space(3))) v4i16_t*)p)); }
#define ATT_PKV(L, H) (bf16x8){L[0], L[1], L[2], L[3], H[0], H[1], H[2], H[3]}
__device__ __forceinline__ void pv_sub(f32x16 (&o)[2], lds_cptr vb, const bf16x8 (&pa)[4]) {
#pragma unroll
    for (int d0 = 0; d0 < 2; ++d0)
#pragma unroll
        for (int ks = 0; ks < 4; ++ks) { const s16x4 l = vtr(vb + v_rd_off(d0, ks, 0)), h = vtr(vb + v_rd_off(d0, ks, 1));
            o[d0] = __builtin_amdgcn_mfma_f32_32x32x16_bf16(pa[ks], ATT_PKV(l, h), o[d0], 0, 0, 0); }
}

constexpr int U16_K = 0, U16_V = 53248, U16_VP = 144, U16_VB = 128 * U16_VP, U16_WS = U16_V + 2 * U16_VB, U16_OST = U16_WS + 2048;
static_assert(U16_OST + 32768 <= RING_BYTES, "16x16 unit LDS map");
template <int DQK>
__device__ __forceinline__ void attn_unit16(const bf16* Qp, const bf16* Qrp  , int ldq, const bf16* Kn, int ldk, const bf16* Kr, int ldkr, const bf16* Vp, int ldv, bf16* Op, int ldo,
                                            int st0, int st1, float negc, char* shm, const float* qrg  , const float* tabcs, int qpos0) {
    constexpr int NKS = DQK / 32, KP = DQK * 2 + 16, KBY = 128 * KP;
    static_assert(2 * KBY <= U16_V, "K ring");
    const int tid = threadIdx.x, lane = tid & 63, i16 = lane & 15, g = lane >> 4; const int wid = __builtin_amdgcn_readfirstlane(tid >> 6);
    char* K_lds = shm + U16_K; char* V_lds = shm + U16_V;
    float* wsf = (float*)(shm + U16_WS) + wid * 64;
    bf16x8 qr[2][NKS];
#pragma unroll
    for (int qb = 0; qb < 2; ++qb) { const size_t ro = (size_t)(wid * 32 + qb * 16 + i16) * ldq + g * 8;
#pragma unroll
        for (int ks = 0; ks < NKS; ++ks) qr[qb][ks] = (DQK == 96 && ks == 2) ? *reinterpret_cast<const bf16x8*>(Qrp + ro) : *reinterpret_cast<const bf16x8*>(Qp + ro + ks * 32); }
    if constexpr (DQK == 96) { if (qrg != nullptr) {
        float gq[8]; { const f32x4 a_ = *(const f32x4*)(qrg + 8 * g), b_ = *(const f32x4*)(qrg + 8 * g + 4); gq[0] = a_[0]; gq[1] = a_[1]; gq[2] = a_[2]; gq[3] = a_[3]; gq[4] = b_[0]; gq[5] = b_[1]; gq[6] = b_[2]; gq[7] = b_[3]; }
        const float sA_ = 0.10206207261596577f * LOG2E; const bool lo_ = g < 2;
#pragma unroll
        for (int qb = 0; qb < 2; ++qb) { const int pos = qpos0 + wid * 32 + qb * 16 + i16;
            const f32x4* tp = (const f32x4*)(tabcs + ((size_t)pos * 16 + 8 * (g & 1)) * 2); const f32x4 t0 = tp[0], t1 = tp[1], t2 = tp[2], t3 = tp[3];
            const float cs[8] = {t0[0], t0[2], t1[0], t1[2], t2[0], t2[2], t3[0], t3[2]}, sn[8] = {t0[1], t0[3], t1[1], t1[3], t2[1], t2[3], t3[1], t3[3]};
            const u32x4 raw = __builtin_bit_cast(u32x4, qr[qb][2]);
            float x[8] = {bf2f(raw.x & 0xffffu), bf2f(raw.x >> 16), bf2f(raw.y & 0xffffu), bf2f(raw.y >> 16), bf2f(raw.z & 0xffffu), bf2f(raw.z >> 16), bf2f(raw.w & 0xffffu), bf2f(raw.w >> 16)};
            float ss = 0.f;
#pragma unroll
            for (int e = 0; e < 8; ++e) ss += x[e] * x[e];
            ss += __shfl_xor(ss, 16); ss += __shfl_xor(ss, 32);
            const float rs = 1.0f / sqrtf(ss * (1.0f / 32) + EPS);
            float o8[8];
#pragma unroll
            for (int e = 0; e < 8; ++e) { const float y = x[e] * rs * gq[e]; const float yp = __shfl_xor(y, 32); o8[e] = (lo_ ? (y * cs[e] - yp * sn[e]) : (y * cs[e] + yp * sn[e])) * sA_; }
            u32x4 w; w.x = pk2(o8[0], o8[1]); w.y = pk2(o8[2], o8[3]); w.z = pk2(o8[4], o8[5]); w.w = pk2(o8[6], o8[7]);
            qr[qb][2] = __builtin_bit_cast(bf16x8, w); } } }
    const int srow = tid >> 3, sc = tid & 7;
    const bf16* kn_src = Kn + (size_t)srow * ldk + sc * 8;
    const bf16* v_src = Vp + (size_t)srow * ldv + sc * 8;
    const bf16* kr_src = (DQK == 96) ? (Kr + (size_t)(tid >> 2) * ldkr + (tid & 3) * 8) : nullptr;
    const int kn_dst = srow * KP + sc * 16, kr_dst = (tid >> 2) * KP + 128 + (tid & 3) * 16, v_dst = srow * U16_VP + sc * 16;
    const char* kfr = K_lds + i16 * KP + g * 16;
    const lds_cptr vfr = (lds_cptr)(V_lds) + (4 * g + (i16 >> 2)) * U16_VP + (i16 & 3) * 8;
    bf16x8 s_kn0, s_kn1, s_kr, s_v0, s_v1;
#define U_LOAD(t) do { const size_t k0_ = (size_t)(t) * 128; s_kn0 = *reinterpret_cast<const bf16x8*>(kn_src + k0_ * ldk); s_kn1 = *reinterpret_cast<const bf16x8*>(kn_src + (k0_ + 64) * ldk); \
        s_v0 = *reinterpret_cast<const bf16x8*>(v_src + k0_ * ldv); s_v1 = *reinterpret_cast<const bf16x8*>(v_src + (k0_ + 64) * ldv); \
        if (DQK == 96) { s_kr = *reinterpret_cast<const bf16x8*>(kr_src + k0_ * ldkr); } } while (0)
#define U_WRITE(b) do { *reinterpret_cast<bf16x8*>(K_lds + (b) * KBY + kn_dst) = s_kn0; *reinterpret_cast<bf16x8*>(K_lds + (b) * KBY + 64 * KP + kn_dst) = s_kn1; \
        *reinterpret_cast<bf16x8*>(V_lds + (b) * U16_VB + v_dst) = s_v0; *reinterpret_cast<bf16x8*>(V_lds + (b) * U16_VB + 64 * U16_VP + v_dst) = s_v1; \
        if (DQK == 96) { *reinterpret_cast<bf16x8*>(K_lds + (b) * KBY + kr_dst) = s_kr; } } while (0)
    f32x4 o[2][4];
#pragma unroll
    for (int qb = 0; qb < 2; ++qb)
#pragma unroll
        for (int d = 0; d < 4; ++d) o[qb][d] = (f32x4){0.f, 0.f, 0.f, 0.f};
    float lsum0 = 0.f, lsum1 = 0.f;
    U_LOAD(st0); U_WRITE(0); __syncthreads();
#if ATT_PRIO
    if (wid >= 4) __builtin_amdgcn_s_setprio(1);
#endif
    for (int t = st0; t < st1; ++t) {
        const int cur = (t - st0) & 1;
        { const int tn_ = (t + 1 < st1) ? t + 1 : t; U_LOAD(tn_); }
#pragma unroll
        for (int sub = 0; sub < 2; ++sub) {
            f32x4 s[2][4];
#pragma unroll
            for (int qb = 0; qb < 2; ++qb)
#pragma unroll
                for (int kb = 0; kb < 4; ++kb) s[qb][kb] = (f32x4){negc, negc, negc, negc};
            { const char* kb_ = kfr + cur * KBY + (sub * 64) * KP;
#pragma unroll
              for (int ks = 0; ks < NKS; ++ks)
#pragma unroll
                  for (int kb = 0; kb < 4; ++kb) { const bf16x8 kf = *reinterpret_cast<const bf16x8*>(kb_ + kb * 16 * KP + ks * 64);
                      s[0][kb] = __builtin_amdgcn_mfma_f32_16x16x32_bf16(kf, qr[0][ks], s[0][kb], 0, 0, 0);
                      s[1][kb] = __builtin_amdgcn_mfma_f32_16x16x32_bf16(kf, qr[1][ks], s[1][kb], 0, 0, 0); } }
#pragma unroll
            for (int qb = 0; qb < 2; ++qb)
#pragma unroll
                for (int kb = 0; kb < 4; ++kb) { s[qb][kb][0] = __builtin_amdgcn_exp2f(s[qb][kb][0]); s[qb][kb][1] = __builtin_amdgcn_exp2f(s[qb][kb][1]);
                    s[qb][kb][2] = __builtin_amdgcn_exp2f(s[qb][kb][2]); s[qb][kb][3] = __builtin_amdgcn_exp2f(s[qb][kb][3]); }
            { float a0 = 0.f, a1 = 0.f;
#pragma unroll
              for (int kb = 0; kb < 4; ++kb) { a0 += (s[0][kb][0] + s[0][kb][1]) + (s[0][kb][2] + s[0][kb][3]); a1 += (s[1][kb][0] + s[1][kb][1]) + (s[1][kb][2] + s[1][kb][3]); }
              lsum0 += a0; lsum1 += a1; }
            bf16x8 pa[2][2];
#pragma unroll
            for (int qb = 0; qb < 2; ++qb)
#pragma unroll
                for (int kp = 0; kp < 2; ++kp) { u32x4 w; w.x = pk2(s[qb][2 * kp][0], s[qb][2 * kp][1]); w.y = pk2(s[qb][2 * kp][2], s[qb][2 * kp][3]);
                    w.z = pk2(s[qb][2 * kp + 1][0], s[qb][2 * kp + 1][1]); w.w = pk2(s[qb][2 * kp + 1][2], s[qb][2 * kp + 1][3]); pa[qb][kp] = *reinterpret_cast<bf16x8*>(&w); }
            { const lds_cptr vb_ = vfr + cur * U16_VB + (sub * 64) * U16_VP;
#pragma unroll
              for (int kp = 0; kp < 2; ++kp)
#pragma unroll
                  for (int d = 0; d < 4; ++d) { const s16x4 l = vtr(vb_ + (2 * kp) * 16 * U16_VP + d * 32), h = vtr(vb_ + (2 * kp + 1) * 16 * U16_VP + d * 32);
                      const bf16x8 vf = ATT_PKV(l, h);
                      o[0][d] = __builtin_amdgcn_mfma_f32_16x16x32_bf16(pa[0][kp], vf, o[0][d], 0, 0, 0);
                      o[1][d] = __builtin_amdgcn_mfma_f32_16x16x32_bf16(pa[1][kp], vf, o[1][d], 0, 0, 0); } }
        }
        U_WRITE(cur ^ 1);
        __syncthreads();
    }
#if ATT_PRIO
    __builtin_amdgcn_s_setprio(0);
#endif
#undef U_LOAD
#undef U_WRITE
    lsum0 += __shfl_xor(lsum0, 16); lsum0 += __shfl_xor(lsum0, 32); lsum1 += __shfl_xor(lsum1, 16); lsum1 += __shfl_xor(lsum1, 32);
    if (g == 0) { wsf[i16] = lsum0; wsf[16 + i16] = lsum1; }
    LDS_WAIT();
    { bf16* stg = (bf16*)(shm + U16_OST) + wid * 2048;
#pragma unroll
      for (int qb = 0; qb < 2; ++qb)
#pragma unroll
          for (int r = 0; r < 4; ++r) { const int q = 16 * qb + 4 * g + r; const float rl = __builtin_amdgcn_rcpf(wsf[q]);
#pragma unroll
              for (int d = 0; d < 4; ++d) stg[q * 64 + 16 * d + i16] = (bf16)f2bf(o[qb][d][r] * rl); }
      LDS_WAIT();
      bf16* Ow = Op + (size_t)(wid * 32) * ldo;
#pragma unroll
      for (int i = 0; i < 4; ++i) { const int row = i * 8 + (lane >> 3), ch = lane & 7; const u32x4 v = *(const u32x4*)(stg + row * 64 + ch * 8); *(u32x4*)(Ow + (size_t)row * ldo + ch * 8) = v; } }
    __syncthreads();
}

constexpr int WBT_OFF = MISC_OFF + 64, WBT_LEN = 480, WBT_ZERO = 240;
static_assert(WBT_OFF + 16 * WBT_LEN * 4 <= LDS_BYTES, "window bias tables");
__device__ __forceinline__ void win_bias_tables(char* shm, const float* gtab, float negc) {
    float* T = (float*)(shm + WBT_OFF);
    for (int i = threadIdx.x; i < 16 * WBT_LEN; i += blockDim.x) { const int hs = i / WBT_LEN, j = i - hs * WBT_LEN, h = hs >> 2, sft = hs & 3;
        T[i] = gtab[h * 512 + (j + sft - WBT_ZERO + 256)] + negc; }
}
#ifndef ATT_MSUM_A
#define ATT_MSUM_A 1
#endif
#ifndef ATT_MSUM
#define ATT_MSUM 1
#endif
#ifndef ATT_NT
#define ATT_NT 1
#endif
template <int DQK, bool WIN = false>
__device__ __forceinline__ void attn_unit16w(const bf16* Qp, const bf16* Qrp, int ldq, const bf16* Kn, int ldk, const bf16* Kr, int ldkr, const bf16* Vp, int ldv, bf16* Op, int ldo, int st0, int st1, float negc, char* shm,
                                             const float* qrg, const float* tabcs, int qpos0, const float* btab = nullptr, const float* sinkp = nullptr) {
    constexpr int NKS = DQK / 32, KP = DQK * 2 + 16, KBY = 128 * KP, NQB = 4;
    const int tid = threadIdx.x, lane = tid & 63, i16 = lane & 15, g = lane >> 4; const int wid = __builtin_amdgcn_readfirstlane(tid >> 6);
    char* K_lds = shm + U16_K; char* V_lds = shm + U16_V;
    float* wsf = (float*)(shm + U16_WS) + wid * 64;
    const int wrow = WIN ? (wid >> 2) * 64 : wid * 64, hcol = WIN ? (wid & 3) * 64 : 0;
    static_assert(!WIN || DQK == 64, "window unit");
    const int qw = qpos0 + wrow;
    const float* wbt = (const float*)(shm + WBT_OFF) + (((wid & 3) * 4 + ((-i16) & 3)) * WBT_LEN) + (4 * g - (qw + i16) + WBT_ZERO - ((-i16) & 3));
    (void)btab;
    bf16x8 qr[NQB][NKS];
#pragma unroll
    for (int qb = 0; qb < NQB; ++qb) { const size_t ro = (size_t)(wrow + qb * 16 + i16) * ldq + hcol + g * 8;
#pragma unroll
        for (int ks = 0; ks < NKS; ++ks) { const bf16x8* qp_ = (DQK == 96 && ks == 2) ? reinterpret_cast<const bf16x8*>(Qrp + ro) : reinterpret_cast<const bf16x8*>(Qp + ro + ks * 32);
            qr[qb][ks] = ATT_NT ? __builtin_nontemporal_load(qp_) : *qp_; } }
    if constexpr (DQK == 96) { if (qrg != nullptr) {
        float gq[8]; { const f32x4 a_ = *(const f32x4*)(qrg + 8 * g), b_ = *(const f32x4*)(qrg + 8 * g + 4); gq[0] = a_[0]; gq[1] = a_[1]; gq[2] = a_[2]; gq[3] = a_[3]; gq[4] = b_[0]; gq[5] = b_[1]; gq[6] = b_[2]; gq[7] = b_[3]; }
        const float sA_ = 0.10206207261596577f * LOG2E; const bool lo_ = g < 2;
#pragma unroll
        for (int qb = 0; qb < NQB; ++qb) { const int pos = qpos0 + wid * 64 + qb * 16 + i16;
            const f32x4* tp = (const f32x4*)(tabcs + ((size_t)pos * 16 + 8 * (g & 1)) * 2); const f32x4 t0 = tp[0], t1 = tp[1], t2 = tp[2], t3 = tp[3];
            const float cs[8] = {t0[0], t0[2], t1[0], t1[2], t2[0], t2[2], t3[0], t3[2]}, sn[8] = {t0[1], t0[3], t1[1], t1[3], t2[1], t2[3], t3[1], t3[3]};
            const u32x4 raw = __builtin_bit_cast(u32x4, qr[qb][2]);
            float x[8] = {bf2f(raw.x & 0xffffu), bf2f(raw.x >> 16), bf2f(raw.y & 0xffffu), bf2f(raw.y >> 16), bf2f(raw.z & 0xffffu), bf2f(raw.z >> 16), bf2f(raw.w & 0xffffu), bf2f(raw.w >> 16)};
            float ss = 0.f;
#pragma unroll
            for (int e = 0; e < 8; ++e) ss += x[e] * x[e];
            ss += __shfl_xor(ss, 16); ss += __shfl_xor(ss, 32);
            const float rs = 1.0f / sqrtf(ss * (1.0f / 32) + EPS);
            float o8[8];
#pragma unroll
            for (int e = 0; e < 8; ++e) { const float y = x[e] * rs * gq[e]; const float yp = __shfl_xor(y, 32); o8[e] = (lo_ ? (y * cs[e] - yp * sn[e]) : (y * cs[e] + yp * sn[e])) * sA_; }
            u32x4 w; w.x = pk2(o8[0], o8[1]); w.y = pk2(o8[2], o8[3]); w.z = pk2(o8[4], o8[5]); w.w = pk2(o8[6], o8[7]);
            qr[qb][2] = __builtin_bit_cast(bf16x8, w); } } }
    if constexpr (DQK == 64 && !WIN) { if (tabcs != nullptr) {
        const bool lo_ = g < 2;
#pragma unroll
        for (int qb = 0; qb < NQB; ++qb) { const int s_ = qpos0 + wid * 64 + qb * 16 + i16;
#pragma unroll
            for (int ks = 0; ks < 2; ++ks) { const int pos = ks ? (s_ & 63) : (s_ >> 6);
                const f32x4* tp = (const f32x4*)(tabcs + ((size_t)pos * 16 + 8 * (g & 1)) * 2); const f32x4 t0 = tp[0], t1 = tp[1], t2 = tp[2], t3 = tp[3];
                const float cs[8] = {t0[0], t0[2], t1[0], t1[2], t2[0], t2[2], t3[0], t3[2]}, sn[8] = {t0[1], t0[3], t1[1], t1[3], t2[1], t2[3], t3[1], t3[3]};
                const u32x4 raw = __builtin_bit_cast(u32x4, qr[qb][ks]);
                const float x[8] = {bf2f(raw.x & 0xffffu), bf2f(raw.x >> 16), bf2f(raw.y & 0xffffu), bf2f(raw.y >> 16), bf2f(raw.z & 0xffffu), bf2f(raw.z >> 16), bf2f(raw.w & 0xffffu), bf2f(raw.w >> 16)};
                float o8[8];
#pragma unroll
                for (int e = 0; e < 8; ++e) { const float yp = __shfl_xor(x[e], 32); o8[e] = lo_ ? (x[e] * cs[e] - yp * sn[e]) : (x[e] * cs[e] + yp * sn[e]); }
                u32x4 w; w.x = pk2(o8[0], o8[1]); w.y = pk2(o8[2], o8[3]); w.z = pk2(o8[4], o8[5]); w.w = pk2(o8[6], o8[7]);
                qr[qb][ks] = __builtin_bit_cast(bf16x8, w); } } } }
    const int srow = tid >> 3, sc = tid & 7;
    const bf16* kn_src = Kn + (size_t)srow * ldk + sc * 8;
    const bf16* v_src = Vp + (size_t)srow * ldv + sc * 8;
    const bf16* kr_src = (DQK == 96) ? (Kr + (size_t)(tid >> 2) * ldkr + (tid & 3) * 8) : nullptr;
    const int kn_dst = srow * KP + sc * 16, kr_dst = (tid >> 2) * KP + 128 + (tid & 3) * 16, v_dst = srow * U16_VP + sc * 16;
    const char* kfr = K_lds + i16 * KP + g * 16;
    const lds_cptr vfr = (lds_cptr)(V_lds) + (4 * g + (i16 >> 2)) * U16_VP + (i16 & 3) * 8;
    bf16x8 s_kn0, s_kr, s_v0;
#define W_LOADA(t) do { const size_t k0_ = (size_t)(t) * 128; s_kn0 = *reinterpret_cast<const bf16x8*>(kn_src + k0_ * ldk); s_v0 = *reinterpret_cast<const bf16x8*>(v_src + k0_ * ldv); \
        if (DQK == 96) { s_kr = *reinterpret_cast<const bf16x8*>(kr_src + k0_ * ldkr); } } while (0)
#define W_WRITEA(b) do { *reinterpret_cast<bf16x8*>(K_lds + (b) * KBY + kn_dst) = s_kn0; *reinterpret_cast<bf16x8*>(V_lds + (b) * U16_VB + v_dst) = s_v0; \
        if (DQK == 96) { *reinterpret_cast<bf16x8*>(K_lds + (b) * KBY + kr_dst) = s_kr; } } while (0)
#define W_LOADB(t) do { const size_t k0_ = (size_t)(t) * 128 + 64; s_kn0 = *reinterpret_cast<const bf16x8*>(kn_src + k0_ * ldk); s_v0 = *reinterpret_cast<const bf16x8*>(v_src + k0_ * ldv); } while (0)
#define W_WRITEB(b) do { *reinterpret_cast<bf16x8*>(K_lds + (b) * KBY + 64 * KP + kn_dst) = s_kn0; *reinterpret_cast<bf16x8*>(V_lds + (b) * U16_VB + 64 * U16_VP + v_dst) = s_v0; } while (0)
    f32x4 o[NQB][4];
#pragma unroll
    for (int qb = 0; qb < NQB; ++qb)
#pragma unroll
        for (int d = 0; d < 4; ++d) o[qb][d] = (f32x4){0.f, 0.f, 0.f, 0.f};
    constexpr bool MSUM = ATT_MSUM && (DQK == 64 || ATT_MSUM_A);
    float lsum[NQB] = {0.f, 0.f, 0.f, 0.f};
    f32x4 ol[NQB];
#pragma unroll
    for (int qb = 0; qb < NQB; ++qb) ol[qb] = (f32x4){0.f, 0.f, 0.f, 0.f};
    const bf16x8 ones8 = {(short)0x3F80, (short)0x3F80, (short)0x3F80, (short)0x3F80, (short)0x3F80, (short)0x3F80, (short)0x3F80, (short)0x3F80};
    W_LOADA(st0); W_WRITEA(0); W_LOADB(st0); W_WRITEB(0); __syncthreads();
#if ATT_PRIO
    if (wid >= 4) __builtin_amdgcn_s_setprio(1);
#endif
    for (int t = st0; t < st1; ++t) {
        const int cur = (t - st0) & 1;
        const int tn_ = (t + 1 < st1) ? t + 1 : t; W_LOADA(tn_);
#pragma unroll
        for (int sub = 0; sub < 2; ++sub) {
            if (sub == 1) { W_WRITEA(cur ^ 1); W_LOADB(tn_); }
            const char* kb_ = kfr + cur * KBY + (sub * 64) * KP; const lds_cptr vb_ = vfr + cur * U16_VB + (sub * 64) * U16_VP;
#pragma unroll
            for (int kp = 0; kp < 2; ++kp) {
                const int k0 = t * 128 + sub * 64 + kp * 32;
                if (WIN && !((k0 + 31 >= qw - 128) && (k0 <= qw + 191))) continue;
                f32x4 s[NQB][2];
#pragma unroll
                for (int qb = 0; qb < NQB; ++qb)
#pragma unroll
                    for (int kl = 0; kl < 2; ++kl) { if constexpr (WIN) s[qb][kl] = *reinterpret_cast<const f32x4*>(wbt + k0 + 16 * kl - 16 * qb); else s[qb][kl] = (f32x4){negc, negc, negc, negc}; }
#pragma unroll
                for (int ks = 0; ks < NKS; ++ks)
#pragma unroll
                    for (int kl = 0; kl < 2; ++kl) { const bf16x8 kf = *reinterpret_cast<const bf16x8*>(kb_ + (2 * kp + kl) * 16 * KP + ks * 64);
#pragma unroll
                        for (int qb = 0; qb < NQB; ++qb) s[qb][kl] = __builtin_amdgcn_mfma_f32_16x16x32_bf16(kf, qr[qb][ks], s[qb][kl], 0, 0, 0); }
                bf16x8 pa[NQB];
#pragma unroll
                for (int qb = 0; qb < NQB; ++qb) {
#pragma unroll
                    for (int kl = 0; kl < 2; ++kl) { s[qb][kl][0] = __builtin_amdgcn_exp2f(s[qb][kl][0]); s[qb][kl][1] = __builtin_amdgcn_exp2f(s[qb][kl][1]);
                        s[qb][kl][2] = __builtin_amdgcn_exp2f(s[qb][kl][2]); s[qb][kl][3] = __builtin_amdgcn_exp2f(s[qb][kl][3]); }
                    if constexpr (!MSUM) lsum[qb] += ((s[qb][0][0] + s[qb][0][1]) + (s[qb][0][2] + s[qb][0][3])) + ((s[qb][1][0] + s[qb][1][1]) + (s[qb][1][2] + s[qb][1][3]));
                    u32x4 w; w.x = pk2(s[qb][0][0], s[qb][0][1]); w.y = pk2(s[qb][0][2], s[qb][0][3]); w.z = pk2(s[qb][1][0], s[qb][1][1]); w.w = pk2(s[qb][1][2], s[qb][1][3]);
                    pa[qb] = *reinterpret_cast<bf16x8*>(&w); }
#pragma unroll
                for (int d = 0; d < 4; ++d) { const s16x4 l = vtr(vb_ + (2 * kp) * 16 * U16_VP + d * 32), h = vtr(vb_ + (2 * kp + 1) * 16 * U16_VP + d * 32);
                    const bf16x8 vf = ATT_PKV(l, h);
#pragma unroll
                    for (int qb = 0; qb < NQB; ++qb) o[qb][d] = __builtin_amdgcn_mfma_f32_16x16x32_bf16(pa[qb], vf, o[qb][d], 0, 0, 0); }
                if constexpr (MSUM) {
#pragma unroll
                    for (int qb = 0; qb < NQB; ++qb) ol[qb] = __builtin_amdgcn_mfma_f32_16x16x32_bf16(pa[qb], ones8, ol[qb], 0, 0, 0); }
            }
        }
        W_WRITEB(cur ^ 1);
        __syncthreads();
    }
#if ATT_PRIO
    __builtin_amdgcn_s_setprio(0);
#endif
#undef W_LOADA
#undef W_WRITEA
#undef W_LOADB
#undef W_WRITEB
    if constexpr (!MSUM) {
#pragma unroll
        for (int qb = 0; qb < NQB; ++qb) { lsum[qb] += __shfl_xor(lsum[qb], 16); lsum[qb] += __shfl_xor(lsum[qb], 32); if constexpr (WIN) lsum[qb] += __builtin_amdgcn_exp2f(sinkp[wid & 3] + negc); }
        if (g == 0) {
#pragma unroll
            for (int qb = 0; qb < NQB; ++qb) wsf[16 * qb + i16] = lsum[qb];
        }
        LDS_WAIT();
    } else if constexpr (WIN) { const float sk_ = __builtin_amdgcn_exp2f(sinkp[wid & 3] + negc);
#pragma unroll
        for (int qb = 0; qb < NQB; ++qb) { ol[qb][0] += sk_; ol[qb][1] += sk_; ol[qb][2] += sk_; ol[qb][3] += sk_; } }
    { bf16* stg = (bf16*)(shm + U16_OST) + wid * 2048;
#pragma unroll
      for (int hb = 0; hb < 2; ++hb) {
#pragma unroll
          for (int qq = 0; qq < 2; ++qq)
#pragma unroll
              for (int r = 0; r < 4; ++r) { const int qb = 2 * hb + qq; const int ql = 16 * qq + 4 * g + r; const float rl = __builtin_amdgcn_rcpf(MSUM ? ol[qb][r] : wsf[32 * hb + ql]);
#pragma unroll
                  for (int d = 0; d < 4; ++d) stg[ql * 64 + 16 * d + i16] = (bf16)f2bf(o[qb][d][r] * rl); }
          LDS_WAIT();
          bf16* Ow = Op + (size_t)(wrow + 32 * hb) * ldo + hcol;
#pragma unroll
          for (int i = 0; i < 4; ++i) { const int row = i * 8 + (lane >> 3), ch = lane & 7; const u32x4 v = *(const u32x4*)(stg + row * 64 + ch * 8); if (ATT_NT) __builtin_nontemporal_store(v, (u32x4*)(Ow + (size_t)row * ldo + ch * 8)); else *(u32x4*)(Ow + (size_t)row * ldo + ch * 8) = v; }
          LDS_WAIT(); asm volatile("" ::: "memory");
      } }
    __syncthreads();
}

template <int DQK, bool WIN>
__device__ __forceinline__ void attn_unit(const bf16* Qp, int ldq, const bf16* Kn, int ldk, const bf16* Kr, int ldkr, const bf16* Vp, int ldv, bf16* Op, int ldo,
                                          int st0, int st1, float negc, int q0, const float* btab, const float* sinkp, char* shm, unsigned long long& tsync) {
    constexpr int NQ = Lay<DQK>::NQ, KP = Lay<DQK>::KP, KBYTES = Lay<DQK>::KBYTES;
    const int tid = threadIdx.x, lane = tid & 63, r32 = lane & 31, hi = lane >> 5; const int wid = __builtin_amdgcn_readfirstlane(tid >> 6);
    char* K_lds = shm + L_K; char* V_lds = shm + L_V;
    float* wsf = (float*)(shm + L_WS) + wid * 64;
    const int wrow = WIN ? (wid >> 2) * 32 : wid * 32, hcol = WIN ? (wid & 3) * 64 : 0;
    const float* bt = (const float*)(shm + L_BT) + (WIN ? (wid & 3) * 512 : 0);
    if constexpr (WIN) { _Pragma("unroll") for (int k_ = 0; k_ < 4; ++k_) ((float*)(shm + L_BT))[tid + 512 * k_] = btab[tid + 512 * k_]; }
    bf16x8 qr[NQ];
    { const bf16* Qw = Qp + (size_t)(wrow + r32) * ldq + hcol + hi * 8;
#pragma unroll
      for (int d0 = 0; d0 < NQ; ++d0) qr[d0] = *reinterpret_cast<const bf16x8*>(Qw + d0 * 16); }
    const int srow = tid >> 3, sc = tid & 7;
    const bf16* kn_src = Kn + (size_t)srow * ldk + sc * 8;
    const bf16* v_src = Vp + (size_t)srow * ldv + sc * 8;
    const bf16* kr_src = (DQK == 96) ? (Kr + (size_t)(tid >> 2) * ldkr + (tid & 3) * 8) : nullptr;
    const int kn_dst = srow * KP + sc * 16, kr_dst = (tid >> 2) * KP + 128 + (tid & 3) * 16, v_dst = v_st(srow, sc * 8);
    const lds_cptr vb0 = (lds_cptr)(V_lds) + v_rd_base(lane);
    bf16x8 s_kn0, s_kn1, s_kr, s_v0, s_v1;
#define ATT_LOAD(t) do { const size_t k0_ = (size_t)(t) * STG; s_kn0 = *reinterpret_cast<const bf16x8*>(kn_src + k0_ * ldk); s_kn1 = *reinterpret_cast<const bf16x8*>(kn_src + (k0_ + 64) * ldk); \
        s_v0 = *reinterpret_cast<const bf16x8*>(v_src + k0_ * ldv); s_v1 = *reinterpret_cast<const bf16x8*>(v_src + (k0_ + 64) * ldv); \
        if (DQK == 96) { s_kr = *reinterpret_cast<const bf16x8*>(kr_src + k0_ * ldkr); } } while (0)
#define ATT_WRITE(b) do { *reinterpret_cast<bf16x8*>(K_lds + (b) * KBYTES + kn_dst) = s_kn0; *reinterpret_cast<bf16x8*>(K_lds + (b) * KBYTES + 64 * KP + kn_dst) = s_kn1; \
        *reinterpret_cast<bf16x8*>(V_lds + (b) * VBYTES + v_dst) = s_v0; *reinterpret_cast<bf16x8*>(V_lds + (b) * VBYTES + 8192 + v_dst) = s_v1; \
        if (DQK == 96) { *reinterpret_cast<bf16x8*>(K_lds + (b) * KBYTES + kr_dst) = s_kr; } } while (0)
    f32x16 o[2]; o[0] = f32x16{}; o[1] = f32x16{};
    float lsum = 0.f;
    const int qw = q0 + wrow;
    ATT_LOAD(st0); ATT_WRITE(0); __syncthreads();
#if ATT_PRIO
    if (wid >= 4) __builtin_amdgcn_s_setprio(1);
#endif
    for (int t = st0; t < st1; ++t) {
        const int cur = (t - st0) & 1;
        { const int tn_ = (t + 1 < st1) ? t + 1 : t; ATT_LOAD(tn_); }
#pragma unroll
        for (int sub = 0; sub < 2; ++sub) {
            bool active = true;
            if constexpr (WIN) { const int k0 = t * STG + sub * KVB; active = (k0 + 63 >= qw - 128) && (k0 <= qw + 159); }
            if (active) {
                f32x16 p0, p1;
#pragma unroll
                for (int r = 0; r < 16; ++r) { p0[r] = negc; p1[r] = negc; }
                { const char* kb = K_lds + cur * KBYTES + (sub * 64 + r32) * KP + hi * 16;
#pragma unroll
                  for (int d0 = 0; d0 < NQ; ++d0) {
                      const bf16x8 b0 = *reinterpret_cast<const bf16x8*>(kb + d0 * 32);
                      const bf16x8 b1 = *reinterpret_cast<const bf16x8*>(kb + 32 * KP + d0 * 32);
                      p0 = __builtin_amdgcn_mfma_f32_32x32x16_bf16(b0, qr[d0], p0, 0, 0, 0);
                      p1 = __builtin_amdgcn_mfma_f32_32x32x16_bf16(b1, qr[d0], p1, 0, 0, 0); } }
                if constexpr (WIN) {
                    const int base = t * STG + sub * KVB - (qw + r32) + 256 + 4 * hi;
#pragma unroll
                    for (int r = 0; r < 16; ++r) { const int ix = base + (r & 3) + 8 * (r >> 2); p0[r] += bt[ix]; p1[r] += bt[ix + 32]; }
                }
#pragma unroll
                for (int r = 0; r < 16; ++r) { p0[r] = __builtin_amdgcn_exp2f(p0[r]); p1[r] = __builtin_amdgcn_exp2f(p1[r]); }
                { float ps = 0.f;
#pragma unroll
                  for (int r = 0; r < 16; ++r) ps += p0[r] + p1[r];
                  lsum += ps; }
                bf16x8 pa[4];
                { u32x4 w;
                  w.x = pk2(p0[0], p0[1]); w.y = pk2(p0[2], p0[3]); w.z = pk2(p0[4], p0[5]); w.w = pk2(p0[6], p0[7]); pa[0] = *reinterpret_cast<bf16x8*>(&w);
                  w.x = pk2(p0[8], p0[9]); w.y = pk2(p0[10], p0[11]); w.z = pk2(p0[12], p0[13]); w.w = pk2(p0[14], p0[15]); pa[1] = *reinterpret_cast<bf16x8*>(&w);
                  w.x = pk2(p1[0], p1[1]); w.y = pk2(p1[2], p1[3]); w.z = pk2(p1[4], p1[5]); w.w = pk2(p1[6], p1[7]); pa[2] = *reinterpret_cast<bf16x8*>(&w);
                  w.x = pk2(p1[8], p1[9]); w.y = pk2(p1[10], p1[11]); w.z = pk2(p1[12], p1[13]); w.w = pk2(p1[14], p1[15]); pa[3] = *reinterpret_cast<bf16x8*>(&w); }
                pv_sub(o, vb0 + cur * VBYTES + sub * 8192, pa);
            }
        }
        if constexpr (!WIN && ATT_SG_ON) {
#pragma unroll
            for (int i_ = 0; i_ < 4 * NQ + 16; ++i_) { __builtin_amdgcn_sched_group_barrier(0x008, 1, 0); __builtin_amdgcn_sched_group_barrier(0x400, ATT_SG_TRANS, 0);
                __builtin_amdgcn_sched_group_barrier(0x002, ATT_SG_VALU, 0); __builtin_amdgcn_sched_group_barrier(0x100, ATT_SG_DSR, 0); }
        }
#if ATT_PROBE
        const unsigned long long tp0_ = __builtin_amdgcn_s_memtime();
#endif
        ATT_WRITE(cur ^ 1);
        __syncthreads();
#if ATT_PROBE
        tsync += __builtin_amdgcn_s_memtime() - tp0_;
#endif
    }
#if ATT_PRIO
    __builtin_amdgcn_s_setprio(0);
#endif
#undef ATT_LOAD
#undef ATT_WRITE
    { auto rr = __builtin_amdgcn_permlane32_swap(__float_as_uint(lsum), __float_as_uint(lsum), false, false); lsum = __uint_as_float(rr[0]) + __uint_as_float(rr[1]); }
    if constexpr (WIN) lsum += __builtin_amdgcn_exp2f(sinkp[wid & 3] + negc);
    if (hi == 0) wsf[r32] = lsum;
    LDS_WAIT();
    float rli[16];
#pragma unroll
    for (int r = 0; r < 16; ++r) rli[r] = __builtin_amdgcn_rcpf(wsf[crow(r, hi)]);
    { bf16* stg = (bf16*)(shm + L_OST) + wid * 2048;
#pragma unroll
      for (int r = 0; r < 16; ++r) { const int orow = crow(r, hi);
#pragma unroll
          for (int d0 = 0; d0 < 2; ++d0) stg[orow * 64 + d0 * 32 + r32] = (bf16)f2bf(o[d0][r] * rli[r]); }
      LDS_WAIT();
      bf16* Ow = Op + (size_t)wrow * ldo + hcol;
#pragma unroll
      for (int i = 0; i < 4; ++i) { const int row = i * 8 + (lane >> 3), ch = lane & 7; const u32x4 v = *(const u32x4*)(stg + row * 64 + ch * 8); *(u32x4*)(Ow + (size_t)row * ldo + ch * 8) = v; } }
    __syncthreads();
}
#undef ATT_PKV
}
struct WaveId { int gw, ngw, lane, wave; };

#ifndef TR_NT
#define TR_NT 1
#endif
struct TrItem { const float* src; bf16* dst; const float* gain; int ldw, ldt; };
template <int MAP>
__device__ __forceinline__ TrItem tr_seg(int it, const float* W, int ldw, int N, bf16* WT, int ldt, int roff, int dk0, const float* gain = nullptr) {
    const int nblk = N / 32, kb = it / nblk, nb = it % nblk, n0 = 32 * nb;
    int drow0;
    if (MAP == 0) drow0 = roff + n0;
    else if (MAP == 1) {
        if (n0 < 384) drow0 = n0;
        else if (n0 < 416) drow0 = PC_KROPE + (n0 - 384);
        else drow0 = n0 - 416 + PC_BQ;
    } else if (MAP == 5) { const int hh = n0 / 128, d0 = n0 % 128; drow0 = roff + (d0 < 64 ? 64 * hh + d0 : 512 + 64 * hh + (d0 - 64)); }
    else if (MAP == 4) { const int hh = n0 / 96, d0 = n0 % 96; drow0 = d0 < 64 ? 64 * hh + d0 : 512 + 32 * hh; }
    else { drow0 = (n0 >> 7) * 256 + (n0 & 127) + (MAP == 3 ? 128 : 0); }
    TrItem t; t.src = W + (size_t)(64 * kb) * ldw + n0; t.dst = WT + (size_t)drow0 * ldt + dk0 + 64 * kb; t.ldw = ldw; t.ldt = ldt; t.gain = gain ? gain + 64 * kb : nullptr; return t;
}
__device__ __forceinline__ void tr_load(const TrItem& t, float (&v)[32], int lane) {
    const float* p = t.src + (size_t)(lane >> 5) * t.ldw + (lane & 31);
#pragma unroll
    for (int i = 0; i < 32; ++i) v[i] = TR_NT ? __builtin_nontemporal_load(p + (size_t)(2 * i) * t.ldw) : p[(size_t)(2 * i) * t.ldw];
}
template <bool GAIN = false>
__device__ __forceinline__ void tr_store(const TrItem& t, const float (&v)[32], LAS float* scr, int lane) {
#pragma unroll
    for (int i = 0; i < 32; ++i) scr[(2 * i + (lane >> 5)) * 33 + (lane & 31)] = v[i];
    LDS_WAIT(); asm volatile("" ::: "memory");
    const int c = lane & 7;
    f32x4 ga = {1.f, 1.f, 1.f, 1.f}, gb = ga;
    if constexpr (GAIN) { ga = *(const f32x4*)(t.gain + 8 * c); gb = *(const f32x4*)(t.gain + 8 * c + 4); }
#pragma unroll
    for (int j = 0; j < 4; ++j) { const int n = (lane >> 3) + 8 * j; const LAS float* s = scr + (8 * c) * 33 + n;
        u32x4 o; o.x = pk2(s[0 * 33] * ga[0], s[1 * 33] * ga[1]); o.y = pk2(s[2 * 33] * ga[2], s[3 * 33] * ga[3]); o.z = pk2(s[4 * 33] * gb[0], s[5 * 33] * gb[1]); o.w = pk2(s[6 * 33] * gb[2], s[7 * 33] * gb[3]);
        if (TR_NT) __builtin_nontemporal_store(o, (u32x4*)(t.dst + (size_t)n * t.ldt + 8 * c)); else *(u32x4*)(t.dst + (size_t)n * t.ldt + 8 * c) = o; }
    LDS_WAIT(); asm volatile("" ::: "memory");
}
__device__ __forceinline__ int ilog2u(unsigned v) { return 31 - __builtin_clz(v); }
__device__ __forceinline__ int t5_bucket_dev(int rel) {
    const int n = rel < 0 ? -rel : rel; int b = rel > 0 ? 16 : 0;
    if (n < 8) return b + n;
    int large = 2 + ilog2u((unsigned)(n * n)); if (large > 15) large = 15;
    return b + large;
}
__device__ __forceinline__ float gain_absmax(const float* g, int n, int lane) { float m = 0.f; for (int i = lane; i < n; i += 64) m = fmaxf(m, fabsf(g[i])); return wave_max(m); }


__device__ __forceinline__ void unpack8(const u32x4 v, float (&x)[8]) {
    x[0] = bf2f(v.x & 0xffffu); x[1] = bf2f(v.x >> 16); x[2] = bf2f(v.y & 0xffffu); x[3] = bf2f(v.y >> 16);
    x[4] = bf2f(v.z & 0xffffu); x[5] = bf2f(v.z >> 16); x[6] = bf2f(v.w & 0xffffu); x[7] = bf2f(v.w >> 16);
}
__device__ __forceinline__ u32x4 pack8(const float (&v)[8]) { u32x4 w; w.x = pk2(v[0], v[1]); w.y = pk2(v[2], v[3]); w.z = pk2(v[4], v[5]); w.w = pk2(v[6], v[7]); return w; }
template <bool ROPE>
__device__ __forceinline__ u32x4 norm_chunk(const u32x4 raw, const float (&g)[8], int nred, float invn, float scale, bool rope, bool lo, const f32x4 (&t)[4]) {
    float x[8]; unpack8(raw, x);
    float ss = 0.f;
#pragma unroll
    for (int e = 0; e < 8; ++e) ss += x[e] * x[e];
    ss += __shfl_xor(ss, 1); ss += __shfl_xor(ss, 2);
    { const float t4 = __shfl_xor(ss, 4); ss += (nred >= 3) ? t4 : 0.f; }
    { const float t8 = __shfl_xor(ss, 8); ss += (nred >= 4) ? t8 : 0.f; }
    { const float t16 = __shfl_xor(ss, 16); ss += (nred >= 5) ? t16 : 0.f; }
    const float rstd = 1.0f / sqrtf(ss * invn + EPS);
    float o[8];
#pragma unroll
    for (int e = 0; e < 8; ++e) { const float y = x[e] * rstd * g[e];
        if (ROPE) { const float yp = __shfl_xor(y, 2); const float c = t[e >> 1][(e & 1) * 2], s = t[e >> 1][(e & 1) * 2 + 1];
            const float r = lo ? (y * c - yp * s) : (y * c + yp * s); o[e] = (rope ? r : y) * scale; }
        else o[e] = y * scale; }
    return pack8(o);
}
__device__ __forceinline__ void load8f(const float* p, float (&g)[8]) { const f32x4 a = *(const f32x4*)p, b = *(const f32x4*)(p + 4); g[0] = a.x; g[1] = a.y; g[2] = a.z; g[3] = a.w; g[4] = b.x; g[5] = b.y; g[6] = b.z; g[7] = b.w; }

__device__ __forceinline__ void ph_rmsnorm(const float* X, const float* g, bf16* H, const WaveId& w) {
    f32x4 gv[4];
#pragma unroll
    for (int j = 0; j < 4; ++j) gv[j] = ((const f32x4*)g)[w.lane + 64 * j];
    int m = w.gw; if (m >= NT) return;
    f32x4 v[4];
#pragma unroll
    for (int j = 0; j < 4; ++j) v[j] = ((const f32x4*)(X + (size_t)m * DM) + w.lane)[64 * j];
    for (; m < NT; m += w.ngw) {
        const int mn = (m + w.ngw < NT) ? m + w.ngw : m; f32x4 nv[4];
#pragma unroll
        for (int j = 0; j < 4; ++j) nv[j] = ((const f32x4*)(X + (size_t)mn * DM) + w.lane)[64 * j];
        float ss = 0.f;
#pragma unroll
        for (int j = 0; j < 4; ++j) ss += (v[j].x * v[j].x + v[j].y * v[j].y) + (v[j].z * v[j].z + v[j].w * v[j].w);
        const float rstd = 1.0f / sqrtf(wave_sum(ss) * (1.0f / DM) + EPS);
        u32x2* o = (u32x2*)(H + (size_t)m * DM) + w.lane;
#pragma unroll
        for (int j = 0; j < 4; ++j) { u32x2 q; q.x = pk2(v[j].x * rstd * gv[j].x, v[j].y * rstd * gv[j].y); q.y = pk2(v[j].z * rstd * gv[j].z, v[j].w * rstd * gv[j].w); o[64 * j] = q; }
#pragma unroll
        for (int j = 0; j < 4; ++j) v[j] = nv[j];
    }
}

__device__ __forceinline__ void ph_prep1(const bf16* PROJ, bf16* OUT, const float* qa_g, const float* kva_g, const float* gq_g, const float* gk_g, const float* kr_g, const float* tabcs  , const WaveId& w) {
    const int lane = w.lane; const float sB = 0.125f * LOG2E;
    float g0[8], g1[8], g2[8];
    load8f(lane < 32 ? qa_g + 8 * lane : (lane < 48 ? kva_g + 8 * (lane - 32) : gq_g + 8 * (lane & 7)), g0);
    load8f(lane < 48 ? gq_g + 8 * (lane & 7) : gk_g + 8 * (lane & 7), g1);
    load8f(kr_g + 8 * (lane & 3), g2);
    const int nred0 = lane < 32 ? 5 : (lane < 48 ? 4 : 3); const float invn0 = lane < 32 ? (1.0f / 256) : (lane < 48 ? (1.0f / 128) : (1.0f / 64));
    const float sc0 = lane >= 48 ? sB : 1.0f, sc1 = lane < 48 ? sB : 1.0f;
    const bool rope0 = lane >= 48, lo = !(lane & 2), k2 = (lane >= 16 && lane < 20);
    const int fi = (lane & 1) * 8, blk = (lane >> 2) & 1;
#define P1_LOAD(R, mm) do { const bf16* row_ = PROJ + (size_t)(mm) * PROJ_LD; const int s_ = (mm) & (SEQ - 1); const int pax_ = blk ? (s_ & 63) : (s_ >> 6); \
        R##c0 = *(const u32x4*)(row_ + 8 * lane); R##c1 = *(const u32x4*)(row_ + 8 * (64 + lane)); R##c2 = *(const u32x4*)(row_ + 8 * (128 + (lane & 31))); \
        const f32x4* ta_ = (const f32x4*)(tabcs + ((size_t)(k2 ? s_ : pax_) * 16 + fi) * 2); const f32x4* tb_ = (const f32x4*)(tabcs + ((size_t)pax_ * 16 + fi) * 2); \
        _Pragma("unroll") for (int k_ = 0; k_ < 4; ++k_) { R##ta[k_] = ta_[k_]; R##tb[k_] = tb_[k_]; } } while (0)
    int m = w.gw; if (m >= NT) return;
    u32x4 Cc0, Cc1, Cc2; f32x4 Cta[4], Ctb[4];
    P1_LOAD(C, m);
    for (; m < NT; m += w.ngw) {
        const int mn = (m + w.ngw < NT) ? m + w.ngw : m;
        u32x4 Nc0, Nc1, Nc2; f32x4 Nta[4], Ntb[4];
        P1_LOAD(N, mn);
        bf16* row = OUT + (size_t)m * PROJ_LD;
        const u32x4 o0 = norm_chunk<true>(Cc0, g0, nred0, invn0, sc0, rope0, lo, Cta);
        const u32x4 o1 = norm_chunk<true>(Cc1, g1, 3, 1.0f / 64, sc1, true, lo, Ctb);
        const u32x4 o2 = norm_chunk<true>(Cc2, g2, 2, 1.0f / 32, 1.0f, true, lo, Cta);
        *(u32x4*)(row + 8 * lane) = o0; *(u32x4*)(row + 8 * (64 + lane)) = o1;
        if (k2) *(u32x4*)(row + 8 * (128 + lane)) = o2;
        Cc0 = Nc0; Cc1 = Nc1; Cc2 = Nc2;
#pragma unroll
        for (int k = 0; k < 4; ++k) { Cta[k] = Nta[k]; Ctb[k] = Ntb[k]; }
    }
#undef P1_LOAD
}
__device__ __forceinline__ void ph_kside(bf16* PROJ, const float* gk_g, const float* kr_g, const float* tabcs, const WaveId& w) {
    const int lane = w.lane, l = lane & 31, hf = lane >> 5;
    const bool isk = l < 16, act = l < 20;
    float g[8]; load8f(isk ? gk_g + 8 * (l & 7) : kr_g + 8 * (l & 3), g);
    const int col = isk ? PC_BK + 8 * l : PC_KROPE + 8 * (l & 3);
    const int nred = isk ? 3 : 2; const float invn = isk ? (1.0f / 64) : (1.0f / 32);
    const bool lo = !(l & 2); const int fi = (l & 1) * 8, blk = (l >> 2) & 1;
    const int step = 2 * w.ngw;
    for (int m0 = 2 * w.gw + hf; m0 < NT; m0 += 4 * step) {
        u32x4 c[4]; f32x4 t[4][4];
#pragma unroll
        for (int j = 0; j < 4; ++j) { const int m = (m0 + j * step < NT) ? m0 + j * step : m0; const int s_ = m & (SEQ - 1); const int pos = isk ? (blk ? (s_ & 63) : (s_ >> 6)) : s_;
            c[j] = *(const u32x4*)(PROJ + (size_t)m * PROJ_LD + col);
            const f32x4* tp = (const f32x4*)(tabcs + ((size_t)pos * 16 + fi) * 2);
#pragma unroll
            for (int k = 0; k < 4; ++k) t[j][k] = tp[k]; }
#pragma unroll
        for (int j = 0; j < 4; ++j) { const int m = m0 + j * step;
            const u32x4 o = norm_chunk<true>(c[j], g, nred, invn, 1.0f, true, lo, t[j]);
            if (act && m < NT) *(u32x4*)(PROJ + (size_t)m * PROJ_LD + col) = o; }
    }
}
__device__ __forceinline__ void ph_prep2(const bf16* UPO, bf16* OUT, const float* qn_g, const float* qr_g, const float* kn_g, const float* tabcs, const WaveId& w) {
    const int lane = w.lane; const float sA = 0.10206207261596577f * LOG2E;
    float ga[8], gb[8], gc[8];
    load8f(qn_g + 8 * (lane & 7), ga); load8f(qr_g + 8 * (lane & 3), gb); load8f(kn_g + 8 * (lane & 7), gc);
    const bool lo = !(lane & 2); const int fi = (lane & 1) * 8;
    const int ca = 12 * (lane >> 3) + (lane & 7), cb = 12 * ((lane >> 2) & 7) + 8 + (lane & 3), cc = 96 + 16 * (lane >> 3) + (lane & 7);
#define P2_LOAD(R, mm) do { const bf16* row_ = UPO + (size_t)(mm) * UP_LD; const int s_ = (mm) & (SEQ - 1); \
        R##c0 = *(const u32x4*)(row_ + 8 * ca); R##c1 = *(const u32x4*)(row_ + 8 * cb); R##c2 = *(const u32x4*)(row_ + 8 * cc); \
        const f32x4* ta_ = (const f32x4*)(tabcs + ((size_t)s_ * 16 + fi) * 2); \
        _Pragma("unroll") for (int k_ = 0; k_ < 4; ++k_) R##ta[k_] = ta_[k_]; } while (0)
    int m = w.gw; if (m >= NT) return;
    u32x4 Cc0, Cc1, Cc2; f32x4 Cta[4];
    P2_LOAD(C, m);
    for (; m < NT; m += w.ngw) {
        const int mn = (m + w.ngw < NT) ? m + w.ngw : m;
        u32x4 Nc0, Nc1, Nc2; f32x4 Nta[4];
        P2_LOAD(N, mn);
        bf16* row = OUT + (size_t)m * UP_LD;
        const u32x4 o0 = norm_chunk<false>(Cc0, ga, 3, 1.0f / 64, sA, false, lo, Cta);
        const u32x4 o1 = norm_chunk<true>(Cc1, gb, 2, 1.0f / 32, sA, true, lo, Cta);
        const u32x4 o2 = norm_chunk<false>(Cc2, gc, 3, 1.0f / 64, 1.0f, false, lo, Cta);
        *(u32x4*)(row + 8 * ca) = o0; if (lane < 32) *(u32x4*)(row + 8 * cb) = o1; *(u32x4*)(row + 8 * cc) = o2;
        Cc0 = Nc0; Cc1 = Nc1; Cc2 = Nc2;
#pragma unroll
        for (int k = 0; k < 4; ++k) Cta[k] = Nta[k];
    }
#undef P2_LOAD
}
__device__ __forceinline__ void ph_prepc(const bf16* PC, bf16* OUT, const float* q_g, const float* k_g, const WaveId& w) {
    const int lane = w.lane; const float sC = 0.125f * LOG2E;
    float gq[8], gk[8]; load8f(q_g + 8 * (lane & 7), gq); load8f(k_g + 8 * (lane & 7), gk);
    const f32x4 dummy[4] = {};
#define PC_LOAD(R, mm) do { const bf16* row_ = PC + (size_t)(mm) * PC_LD; \
        R##c0 = *(const u32x4*)(row_ + 8 * lane); R##c1 = *(const u32x4*)(row_ + 8 * (64 + lane)); R##c2 = *(const u32x4*)(row_ + 8 * (128 + (lane & 31))); } while (0)
    int m = w.gw; if (m >= NT) return;
    u32x4 Cc0, Cc1, Cc2;
    PC_LOAD(C, m);
    for (; m < NT; m += w.ngw) {
        const int mn = (m + w.ngw < NT) ? m + w.ngw : m;
        u32x4 Nc0, Nc1, Nc2;
        PC_LOAD(N, mn);
        bf16* row = OUT + (size_t)m * PC_LD;
        const u32x4 o0 = norm_chunk<false>(Cc0, gq, 3, 1.0f / 64, sC, false, false, dummy);
        const u32x4 o1 = norm_chunk<false>(Cc1, gq, 3, 1.0f / 64, sC, false, false, dummy);
        const u32x4 o2 = norm_chunk<false>(Cc2, gk, 3, 1.0f / 64, 1.0f, false, false, dummy);
        *(u32x4*)(row + 8 * lane) = o0; *(u32x4*)(row + 8 * (64 + lane)) = o1; if (lane < 32) *(u32x4*)(row + 8 * (128 + lane)) = o2;
        Cc0 = Nc0; Cc1 = Nc1; Cc2 = Nc2;
    }
#undef PC_LOAD
}

__device__ __forceinline__ void build_rtab(const float* g, const float* w_group, const float* w_router, bf16* tab, int idx  ) {
    const int lane = idx & 63, ct = (idx >> 6) & 1, kk = idx >> 7, c = lane & 15, k0 = 32 * kk + 8 * (lane >> 4);
    float hi[8], lo[8];
#pragma unroll
    for (int j = 0; j < 8; ++j) { const int k = k0 + j; const float wv = (ct == 0) ? w_router[k * 16 + c] : (c < 4 ? w_group[k * 4 + c] : 0.f); const float x = wv * g[k];
        const float h = bf2f(f2bf(x)); hi[j] = h; lo[j] = x - h; }
    *(u32x4*)(tab + ((size_t)((kk * 2 + ct) * 2 + 0) * 64 + lane) * 8) = pack8(hi);
    *(u32x4*)(tab + ((size_t)((kk * 2 + ct) * 2 + 1) * 64 + lane) * 8) = pack8(lo);
}
__device__ __forceinline__ void ph_router(const bf16* XR, float* rsv, const LAS unsigned char* rtab, LAS float* scr  ,
                                          const float* b_group, const float* b_router, int* eidx, float* wts, int* rank, int* list, unsigned* cnt,
                                          LAS int* tinfo  , const WaveId& w) {
    const int lane = w.lane, tok = lane & 15, ks = lane >> 4;
    float bg[4];
#pragma unroll
    for (int i = 0; i < 4; ++i) bg[i] = b_group[i];
    int it = 0;
    for (int gi = w.gw; gi < NT / 16; gi += w.ngw, ++it) {
        const int m0 = gi * 16;
        const bf16* arow = XR + (size_t)(m0 + tok) * DM + ks * 8;
        f32x4 acc0 = {0.f, 0.f, 0.f, 0.f}, acc1 = {0.f, 0.f, 0.f, 0.f}, gram = {0.f, 0.f, 0.f, 0.f};
        bf16x8 a[8];
#pragma unroll
        for (int i = 0; i < 8; ++i) a[i] = *(const bf16x8*)(arow + 32 * i);
#pragma unroll
        for (int bt = 0; bt < 4; ++bt) {
            bf16x8 na[8];
            if (bt < 3) {
#pragma unroll
                for (int i = 0; i < 8; ++i) na[i] = *(const bf16x8*)(arow + 32 * (8 * (bt + 1) + i));
            }
#pragma unroll
            for (int i = 0; i < 8; ++i) { const int kk = 8 * bt + i; const LAS unsigned char* tb = rtab + (size_t)kk * 4096 + lane * 16;
                const bf16x8 b0h = *(const LAS bf16x8*)(tb), b0l = *(const LAS bf16x8*)(tb + 1024), b1h = *(const LAS bf16x8*)(tb + 2048), b1l = *(const LAS bf16x8*)(tb + 3072);
                acc0 = __builtin_amdgcn_mfma_f32_16x16x32_bf16(a[i], b0h, acc0, 0, 0, 0); acc0 = __builtin_amdgcn_mfma_f32_16x16x32_bf16(a[i], b0l, acc0, 0, 0, 0);
                acc1 = __builtin_amdgcn_mfma_f32_16x16x32_bf16(a[i], b1h, acc1, 0, 0, 0); acc1 = __builtin_amdgcn_mfma_f32_16x16x32_bf16(a[i], b1l, acc1, 0, 0, 0);
                gram = __builtin_amdgcn_mfma_f32_16x16x32_bf16(a[i], a[i], gram, 0, 0, 0); }
            if (bt < 3) {
#pragma unroll
                for (int i = 0; i < 8; ++i) a[i] = na[i];
            }
        }
#pragma unroll
        for (int r = 0; r < 4; ++r) { scr[(4 * ks + r) * 36 + tok] = acc0[r]; scr[(4 * ks + r) * 36 + 16 + tok] = acc1[r]; }
        if ((tok >> 2) == ks) { const int r = tok & 3; const float d = r == 0 ? gram[0] : (r == 1 ? gram[1] : (r == 2 ? gram[2] : gram[3])); scr[tok * 36 + 32] = d; }
        LDS_WAIT(); asm volatile("" ::: "memory");
        const LAS float* my = scr + tok * 36;
        const float rstd = 1.0f / sqrtf(my[32] * (1.0f / DM) + EPS);
        const float g0 = my[16] * rstd + bg[0], g1 = my[17] * rstd + bg[1], g2 = my[18] * rstd + bg[2], g3 = my[19] * rstd + bg[3];
        int gsel = 0; float gm = g0; if (g1 > gm) { gm = g1; gsel = 1; } if (g2 > gm) { gm = g2; gsel = 2; } if (g3 > gm) { gm = g3; gsel = 3; }
        const float gp = 1.0f / (expf(g0 - gm) + expf(g1 - gm) + expf(g2 - gm) + expf(g3 - gm));
        const LAS float* ml = my + 4 * gsel;
        float e0 = ml[0] * rstd, e1 = ml[1] * rstd, e2 = ml[2] * rstd, e3 = ml[3] * rstd;
        { const f32x4 bv = *(const f32x4*)(b_router + 4 * gsel); e0 += bv.x; e1 += bv.y; e2 += bv.z; e3 += bv.w; }
        int i1 = 0; float m1 = e0; if (e1 > m1) { m1 = e1; i1 = 1; } if (e2 > m1) { m1 = e2; i1 = 2; } if (e3 > m1) { m1 = e3; i1 = 3; }
        int i2 = -1; float m2 = -3.0e38f;
        if (i1 != 0 && e0 > m2) { m2 = e0; i2 = 0; } if (i1 != 1 && e1 > m2) { m2 = e1; i2 = 1; } if (i1 != 2 && e2 > m2) { m2 = e2; i2 = 2; } if (i1 != 3 && e3 > m2) { m2 = e3; i2 = 3; }
        const float t2 = expf(m2 - m1); const float w1 = gp / (1.0f + t2), w2 = gp * t2 / (1.0f + t2);
        if (lane < 16) {
            const int m = m0 + lane, ea = gsel * 4 + i1, eb = gsel * 4 + i2;
            const int la = __hip_atomic_fetch_add(tinfo + ea, 1, __ATOMIC_RELAXED, __HIP_MEMORY_SCOPE_WORKGROUP);
            const int lb = __hip_atomic_fetch_add(tinfo + eb, 1, __ATOMIC_RELAXED, __HIP_MEMORY_SCOPE_WORKGROUP);
            eidx[2 * m] = ea; eidx[2 * m + 1] = eb; wts[2 * m] = w1; wts[2 * m + 1] = w2;
            LAS int* ti = tinfo + 32 + 4 * ((it * 8 + w.wave) * 16 + lane); ti[0] = m; ti[1] = ea | (eb << 8); ti[2] = la; ti[3] = lb;
            rsv[m] = rstd;
        }
        LDS_WAIT(); asm volatile("" ::: "memory");
        LDS_WAIT(); asm volatile("" ::: "memory");
    }
    __syncthreads();
    if (threadIdx.x < 16) tinfo[16 + threadIdx.x] = (int)__hip_atomic_fetch_add(cnt + 64 * threadIdx.x, (unsigned)tinfo[threadIdx.x], __ATOMIC_RELAXED, __HIP_MEMORY_SCOPE_AGENT);
    __syncthreads();
    { const int niter = (NT / 16 - (int)blockIdx.x * 8 + w.ngw - 1) / w.ngw;
      for (int k = threadIdx.x; k < niter * 128; k += 512) { const LAS int* ti = tinfo + 32 + 4 * k; const int mm = ti[0];
          if (mm >= 0) { const int ea = ti[1] & 255, eb = ti[1] >> 8; const int ra = tinfo[16 + ea] + ti[2], rb = tinfo[16 + eb] + ti[3];
              rank[2 * mm] = ra; rank[2 * mm + 1] = rb; list[(size_t)ea * NT + ra] = mm; list[(size_t)eb * NT + rb] = mm; } } }
}
__device__ __forceinline__ int moe_offsets(const unsigned* cnt, int (&off)[17]) {
    int a = 0;
#pragma unroll
    for (int e = 0; e < 16; ++e) { off[e] = a; a += ((int)cnt[64 * e] + 255) & ~255; }
    off[16] = a; return a >> 8;
}
template <bool FINAL>
__device__ __forceinline__ void ph_combine(bf16* XR, float* OUT, const bf16* Y, const int* eidx, const int* rank, const float* wts, const unsigned* cnt, float* RS, const WaveId& w) {
    const int lane = w.lane;
    int off[17]; moe_offsets(cnt, off);
#define CB_LOAD(R, mm) do { const int e0_ = eidx[2 * (mm)], e1_ = eidx[2 * (mm) + 1]; int b0_ = 0, b1_ = 0; \
        _Pragma("unroll") for (int q_ = 0; q_ < 16; ++q_) { b0_ = (q_ == e0_) ? off[q_] : b0_; b1_ = (q_ == e1_) ? off[q_] : b1_; } \
        const int s0_ = b0_ + rank[2 * (mm)], s1_ = b1_ + rank[2 * (mm) + 1]; R##w0 = wts[2 * (mm)]; R##w1 = wts[2 * (mm) + 1]; \
        const u32x4* xr_ = (const u32x4*)(XR + (size_t)(mm) * DM) + lane; const u32x4* y0_ = (const u32x4*)(Y + (size_t)s0_ * DM) + lane; const u32x4* y1_ = (const u32x4*)(Y + (size_t)s1_ * DM) + lane; \
        _Pragma("unroll") for (int j_ = 0; j_ < 2; ++j_) { R##x[j_] = xr_[64 * j_]; R##a[j_] = y0_[64 * j_]; R##b[j_] = y1_[64 * j_]; } } while (0)
    int m = w.gw; if (m >= NT) return;
    u32x4 Cx[2], Ca[2], Cb[2]; float Cw0, Cw1;
    CB_LOAD(C, m);
    for (; m < NT; m += w.ngw) {
        const int mn = (m + w.ngw < NT) ? m + w.ngw : m;
        u32x4 Nx[2], Na[2], Nb[2]; float Nw0, Nw1;
        CB_LOAD(N, mn);
        float v[2][8]; float ss = 0.f;
#pragma unroll
        for (int j = 0; j < 2; ++j) { float x[8], a[8], b[8]; unpack8(Cx[j], x); unpack8(Ca[j], a); unpack8(Cb[j], b);
#pragma unroll
            for (int e = 0; e < 8; ++e) { v[j][e] = x[e] + Cw0 * a[e] + Cw1 * b[e]; ss += v[j][e] * v[j][e]; } }
        if (FINAL) {
#pragma unroll
            for (int j = 0; j < 2; ++j) { f32x4* o = (f32x4*)(OUT + (size_t)m * DM + 8 * (lane + 64 * j)); o[0] = (f32x4){v[j][0], v[j][1], v[j][2], v[j][3]}; o[1] = (f32x4){v[j][4], v[j][5], v[j][6], v[j][7]}; }
        } else {
            const float rstd = 1.0f / sqrtf(wave_sum(ss) * (1.0f / DM) + EPS);
#pragma unroll
            for (int j = 0; j < 2; ++j) *((u32x4*)(XR + (size_t)m * DM) + lane + 64 * j) = pack8(v[j]);
            if (lane == 0) RS[m] = rstd;
        }
#pragma unroll
        for (int j = 0; j < 2; ++j) { Cx[j] = Nx[j]; Ca[j] = Na[j]; Cb[j] = Nb[j]; }
        Cw0 = Nw0; Cw1 = Nw1;
    }
#undef CB_LOAD
}

template <int DQK, bool WIN>
__device__ __forceinline__ void naive_attn_row(const bf16* qrow, const bf16* Kn, int ldk, const bf16* Kr, int ldkr, const bf16* Vp, int ldv, bf16* orow,
                                               int qpos, const float* btab, float sinkl2, LAS float* qf  , int lane) {
    for (int d = lane; d < DQK; d += 64) qf[d] = bf2f(qrow[d]);
    LDS_WAIT(); asm volatile("" ::: "memory");
    float m = -1.0e30f, l = 0.f, o = 0.f;
    const int kbeg = WIN ? qpos - 128 : 0, nch = WIN ? 5 : SEQ / 64;
    for (int ci = 0; ci < nch; ++ci) {
        const int key = kbeg + ci * 64 + lane; const bool valid = !WIN || (key >= 0 && key < SEQ && key - qpos <= 128);
        const int kc = valid ? key : 0;
        float s = 0.f;
        { const bf16* kp = Kn + (size_t)kc * ldk;
#pragma unroll
          for (int c = 0; c < 8; ++c) { const u32x4 kv = *(const u32x4*)(kp + c * 8); const LAS float* q = qf + c * 8;
              s += q[0] * bf2f(kv.x & 0xffffu) + q[1] * bf2f(kv.x >> 16) + q[2] * bf2f(kv.y & 0xffffu) + q[3] * bf2f(kv.y >> 16) + q[4] * bf2f(kv.z & 0xffffu) + q[5] * bf2f(kv.z >> 16) + q[6] * bf2f(kv.w & 0xffffu) + q[7] * bf2f(kv.w >> 16); }
          if (DQK == 96) { const bf16* rp = Kr + (size_t)kc * ldkr;
#pragma unroll
              for (int c = 0; c < 4; ++c) { const u32x4 kv = *(const u32x4*)(rp + c * 8); const LAS float* q = qf + 64 + c * 8;
                  s += q[0] * bf2f(kv.x & 0xffffu) + q[1] * bf2f(kv.x >> 16) + q[2] * bf2f(kv.y & 0xffffu) + q[3] * bf2f(kv.y >> 16) + q[4] * bf2f(kv.z & 0xffffu) + q[5] * bf2f(kv.z >> 16) + q[6] * bf2f(kv.w & 0xffffu) + q[7] * bf2f(kv.w >> 16); } } }
        if (WIN) s = valid ? s + btab[key - qpos + 256] : -INFINITY;
        const float mn = fmaxf(m, wave_max(s)); const float p = exp2f(s - mn), al = exp2f(m - mn);
        l = l * al + wave_sum(p); o *= al; m = mn;
        const int kb = kbeg + ci * 64;
        for (int j = 0; j < 64; ++j) { const float pj = __shfl(p, j); int kk = kb + j; if (WIN) kk = (kk < 0 || kk >= SEQ) ? 0 : kk; o += pj * bf2f(Vp[(size_t)kk * ldv + lane]); }
    }
    if (WIN) { const float mn = fmaxf(m, sinkl2); const float al = exp2f(m - mn); l = l * al + exp2f(sinkl2 - mn); o *= al; }
    orow[lane] = (bf16)f2bf(o / l);
    LDS_WAIT(); asm volatile("" ::: "memory");
}
constexpr int NPHASE = 19;
#ifndef CV_BATCH
#define CV_BATCH 1
#endif
#ifndef CV_DEPHASE
#define CV_DEPHASE 1
#endif
#ifndef CV_REP
#define CV_REP 1
#endif
#ifndef UP_KV_K128
#define UP_KV_K128 1
#endif
#ifndef MK_FUSE_PREP1
#define MK_FUSE_PREP1 1
#endif
#ifndef MK_FUSE_PREP2
#define MK_FUSE_PREP2 1
#endif
#ifndef MK_FUSE_PREPC
#define MK_FUSE_PREPC 1
#endif
#ifndef ATT_WIDE_C
#define ATT_WIDE_C 1
#endif
#ifndef ATT_WIDE_A
#define ATT_WIDE_A 1
#endif
#ifndef ATT_WIDE_B
#define ATT_WIDE_B 1
#endif
#ifndef ATT_MAP
#define ATT_MAP vcu
#endif
struct Args { const float* in[28]; float* out; unsigned char* ws; int ph_lo, ph_hi; };
enum { I_X = 0, I_MIXN, I_FFNN, I_WINAB, I_QAN, I_WQUP, I_KVAN, I_WKVUP, I_QNG, I_KNG, I_QRG, I_KRG, I_GQG, I_GKG, I_WOUTAB, I_WINC, I_WQG, I_WKG, I_SINK, I_WOUTC,
       I_RELB, I_WGRP, I_BGRP, I_WRTR, I_BRTR, I_WGATE, I_WUP, I_WDOWN };

__global__ void __launch_bounds__(512, 2) mk_fwd(Args args) {
    extern __shared__ __attribute__((aligned(16))) unsigned char lds[];
    LAS unsigned char* L = (LAS unsigned char*)lds;
    const int tid = threadIdx.x, lane = tid & 63, wave = __builtin_amdgcn_readfirstlane(tid >> 6);
    const int G = gridDim.x, bx = blockIdx.x;
    const int vcu = (G % 8 == 0) ? (bx % 8) * (G / 8) + bx / 8 : bx;
    WaveId W; W.gw = bx * 8 + wave; W.ngw = G * 8; W.lane = lane; W.wave = wave;
    const __attribute__((address_space(4))) Args* argp_ = (const __attribute__((address_space(4))) Args*)__builtin_amdgcn_kernarg_segment_ptr();
#define INP(i) ({ const __attribute__((address_space(4))) Args* a_ = argp_; asm volatile("" : "+s"(a_)); (const float*)a_->in[i]; })
    unsigned char* ws = args.ws;
    unsigned* ctl = (unsigned*)(ws + WS_CTL);
    float* tab = (float*)(ws + WS_TAB);
    int* r_eidx = (int*)(ws + WS_ROUTE); float* r_wts = (float*)(ws + WS_ROUTE + 512 * 1024); int* r_slot = (int*)(ws + WS_ROUTE + 1024 * 1024);
    bf16* WT_AB = (bf16*)(ws + WS_WAB); bf16* WT_UP = (bf16*)(ws + WS_WUP); bf16* WT_OAB = (bf16*)(ws + WS_WOAB); bf16* WT_C = (bf16*)(ws + WS_WC); bf16* WT_OC = (bf16*)(ws + WS_WOC);
    bf16* WT_GU = (bf16*)(ws + WS_WGU); bf16* WT_D = (bf16*)(ws + WS_WD);
    bf16* HB = (bf16*)(ws + WS_H); bf16* PROJ = (bf16*)(ws + WS_PROJ); bf16* UPO = (bf16*)(ws + WS_UPO); bf16* PROJC = (bf16*)(ws + WS_PROJC);
    bf16* ACT = (bf16*)(ws + WS_ACT); bf16* DUMMY = (bf16*)(ws + WS_END);
    bf16* XRB = (bf16*)(ws + WS_XR);
    bf16* RTAB = (bf16*)(ws + WS_RTAB);
    volatile LAS unsigned* MISC = (volatile LAS unsigned*)(L + MISC_OFF);
    if (tid < 16) MISC[tid] = 0u;
    __syncthreads();
    const int lo = args.ph_lo, hi = args.ph_hi;
    XcdBarrier bar; bar.bar = ctl + CW_BAR; bar.x = 0; bar.st = nullptr;
    if (hi - lo > 1) bar = xcd_barrier_post(ctl + CW_BAR, MISC + 8);
#define IN(k) (lo <= (k) && (k) < hi)
#define SEAM(k) do { if (IN(k) && IN((k) + 1)) xcd_barrier(bar); } while (0)
#ifndef MK_REP_MASK
#define MK_REP_MASK 0
#endif
#ifndef MK_REP_N
#define MK_REP_N 1
#endif
#define REPS(k) (((MK_REP_MASK >> (k)) & 1) ? MK_REP_N : 1)
#define PH_BEGIN(k) if (IN(k)) { for (int rep_ = 0; rep_ < REPS(k); ++rep_) { if (rep_) xcd_barrier(bar);
#define PH_END(k) } } SEAM(k);

    constexpr int I_E5 = 256, MOE_ONLY = 3 * 32 * I_E5, I_O5 = 16 * 32, I_C5 = 16 * 48, MOE_ITEMS = MOE_ONLY + 2 * I_O5 + I_C5;
#define CV_DECODE(T, r_) do { if ((r_) >= MOE_ONLY) { const int rr = (r_) - MOE_ONLY; \
                    if (rr < I_O5) T = tr_seg<0>(rr, INP(I_WOUTAB), 1024, 1024, WT_OAB, 1024, 0, 0); \
                    else if (rr < I_O5 + I_C5) T = tr_seg<0>(rr - I_O5, INP(I_WINC), 1536, 1536, WT_C, 1024, 0, 0, INP(I_MIXN) + DM); \
                    else T = tr_seg<0>(rr - I_O5 - I_C5, INP(I_WOUTC), 1024, 1024, WT_OC, 1024, 0, 0); break; } \
                const int le = (r_) / (3 * I_E5), qq = (r_) % (3 * I_E5); \
                if (qq < I_E5) T = tr_seg<2>(qq, INP(I_WGATE) + (size_t)le * 1024 * 512, 512, 512, WT_GU + (size_t)le * 1024 * 1024, 1024, 0, 0, INP(I_FFNN) + (le >> 4) * DM); \
                else if (qq < 2 * I_E5) T = tr_seg<3>(qq - I_E5, INP(I_WUP) + (size_t)le * 1024 * 512, 512, 512, WT_GU + (size_t)le * 1024 * 1024, 1024, 0, 0, INP(I_FFNN) + (le >> 4) * DM); \
                else T = tr_seg<0>(qq - 2 * I_E5, INP(I_WDOWN) + (size_t)le * 512 * 1024, 1024, 1024, WT_D + (size_t)le * 1024 * 512, 512, 0, 0); } while (0)
#define CV_RUN(base_, cnt_, wi_, nw_) do { LAS float* scr5 = (LAS float*)(L + wave * 16384); int k_ = (wi_); const int end_ = (cnt_), st_ = (nw_); \
        for (; k_ + st_ < end_; k_ += 2 * st_) { float va_[32], vb_[32]; const int ra_ = (base_) + k_, rb_ = ra_ + st_; \
            { TrItem ti_; CV_DECODE(ti_, ra_); tr_load(ti_, va_, lane); } { TrItem ti_; CV_DECODE(ti_, rb_); tr_load(ti_, vb_, lane); } \
            { TrItem ti_; CV_DECODE(ti_, ra_); if (ti_.gain != nullptr) tr_store<true>(ti_, va_, scr5, lane); else tr_store<false>(ti_, va_, scr5, lane); } \
            { TrItem ti_; CV_DECODE(ti_, rb_); if (ti_.gain != nullptr) tr_store<true>(ti_, vb_, scr5, lane); else tr_store<false>(ti_, vb_, scr5, lane); } } \
        if (k_ < end_) { float va_[32]; const int ra_ = (base_) + k_; TrItem ti_; CV_DECODE(ti_, ra_); tr_load(ti_, va_, lane); \
            if (ti_.gain != nullptr) tr_store<true>(ti_, va_, scr5, lane); else tr_store<false>(ti_, va_, scr5, lane); } } while (0)
#define CV_TAIL(units_, c_, base_, cnt_) do { const int rem_ = (units_) % G, S_ = rem_ ? G - rem_ : 0; \
        if (2 * S_ >= G) { if ((c_) >= rem_) { CV_RUN(base_, cnt_, ((c_) - rem_) * 8 + wave, S_ * 8); } } else { CV_RUN(base_, cnt_, (c_) * 8 + wave, G * 8); } } while (0)
#ifndef CV_T1
#define CV_T1 0
#endif
#ifndef CV_T1N
#define CV_T1N 4096
#endif
#ifndef CV_T8
#define CV_T8 1
#endif
    constexpr int CV1_BASE = 0, CV1_CNT = CV_T1 ? CV_T1N : 0, CV8_BASE = MOE_ONLY / 2, CV8_CNT = MOE_ONLY / 2;
    constexpr int CV5_BASE = CV1_CNT, CV5_CNT = (CV_T8 ? MOE_ONLY / 2 : MOE_ONLY) - CV1_CNT;
    constexpr int CV5D_BASE = MOE_ONLY, CV5D_CNT = MOE_ITEMS - MOE_ONLY;

    PH_BEGIN(0) {
        LAS float* scr = (LAS float*)(L + wave * 16384);
        constexpr int I_AB = 16 * 37, I_QU = 4 * 24, I_KU = 2 * 32, I_O = 16 * 32, I_C = 16 * 48, I_E = 256;
        constexpr int NIT = I_AB + I_QU + I_KU;
#define P0_DECODE(T, it_) do { int r = (it_); \
            if (r < I_AB) { T = tr_seg<1>(r, INP(I_WINAB), 1184, 1184, WT_AB, 1024, 0, 0); break; } r -= I_AB; \
            if (r < I_QU) { T = tr_seg<MK_FUSE_PREP2 ? 4 : 0>(r, INP(I_WQUP), 768, 768, WT_UP, UP_K, 0, 0); break; } r -= I_QU; \
            if (r < I_KU) { T = tr_seg<MK_FUSE_PREP2 ? 5 : 0>(r, INP(I_WKVUP), 1024, 1024, WT_UP, UP_K, 768, 128); break; } r -= I_KU; \
            if (r < I_O) { T = tr_seg<0>(r, INP(I_WOUTAB), 1024, 1024, WT_OAB, 1024, 0, 0); break; } r -= I_O; \
            if (r < I_C) { T = tr_seg<0>(r, INP(I_WINC), 1536, 1536, WT_C, 1024, 0, 0, INP(I_MIXN) + DM); break; } r -= I_C; \
            if (r < I_O) { T = tr_seg<0>(r, INP(I_WOUTC), 1024, 1024, WT_OC, 1024, 0, 0); break; } r -= I_O; \
            const int le = r / (3 * I_E), q = r % (3 * I_E);            \
            if (q < I_E) T = tr_seg<2>(q, INP(I_WGATE) + (size_t)le * 1024 * 512, 512, 512, WT_GU + (size_t)le * 1024 * 1024, 1024, 0, 0); \
            else if (q < 2 * I_E) T = tr_seg<3>(q - I_E, INP(I_WUP) + (size_t)le * 1024 * 512, 512, 512, WT_GU + (size_t)le * 1024 * 1024, 1024, 0, 0); \
            else T = tr_seg<0>(q - 2 * I_E, INP(I_WDOWN) + (size_t)le * 512 * 1024, 1024, 1024, WT_D + (size_t)le * 1024 * 512, 512, 0, 0); } while (0)
        if (W.gw < NIT) {
            TrItem cur; P0_DECODE(cur, W.gw); float v[32]; tr_load(cur, v, lane);
            for (int it = W.gw; it < NIT; it += W.ngw) {
                const int itn = (it + W.ngw < NIT) ? it + W.ngw : it; TrItem nxt; P0_DECODE(nxt, itn); float nv[32]; tr_load(nxt, nv, lane);
                if (cur.gain != nullptr) tr_store<true>(cur, v, scr, lane); else tr_store<false>(cur, v, scr, lane);
                cur = nxt;
#pragma unroll
                for (int i = 0; i < 32; ++i) v[i] = nv[i];
            }
        }
        { const int gt = W.gw * 64 + lane, ngt = W.ngw * 64; const u32x4 z = {0u, 0u, 0u, 0u};
          for (int i = gt; i < 96 * 128; i += ngt) *(u32x4*)(WT_AB + (size_t)(1184 + i / 128) * 1024 + (i % 128) * 8) = z;
          for (int i = gt; i < 1024 * 16; i += ngt) *(u32x4*)(WT_UP + (size_t)(768 + i / 16) * UP_K + (i % 16) * 8) = z;
          for (int i = gt; i < 4096 * 16; i += ngt) { const float ang = (float)(i >> 4) * powf(10000.0f, -(float)(i & 15) * (1.0f / 16.0f)); tab[TB_CS + 2 * i] = cosf(ang); tab[TB_CS + 2 * i + 1] = sinf(ang); }
          const float* relb = INP(I_RELB);
          for (int i = gt; i < 16 * 512; i += ngt) { const int h = i >> 9, rel = (i & 511) - 256; tab[TB_BIAS + i] = (rel >= -128 && rel <= 128) ? relb[t5_bucket_dev(rel) * 16 + h] * LOG2E : -1.0e30f; } }
        { const int gt = W.gw * 64 + lane, ngt = W.ngw * 64;
          for (int i = gt; i < 2 * 4096; i += ngt) { const int ly = i >> 12; build_rtab(INP(I_FFNN) + ly * DM, INP(I_WGRP) + (size_t)ly * 1024 * 4, INP(I_WRTR) + (size_t)ly * 1024 * 16, RTAB + (size_t)ly * 65536, i & 4095); } }
        if (W.gw == 0) {
            const float gqn = gain_absmax(INP(I_QNG), 64, lane), gkn = gain_absmax(INP(I_KNG), 64, lane), gqr = gain_absmax(INP(I_QRG), 32, lane), gkr = gain_absmax(INP(I_KRG), 32, lane);
            const float gbq = gain_absmax(INP(I_GQG), 64, lane), gbk = gain_absmax(INP(I_GKG), 64, lane), gcq = gain_absmax(INP(I_WQG), 64, lane), gck = gain_absmax(INP(I_WKG), 64, lane);
            float bm = 0.f; for (int i = lane; i < 512; i += 64) bm = fmaxf(bm, INP(I_RELB)[i]); bm = wave_max(bm);
            if (lane == 0) { tab[TB_CONST + 0] = -(0.10206207261596577f * LOG2E * (64.f * gqn * gkn + 32.f * gqr * gkr));
                             tab[TB_CONST + 1] = -(0.125f * LOG2E * 64.f * gbq * gbk);
                             tab[TB_CONST + 2] = -(0.125f * LOG2E * 64.f * gcq * gck + bm * LOG2E); }
            if (lane < 16) tab[TB_CONST + 16 + lane] = INP(I_SINK)[lane] * LOG2E;
        }
        ph_rmsnorm(INP(I_X), INP(I_MIXN), HB, W);
    }
    PH_END(0)
#ifdef MK_EXTRA_BAR
    if (IN(0) && IN(1)) { for (int xb_ = 0; xb_ < MK_EXTRA_BAR; ++xb_) xcd_barrier(bar); }
#endif


        PH_BEGIN(1) {
#if MK_GEMM
            pg8::Gemm g{HB, WT_AB, 1024, 1024, 1024}; pg8::StaticOrder S; S.init(NT, PROJ_LD, 1024, 1024, G, bx);
#if MK_FUSE_PREP1
            pg8::EpiProjNormA E{PROJ, PROJ_LD, INP(I_QAN), INP(I_KVAN), INP(I_GQG), 0.125f * LOG2E, (LAS float*)(L + MISC_OFF + 16384), EPS};
            pg8::gemm_phase<pg8::EpiProjNormA, pg8::StaticOrder, true>(L, g, S, E);
#if CV_T1
            CV_TAIL((NT / 256) * (PROJ_LD / 256), bx, CV1_BASE, CV1_CNT);
#endif
#else
            pg8::EpiStoreBf16 E{PROJ, PROJ_LD};
            pg8::gemm_phase<pg8::EpiStoreBf16, pg8::StaticOrder, true>(L, g, S, E);
#endif
#else
            naive_gemm<0>(HB, 1024, WT_AB, 1024, NT, PROJ_LD, 1024, PROJ, nullptr, nullptr, PROJ_LD, W);
#endif
        }
        PH_END(1)
#if !MK_FUSE_PREP1
        PH_BEGIN(2) ph_prep1(PROJ, rep_ ? DUMMY : PROJ, INP(I_QAN), INP(I_KVAN), INP(I_GQG), INP(I_GKG), INP(I_KRG), tab + TB_CS, W);
        PH_END(2)
#endif
        PH_BEGIN(3) {
#if MK_FUSE_PREP1
            if (!rep_) { const int kfirst = (G > 192 && G < 384) ? 384 - G : 0;
                if (bx >= kfirst) { WaveId Wk = W; Wk.gw = (bx - kfirst) * 8 + wave; Wk.ngw = (G - kfirst) * 8;
                    ph_kside(PROJ, INP(I_GKG), INP(I_KRG), tab + TB_CS, Wk); } }
#endif
#if MK_GEMM
            pg8::Gemm g{PROJ, WT_UP, PROJ_LD, UP_K, UP_K}; pg8::StaticOrder S; S.init(NT, UP_LD, PROJ_LD, UP_K, G, bx, 3);
#if MK_FUSE_PREP2
            { pg8::StaticOrder Sq; Sq.init(NT, 768, PROJ_LD, UP_K, G, bx);
              pg8::EpiHeadNormA Eq{UPO, UP_LD, INP(I_QNG), INP(I_QNG), 0.10206207261596577f * LOG2E, EPS, 2, 2, nullptr};
              pg8::gemm_phase<pg8::EpiHeadNormA, pg8::StaticOrder, true>(L, g, Sq, Eq); }
#if UP_KV_K128
            { int kk_ = 128; asm volatile("" : "+s"(kk_));
              pg8::Gemm gk{PROJ + 256, WT_UP + (size_t)768 * UP_K + 128, PROJ_LD, UP_K, kk_}; pg8::StaticOrder Sk; Sk.init(NT, 1024, PROJ_LD, UP_K, G, bx);
#else
            { pg8::Gemm gk{PROJ + 128, WT_UP + (size_t)768 * UP_K, PROJ_LD, UP_K, UP_K}; pg8::StaticOrder Sk; Sk.init(NT, 1024, PROJ_LD, UP_K, G, bx);
#endif
              pg8::EpiHeadNormA Ek{UPO + 768, UP_LD, INP(I_KNG), INP(I_KNG), 1.0f, EPS, 0, 2, nullptr};
              pg8::gemm_phase<pg8::EpiHeadNormA, pg8::StaticOrder, true>(L, gk, Sk, Ek); }
#else
            pg8::EpiStoreBf16 E{UPO, UP_LD};
            pg8::gemm_phase<pg8::EpiStoreBf16, pg8::StaticOrder, true>(L, g, S, E);
#endif
#else
            naive_gemm<0>(PROJ, PROJ_LD, WT_UP, UP_K, NT, UP_LD, UP_K, UPO, nullptr, nullptr, UP_LD, W);
#endif
        }
        PH_END(3)
#if !MK_FUSE_PREP2
        PH_BEGIN(4) ph_prep2(UPO, rep_ ? DUMMY : UPO, INP(I_QNG), INP(I_QRG), INP(I_KNG), tab + TB_CS, W);
        PH_END(4)
#endif
        PH_BEGIN(5) {
            const float negcA = tab[TB_CONST + 0], negcB = tab[TB_CONST + 1];
#if MK_ATTN
            unsigned long long tsync = 0ull;
#ifdef MK_CLKPROBE
            const unsigned long long cp0_ = __builtin_amdgcn_s_memtime();
#endif
            int pos_ = 0; const int grp_ = bx % 5; bool cvdone_ = false;
#define P5_CVALL() do { if (CV5_CNT > 0) { CV_RUN(CV5_BASE, CV5_CNT, W.gw, W.ngw); } CV_RUN(CV5D_BASE, CV5D_CNT, W.gw, W.ngw); __syncthreads(); } while (0)
#define P5_SLOT() do { if (pos_ == grp_) { P5_CVALL(); cvdone_ = true; } ++pos_; } while (0)
#if ATT_WIDE_A
            for (int u = ATT_MAP; u < 512; u += G) { const int b = u >> 6, h = (u >> 3) & 7, qb = u & 7; const size_t r0 = (size_t)b * SEQ, rq = r0 + qb * 512;
                P5_SLOT();
                att::attn_unit16w<96>(UPO + rq * UP_LD + (MK_FUSE_PREP2 ? 64 : 96) * h, UPO + rq * UP_LD + (MK_FUSE_PREP2 ? 512 + 32 * h : 96 * h + 64), UP_LD, UPO + r0 * UP_LD + 768 + (MK_FUSE_PREP2 ? 64 : 128) * h, UP_LD, PROJ + r0 * PROJ_LD + PC_KROPE, PROJ_LD,
                                      UPO + r0 * UP_LD + (MK_FUSE_PREP2 ? 1280 + 64 * h : 768 + 128 * h + 64), UP_LD, HB + rq * DM + 64 * h, DM, 0, SEQ / 128, negcA, (char*)lds, MK_FUSE_PREP2 ? INP(I_QRG) : nullptr, tab + TB_CS, qb * 512); }
#else
            for (int u = ATT_MAP; u < 1024; u += G) { const int b = u >> 7, h = (u >> 4) & 7, qb = u & 15; const size_t r0 = (size_t)b * SEQ, rq = r0 + qb * 256;
                P5_SLOT();
                att::attn_unit16<96>(UPO + rq * UP_LD + (MK_FUSE_PREP2 ? 64 : 96) * h, UPO + rq * UP_LD + (MK_FUSE_PREP2 ? 512 + 32 * h : 96 * h + 64), UP_LD, UPO + r0 * UP_LD + 768 + (MK_FUSE_PREP2 ? 64 : 128) * h, UP_LD, PROJ + r0 * PROJ_LD + PC_KROPE, PROJ_LD,
                                          UPO + r0 * UP_LD + (MK_FUSE_PREP2 ? 1280 + 64 * h : 768 + 128 * h + 64), UP_LD, HB + rq * DM + 64 * h, DM, 0, SEQ / 128, negcA, (char*)lds, MK_FUSE_PREP2 ? INP(I_QRG) : nullptr, tab + TB_CS, qb * 256); }
#endif
#if ATT_WIDE_B
            for (int u = ATT_MAP; u < 512; u += G) { const int b = u >> 6, h = (u >> 3) & 7, qb = u & 7; const size_t r0 = (size_t)b * SEQ, rq = r0 + qb * 512;
                P5_SLOT();
                att::attn_unit16w<64>(PROJ + rq * PROJ_LD + PC_BQ + 64 * h, nullptr, PROJ_LD, PROJ + r0 * PROJ_LD + PC_BK + 64 * (h >> 2), PROJ_LD, nullptr, 0,
                                  PROJ + r0 * PROJ_LD + PC_BV + 64 * (h >> 2), PROJ_LD, HB + rq * DM + 512 + 64 * h, DM, 0, SEQ / 128, negcB, (char*)lds, nullptr, MK_FUSE_PREP1 ? tab + TB_CS : nullptr, qb * 512); }
#else
            for (int u = ATT_MAP; u < 1024; u += G) { const int b = u >> 7, h = (u >> 4) & 7, qb = u & 15; const size_t r0 = (size_t)b * SEQ, rq = r0 + qb * 256;
                P5_SLOT();
                att::attn_unit16<64>(PROJ + rq * PROJ_LD + PC_BQ + 64 * h, nullptr, PROJ_LD, PROJ + r0 * PROJ_LD + PC_BK + 64 * (h >> 2), PROJ_LD, nullptr, 0,
                                          PROJ + r0 * PROJ_LD + PC_BV + 64 * (h >> 2), PROJ_LD, HB + rq * DM + 512 + 64 * h, DM, 0, SEQ / 128, negcB, (char*)lds, nullptr, nullptr, 0); }
#endif
            if (!cvdone_) { P5_CVALL(); }
#if ATT_PROBE
            { const unsigned long long ts0_ = __builtin_amdgcn_s_memtime(); while (__builtin_amdgcn_s_memtime() - ts0_ < tsync) __builtin_amdgcn_s_sleep(8); }
#endif
#ifdef MK_CLKPROBE
            { const unsigned long long cyc_ = __builtin_amdgcn_s_memtime() - cp0_; const unsigned long long r0_ = __builtin_amdgcn_s_memrealtime(); while (__builtin_amdgcn_s_memrealtime() - r0_ < cyc_ / 21ull) __builtin_amdgcn_s_sleep(8); }
#endif
#else
            LAS float* qf = (LAS float*)(L + wave * 512);
            for (long it = W.gw; it < (long)NT * 8; it += W.ngw) { const int m = (int)(it >> 3), h = (int)(it & 7); const size_t r0 = (size_t)(m / SEQ) * SEQ;
                naive_attn_row<96, false>(UPO + (size_t)m * UP_LD + 96 * h, UPO + r0 * UP_LD + 768 + (MK_FUSE_PREP2 ? 64 : 128) * h, UP_LD, PROJ + r0 * PROJ_LD + PC_KROPE, PROJ_LD,
                                          UPO + r0 * UP_LD + (MK_FUSE_PREP2 ? 1280 + 64 * h : 768 + 128 * h + 64), UP_LD, HB + (size_t)m * DM + 64 * h, 0, nullptr, 0.f, qf, lane); }
            for (long it = W.gw; it < (long)NT * 8; it += W.ngw) { const int m = (int)(it >> 3), h = (int)(it & 7); const size_t r0 = (size_t)(m / SEQ) * SEQ;
                naive_attn_row<64, false>(PROJ + (size_t)m * PROJ_LD + PC_BQ + 64 * h, PROJ + r0 * PROJ_LD + PC_BK + 64 * (h >> 2), PROJ_LD, nullptr, 0,
                                          PROJ + r0 * PROJ_LD + PC_BV + 64 * (h >> 2), PROJ_LD, HB + (size_t)m * DM + 512 + 64 * h, 0, nullptr, 0.f, qf, lane); }
            (void)negcA; (void)negcB;
#endif
        }
        PH_END(5)
        PH_BEGIN(6) {
#if MK_GEMM
            pg8::Gemm g{HB, WT_OAB, 1024, 1024, 1024}; pg8::StaticOrder S; S.init(NT, DM, 1024, 1024, G, bx); pg8::EpiResXBA E{INP(I_X), XRB, DM};
            pg8::gemm_phase<pg8::EpiResXBA, pg8::StaticOrder, true>(L, g, S, E);
#else

#endif
        }
        PH_END(6)

    { constexpr int LAYER_ = 0;
    constexpr int layer = LAYER_; constexpr int pb = 8 * layer;
    unsigned* cnt = ctl + CW_CNT + 1024 * layer;
    int* eidx = r_eidx + (size_t)layer * NT * 2; float* wts = r_wts + (size_t)layer * NT * 2; int* rank = r_slot + (size_t)layer * NT * 2;
    int* list = (int*)(ws + WS_LIST);
    bf16* YB = (bf16*)(ws + WS_Y);
    PH_BEGIN(7 + pb) {
        { const u32x4* src = (const u32x4*)(RTAB + (size_t)layer * 65536); LAS u32x4* dst = (LAS u32x4*)L;
          for (int i = tid; i < 8192; i += 512) dst[i] = src[i]; }
        LAS int* tinfo = (LAS int*)(L + MISC_OFF + 2048);
        { const int niter = (NT / 16 - bx * 8 + W.ngw - 1) / W.ngw;
          for (int i = tid; i < 32 + 4 * niter * 128; i += 512) tinfo[i] = (i < 32) ? 0 : -1; }
        __syncthreads();
        ph_router(XRB, (float*)(ws + WS_RS) + (size_t)layer * NT, L, (LAS float*)(L + MISC_OFF + 8192 + wave * 2304), INP(I_BGRP) + layer * 4, INP(I_BRTR) + layer * 16, eidx, wts, rank, list, cnt, tinfo, W);
    }
    PH_END(7 + pb)
    PH_BEGIN(8 + pb) {
        LAS unsigned char* tile_e = L + MISC_OFF + 1024; LAS int* rowtok = (LAS int*)(L + MISC_OFF + 2048); LAS float* rowrs = (LAS float*)(L + MISC_OFF + 16384);
        const float* rsv = (const float*)(ws + WS_RS) + (size_t)layer * NT;
        if (tid < 64) { int off[17]; const int ntile = moe_offsets(cnt, off);
            for (int t = lane; t < ntile; t += 64) { const int row = t * 256; int e = 0;
#pragma unroll
                for (int q = 1; q < 16; ++q) e = (row >= off[q]) ? q : e;
                tile_e[t] = (unsigned char)e; }
            if (lane == 0) MISC[4] = (unsigned)ntile; }
        __syncthreads();
        const int ntile = (int)MISC[4];
        { int off[17]; moe_offsets(cnt, off);
          for (int idx = tid; idx < 13 * 256; idx += 512) { const int ui = idx >> 8, r = idx & 255; const long Lu = (long)ui * G + vcu;
              if (Lu < (long)ntile * 4) { const int pm = (int)(Lu >> 2); const int e = tile_e[pm]; int base = 0, ce = 0;
#pragma unroll
                  for (int q = 0; q < 16; ++q) { base = (q == e) ? off[q] : base; ce = (q == e) ? (int)cnt[64 * q] : ce; }
                  const int lr = pm * 256 - base + r; const int tk = (lr < ce) ? list[(size_t)e * NT + lr] : 0; rowtok[idx] = tk; rowrs[idx] = (lr < ce) ? rsv[tk] : 0.f; } } }
        __syncthreads();
        pg8::Gemm g{XRB, WT_GU + (size_t)layer * 16 * 1024 * 1024, 1024, 1024, 1024};
        pg8::MoeOrder S{tile_e, ntile, 4, G, vcu, 1024, 1024, (long)1024 * 1024}; pg8::EpiSwiGLU E{ACT, DEXP, rowrs};
        pg8::gemm_phase<pg8::EpiSwiGLU, pg8::MoeOrder, true, true>(L, g, S, E, rowtok);
#if CV_T8
        if (layer == 0) { CV_TAIL(ntile * 4, vcu, CV8_BASE, CV8_CNT); }
#endif
    }
    PH_END(8 + pb)
    PH_BEGIN(9 + pb) {
        LAS unsigned char* tile_e = L + MISC_OFF + 1024;
        if (tid < 64) { int off[17]; const int ntile = moe_offsets(cnt, off);
            for (int t = lane; t < ntile; t += 64) { const int row = t * 256; int e = 0;
#pragma unroll
                for (int q = 1; q < 16; ++q) e = (row >= off[q]) ? q : e;
                tile_e[t] = (unsigned char)e; }
            if (lane == 0) MISC[4] = (unsigned)ntile; }
        __syncthreads();
        const int ntile = (int)MISC[4];
        pg8::Gemm g{ACT, WT_D + (size_t)layer * 16 * 1024 * 512, DEXP, DEXP, DEXP};
        pg8::MoeOrder S{tile_e, ntile, 4, G, vcu, DEXP, DEXP, (long)1024 * 512}; pg8::EpiStoreAdj E{YB, DM};
        pg8::gemm_phase<pg8::EpiStoreAdj, pg8::MoeOrder, true>(L, g, S, E);
    }
    PH_END(9 + pb)
    PH_BEGIN(10 + pb) {
        if (layer == 0) ph_combine<false>(XRB, nullptr, YB, eidx, rank, wts, cnt, (float*)(ws + WS_RS) + 2 * (size_t)NT, W);
        else ph_combine<true>(XRB, args.out, YB, eidx, rank, wts, cnt, nullptr, W);
    } } } if (layer == 0) SEAM(10);

    }

        PH_BEGIN(11) {
#if MK_GEMM
            pg8::Gemm g{XRB, WT_C, 1024, 1024, 1024}; pg8::StaticOrder S; S.init(NT, PC_LD, 1024, 1024, G, bx);
#if MK_FUSE_PREPC
            pg8::EpiHeadNormA E{PROJC, PC_LD, INP(I_WQG), INP(I_WKG), 0.125f * LOG2E, EPS, 4, 5, (const float*)(ws + WS_RS) + 2 * (size_t)NT};
            pg8::gemm_phase<pg8::EpiHeadNormA, pg8::StaticOrder, true>(L, g, S, E);
#else
            pg8::EpiStoreBf16 E{PROJC, PC_LD};
            pg8::gemm_phase<pg8::EpiStoreBf16, pg8::StaticOrder, true>(L, g, S, E);
#endif
#else
            naive_gemm<0>(HB, 1024, WT_C, 1024, NT, PC_LD, 1024, PROJC, nullptr, nullptr, PC_LD, W);
#endif
        }
        PH_END(11)
#if !MK_FUSE_PREPC
        PH_BEGIN(12) ph_prepc(PROJC, rep_ ? DUMMY : PROJC, INP(I_WQG), INP(I_WKG), W);
        PH_END(12)
#endif
        PH_BEGIN(13) {
            const float negcC = tab[TB_CONST + 2];
#if MK_ATTN
            unsigned long long tsync = 0ull;
#if ATT_WIDE_C
            int wkvh_ = -1;
            for (int u = ATT_MAP; u < 1024; u += G) { const int b = u >> 7, kvh = (u >> 5) & 3, qb = u & 31;
                if (kvh != wkvh_) { __syncthreads(); att::win_bias_tables((char*)lds, tab + TB_BIAS + 2048 * kvh, negcC); wkvh_ = kvh; __syncthreads(); } const size_t r0 = (size_t)b * SEQ, rq = r0 + qb * 128;
                const int q0 = qb * 128; const int lo = q0 >= 128 ? q0 - 128 : 0, hi_ = q0 + 256 < SEQ ? q0 + 256 : SEQ; const int kt0 = lo / 128, kt1 = (hi_ + 127) / 128;
                att::attn_unit16w<64, true>(PROJC + rq * PC_LD + 256 * kvh, nullptr, PC_LD, PROJC + r0 * PC_LD + 1024 + 64 * kvh, PC_LD, nullptr, 0,
                                            PROJC + r0 * PC_LD + 1280 + 64 * kvh, PC_LD, HB + rq * DM + 256 * kvh, DM, kt0, kt1, negcC, (char*)lds, nullptr, nullptr, q0, tab + TB_BIAS + 2048 * kvh, tab + TB_CONST + 16 + 4 * kvh); }
#else
            for (int u = ATT_MAP; u < 2048; u += G) { const int b = u >> 8, kvh = (u >> 6) & 3, qb = u & 63; const size_t r0 = (size_t)b * SEQ, rq = r0 + qb * 64;
                const int q0 = qb * 64; const int lo = q0 >= 128 ? q0 - 128 : 0, hi_ = q0 + 192 < SEQ ? q0 + 192 : SEQ; const int kt0 = lo / att::STAGE_KEYS, kt1 = (hi_ + att::STAGE_KEYS - 1) / att::STAGE_KEYS;
                att::attn_unit<64, true>(PROJC + rq * PC_LD + 256 * kvh, PC_LD, PROJC + r0 * PC_LD + 1024 + 64 * kvh, PC_LD, nullptr, 0,
                                         PROJC + r0 * PC_LD + 1280 + 64 * kvh, PC_LD, HB + rq * DM + 256 * kvh, DM, kt0, kt1, negcC, q0, tab + TB_BIAS + 2048 * kvh, tab + TB_CONST + 16 + 4 * kvh, (char*)lds, tsync); }
#endif
#else
            LAS float* qf = (LAS float*)(L + wave * 512);
            for (long it = W.gw; it < (long)NT * 16; it += W.ngw) { const int m = (int)(it >> 4), h = (int)(it & 15); const size_t r0 = (size_t)(m / SEQ) * SEQ;
                naive_attn_row<64, true>(PROJC + (size_t)m * PC_LD + 64 * h, PROJC + r0 * PC_LD + 1024 + 64 * (h >> 2), PC_LD, nullptr, 0,
                                         PROJC + r0 * PC_LD + 1280 + 64 * (h >> 2), PC_LD, HB + (size_t)m * DM + 64 * h, m & (SEQ - 1), tab + TB_BIAS + 512 * h, tab[TB_CONST + 16 + h], qf, lane); }
            (void)negcC;
#endif
        }
        PH_END(13)
        PH_BEGIN(14) {
#if MK_GEMM
            pg8::Gemm g{HB, WT_OC, 1024, 1024, 1024}; pg8::StaticOrder S; S.init(NT, DM, 1024, 1024, G, bx); pg8::EpiResBBA E{XRB, DM};
            pg8::gemm_phase<pg8::EpiResBBA, pg8::StaticOrder, true>(L, g, S, E);
#else

#endif
        }
        PH_END(14)

    { constexpr int LAYER_ = 1;
    constexpr int layer = LAYER_; constexpr int pb = 8 * layer;
    unsigned* cnt = ctl + CW_CNT + 1024 * layer;
    int* eidx = r_eidx + (size_t)layer * NT * 2; float* wts = r_wts + (size_t)layer * NT * 2; int* rank = r_slot + (size_t)layer * NT * 2;
    int* list = (int*)(ws + WS_LIST);
    bf16* YB = (bf16*)(ws + WS_Y);
    PH_BEGIN(7 + pb) {
        { const u32x4* src = (const u32x4*)(RTAB + (size_t)layer * 65536); LAS u32x4* dst = (LAS u32x4*)L;
          for (int i = tid; i < 8192; i += 512) dst[i] = src[i]; }
        LAS int* tinfo = (LAS int*)(L + MISC_OFF + 2048);
        { const int niter = (NT / 16 - bx * 8 + W.ngw - 1) / W.ngw;
          for (int i = tid; i < 32 + 4 * niter * 128; i += 512) tinfo[i] = (i < 32) ? 0 : -1; }
        __syncthreads();
        ph_router(XRB, (float*)(ws + WS_RS) + (size_t)layer * NT, L, (LAS float*)(L + MISC_OFF + 8192 + wave * 2304), INP(I_BGRP) + layer * 4, INP(I_BRTR) + layer * 16, eidx, wts, rank, list, cnt, tinfo, W);
    }
    PH_END(7 + pb)
    PH_BEGIN(8 + pb) {
        LAS unsigned char* tile_e = L + MISC_OFF + 1024; LAS int* rowtok = (LAS int*)(L + MISC_OFF + 2048); LAS float* rowrs = (LAS float*)(L + MISC_OFF + 16384);
        const float* rsv = (const float*)(ws + WS_RS) + (size_t)layer * NT;
        if (tid < 64) { int off[17]; const int ntile = moe_offsets(cnt, off);
            for (int t = lane; t < ntile; t += 64) { const int row = t * 256; int e = 0;
#pragma unroll
                for (int q = 1; q < 16; ++q) e = (row >= off[q]) ? q : e;
                tile_e[t] = (unsigned char)e; }
            if (lane == 0) MISC[4] = (unsigned)ntile; }
        __syncthreads();
        const int ntile = (int)MISC[4];
        { int off[17]; moe_offsets(cnt, off);
          for (int idx = tid; idx < 13 * 256; idx += 512) { const int ui = idx >> 8, r = idx & 255; const long Lu = (long)ui * G + vcu;
              if (Lu < (long)ntile * 4) { const int pm = (int)(Lu >> 2); const int e = tile_e[pm]; int base = 0, ce = 0;
#pragma unroll
                  for (int q = 0; q < 16; ++q) { base = (q == e) ? off[q] : base; ce = (q == e) ? (int)cnt[64 * q] : ce; }
                  const int lr = pm * 256 - base + r; const int tk = (lr < ce) ? list[(size_t)e * NT + lr] : 0; rowtok[idx] = tk; rowrs[idx] = (lr < ce) ? rsv[tk] : 0.f; } } }
        __syncthreads();
        pg8::Gemm g{XRB, WT_GU + (size_t)layer * 16 * 1024 * 1024, 1024, 1024, 1024};
        pg8::MoeOrder S{tile_e, ntile, 4, G, vcu, 1024, 1024, (long)1024 * 1024}; pg8::EpiSwiGLU E{ACT, DEXP, rowrs};
        pg8::gemm_phase<pg8::EpiSwiGLU, pg8::MoeOrder, true, true>(L, g, S, E, rowtok);
#if CV_T8
        if (layer == 0) { CV_TAIL(ntile * 4, vcu, CV8_BASE, CV8_CNT); }
#endif
    }
    PH_END(8 + pb)
    PH_BEGIN(9 + pb) {
        LAS unsigned char* tile_e = L + MISC_OFF + 1024;
        if (tid < 64) { int off[17]; const int ntile = moe_offsets(cnt, off);
            for (int t = lane; t < ntile; t += 64) { const int row = t * 256; int e = 0;
#pragma unroll
                for (int q = 1; q < 16; ++q) e = (row >= off[q]) ? q : e;
                tile_e[t] = (unsigned char)e; }
            if (lane == 0) MISC[4] = (unsigned)ntile; }
        __syncthreads();
        const int ntile = (int)MISC[4];
        pg8::Gemm g{ACT, WT_D + (size_t)layer * 16 * 1024 * 512, DEXP, DEXP, DEXP};
        pg8::MoeOrder S{tile_e, ntile, 4, G, vcu, DEXP, DEXP, (long)1024 * 512}; pg8::EpiStoreAdj E{YB, DM};
        pg8::gemm_phase<pg8::EpiStoreAdj, pg8::MoeOrder, true>(L, g, S, E);
    }
    PH_END(9 + pb)
    PH_BEGIN(10 + pb) {
        if (layer == 0) ph_combine<false>(XRB, nullptr, YB, eidx, rank, wts, cnt, (float*)(ws + WS_RS) + 2 * (size_t)NT, W);
        else ph_combine<true>(XRB, args.out, YB, eidx, rank, wts, cnt, nullptr, W);
    } } } if (layer == 0) SEAM(10);

    }
#undef IN
#undef INP
#undef SEAM
#undef PH_BEGIN
#undef PH_END
}

extern "C" void kernel_launch(void* const* d_in, const int* in_sizes, int n_in, void* d_out, int out_size, void* d_ws, size_t ws_size, hipStream_t stream) {
    static int grid = 0;
    if (grid == 0) {
        if (n_in != 28 || in_sizes[0] != NT * DM || out_size != NT * DM || ws_size < WS_END) {
            fprintf(stderr, "kernel_launch: shape mismatch: n_in %d in0 %d out %d ws %zu (need >= %zu); nothing launched\n", n_in, n_in > 0 ? in_sizes[0] : -1, out_size, ws_size, (size_t)WS_END); grid = -1; return; }
        int dev = 0, cus = 0, per_cu = 0;
        if (hipGetDevice(&dev) != hipSuccess || hipDeviceGetAttribute(&cus, hipDeviceAttributeMultiprocessorCount, dev) != hipSuccess) { fprintf(stderr, "kernel_launch: device query failed\n"); grid = -1; return; }
        if (hipFuncSetAttribute((const void*)mk_fwd, hipFuncAttributeMaxDynamicSharedMemorySize, LDS_BYTES) != hipSuccess) { fprintf(stderr, "kernel_launch: hipFuncSetAttribute failed\n"); grid = -1; return; }
        if (hipOccupancyMaxActiveBlocksPerMultiprocessor(&per_cu, (const void*)mk_fwd, 512, LDS_BYTES) != hipSuccess || per_cu < 1)
            fprintf(stderr, "kernel_launch: note: occupancy query reports %d workgroups per CU\n", per_cu);
        (void)hipGetLastError();
        grid = cus;
    }
    if (grid < 0) return;
    if (hipMemsetAsync((char*)d_ws + WS_CTL, 0, CTL_ZERO_BYTES, stream) != hipSuccess) { fprintf(stderr, "kernel_launch: memset failed\n"); return; }
    Args a{};
    for (int i = 0; i < 28; ++i) a.in[i] = (const float*)d_in[i];
    a.out = (float*)d_out; a.ws = (unsigned char*)d_ws;
#if MK_ONE_LAUNCH
    a.ph_lo = 0; a.ph_hi = NPHASE;
    hipLaunchKernelGGL(mk_fwd, dim3(grid), dim3(512), LDS_BYTES, stream, a);
#else
    for (int p = 0; p < NPHASE; ++p) { a.ph_lo = p; a.ph_hi = p + 1; hipLaunchKernelGGL(mk_fwd, dim3(grid), dim3(512), LDS_BYTES, stream, a); }
#endif
    const hipError_t le = hipPeekAtLastError();
    if (le != hipSuccess) fprintf(stderr, "kernel_launch: launch failed: %s\n", hipGetErrorName(le));
}
```

```cpp
#define MK_ONE_LAUNCH 1
#define MK_GEMM 1
#define MK_ATTN 1
#define ATT_SG_ON 0
#include <hip/hip_runtime.h>
#include <cstdio>
#include <cstdint>

#ifndef MK_ONE_LAUNCH
#define MK_ONE_LAUNCH 1
#endif
#ifndef MK_GEMM
#define MK_GEMM 1
#endif
#ifndef MK_ATTN
#define MK_ATTN 1
#endif

#define GAS __attribute__((address_space(1)))
#define LAS __attribute__((address_space(3)))
typedef unsigned short bf16;
typedef short bf16x8 __attribute__((ext_vector_type(8)));
typedef short s16x4 __attribute__((ext_vector_type(4)));
typedef float f32x2 __attribute__((ext_vector_type(2)));
typedef float f32x4 __attribute__((ext_vector_type(4)));
typedef float f32x16 __attribute__((ext_vector_type(16)));
typedef unsigned u32x2 __attribute__((ext_vector_type(2)));
typedef unsigned u32x4 __attribute__((ext_vector_type(4)));

constexpr int NBATCH = 8, SEQ = 4096, NT = NBATCH * SEQ, DM = 1024;
constexpr float EPS = 1e-6f;
constexpr float LOG2E = 1.4426950408889634f;
constexpr int PROJ_LD = 1280;
constexpr int UP_LD = 1792, UP_K = 256;
constexpr int PC_LD = 1536;
constexpr int PC_QLAT = 0, PC_KVLAT = 256, PC_BQ = 384, PC_BK = 896, PC_BV = 1024, PC_KROPE = 1152;
constexpr int NEXP = 16, DEXP = 512;
constexpr int MOE_ROWS = 2 * NT + NEXP * 256;

constexpr size_t MiB = 1u << 20;
constexpr size_t WS_CTL = 0, CTL_ZERO_BYTES = 64 * 1024;
constexpr size_t WS_TAB = 1 * MiB;
constexpr size_t WS_ROUTE = 2 * MiB;
constexpr size_t WS_RS = WS_ROUTE + 1536 * 1024;
constexpr size_t WS_WAB = 4 * MiB, WS_WUP = 7 * MiB, WS_WOAB = 9 * MiB, WS_WC = 11 * MiB, WS_WOC = 14 * MiB;
constexpr size_t WS_WGU = 16 * MiB;
constexpr size_t WS_WD = 80 * MiB;
constexpr size_t WS_H = 112 * MiB;
constexpr size_t WS_R = 176 * MiB;
constexpr size_t WS_PROJ = WS_R;
constexpr size_t WS_UPO = WS_R + 80 * MiB;
constexpr size_t WS_PROJC = WS_R;
constexpr size_t WS_Y = WS_R;
constexpr size_t WS_ACT = WS_R + 136 * MiB;
constexpr size_t WS_LIST = WS_R + 204 * MiB;
constexpr size_t WS_XR = WS_R + 206 * MiB;
constexpr size_t WS_RTAB = WS_R + 270 * MiB;
constexpr size_t WS_END = WS_R + 271 * MiB;
static_assert((size_t)MOE_ROWS * 1024 * 2 <= 136 * MiB && (size_t)MOE_ROWS * 512 * 2 <= 68 * MiB, "moe buffers");
constexpr int CW_CNT = 1024;
constexpr int CW_BAR = 4096;
constexpr int TB_BIAS = 0;
constexpr int TB_CONST = 8192;
constexpr int TB_CS = 32768;

constexpr int RING_BYTES = 131072;
constexpr int MISC_OFF = RING_BYTES;
constexpr int LDS_BYTES = 163840;

__device__ __forceinline__ float bf2f(unsigned b) { return __uint_as_float(b << 16); }
__device__ __forceinline__ unsigned f2bf(float f) { unsigned u = __float_as_uint(f); return (u + 0x7fffu + ((u >> 16) & 1u)) >> 16; }
__device__ __forceinline__ unsigned pk2(float lo, float hi) { unsigned r; asm volatile("v_cvt_pk_bf16_f32 %0, %1, %2" : "=v"(r) : "v"(lo), "v"(hi)); return r; }
__device__ __forceinline__ float wave_sum(float v) {
#pragma unroll
    for (int o = 1; o < 64; o <<= 1) v += __shfl_xor(v, o);
    return v;
}
__device__ __forceinline__ float wave_max(float v) {
#pragma unroll
    for (int o = 1; o < 64; o <<= 1) v = fmaxf(v, __shfl_xor(v, o));
    return v;
}
#define LDS_WAIT() asm volatile("s_waitcnt lgkmcnt(0)" ::: "memory")

#define XB_TMO      128
#define XB_XCNT(j)  (256  + 64 * (j))
#define XB_XSUB(j)  (1280 + 64 * (j))
#define XB_XGEN(j)  (2304 + 64 * (j))
#define XB_TOP      3328
#define XB_TOPGEN   3392
#define XCD_BAR_WORDS 3456
#define XB_SPIN_CAP (1u << 18)
__device__ __forceinline__ unsigned xb_ld(unsigned* p)              { return __hip_atomic_load(p, __ATOMIC_RELAXED, __HIP_MEMORY_SCOPE_AGENT); }
__device__ __forceinline__ unsigned xb_add(unsigned* p, unsigned v) { return __hip_atomic_fetch_add(p, v, __ATOMIC_RELAXED, __HIP_MEMORY_SCOPE_AGENT); }
__device__ __forceinline__ unsigned xb_xcc_id() { return (unsigned)__builtin_amdgcn_s_getreg((3 << 11) | 20) & 0xFu; }
#define XB_SPIN(cond, bar) do { unsigned _sp = 0; while (cond) { __builtin_amdgcn_s_sleep(1); \
    if ((++_sp & 255u) == 0u) { if (xb_ld(&(bar)[XB_TMO])) break; if (_sp > XB_SPIN_CAP) { atomicAdd(&(bar)[XB_TMO], 1u); break; } } } } while (0)
struct XcdBarrier { unsigned* bar; unsigned x; volatile LAS unsigned* st; };
__device__ __forceinline__ XcdBarrier xcd_barrier_post(unsigned* bar, volatile LAS unsigned* st) {
    XcdBarrier b; b.bar = bar; b.x = xb_xcc_id(); b.st = st;
    if (threadIdx.x == 0) (void)xb_add(&bar[XB_XCNT(b.x)], 1u);
    return b;
}
__device__ __forceinline__ void xcd_barrier_complete(unsigned* bar, unsigned x, unsigned& nloc, unsigned& nx) {
    const unsigned G = gridDim.x * gridDim.y * gridDim.z;
    unsigned sum, cnt, mine, sp = 0u;
    for (;;) {
        sum = 0u; cnt = 0u; mine = 0u;
#pragma unroll
        for (unsigned j = 0; j < 16; ++j) { const unsigned c = xb_ld(&bar[XB_XCNT(j)]); sum += c; cnt += (c > 0u) ? 1u : 0u; mine = (j == x) ? c : mine; }
        if (sum == G) break;
        __builtin_amdgcn_s_sleep(1);
        if ((++sp & 255u) == 0u) { if (xb_ld(&bar[XB_TMO])) break; if (sp > XB_SPIN_CAP) { atomicAdd(&bar[XB_TMO], 1u); break; } }
    }
    nloc = mine > 0u ? mine : 1u; nx = cnt > 0u ? cnt : 1u;
}
__device__ __forceinline__ void xcd_barrier(const XcdBarrier& b) {
    asm volatile("s_waitcnt vmcnt(0)" ::: "memory");
    __syncthreads();
    if (threadIdx.x == 0) {
        unsigned* bar = b.bar;
        __builtin_amdgcn_s_waitcnt(0);
        unsigned nloc = b.st[0], nx = b.st[1];
        if (nloc == 0u) { xcd_barrier_complete(bar, b.x, nloc, nx); b.st[0] = nloc; b.st[1] = nx; }
        const unsigned old = xb_add(&bar[XB_XSUB(b.x)], 1u);
        const unsigned gen = old / nloc;
        if (old + 1u == (gen + 1u) * nloc) {
            __builtin_amdgcn_fence(__ATOMIC_RELEASE, "agent");
            asm volatile("s_waitcnt vmcnt(0)" ::: "memory");
            const unsigned og = xb_add(&bar[XB_TOP], 1u);
            const unsigned tg = og / nx;
            if (og + 1u == (tg + 1u) * nx) xb_add(&bar[XB_TOPGEN], 1u);
            else XB_SPIN(xb_ld(&bar[XB_TOPGEN]) == tg, bar);
            __builtin_amdgcn_fence(__ATOMIC_ACQUIRE, "agent");
            xb_add(&bar[XB_XGEN(b.x)], 1u);
            asm volatile("s_waitcnt vmcnt(0)" ::: "memory");
        } else {
            XB_SPIN(xb_ld(&bar[XB_XGEN(b.x)]) == gen, bar);
            __builtin_amdgcn_fence(__ATOMIC_ACQUIRE, "agent");
            asm volatile("s_waitcnt vmcnt(0)" ::: "memory");
        }
    }
    __syncthreads();
}
namespace pg8 {
#define PG8_LAS __attribute__((address_space(3)))
typedef unsigned short bf16_t;
constexpr int BM = 256, BK = 64, HALF = 128, HTB = HALF * BK * 2, STAGE_BYTES = 8 * HTB, NXCD = 8, WGM = 8;

__host__ __device__ __forceinline__ int lds_byte(int r, int c) { const int st = (r >> 4) * 2 + (c >> 5), rr = r & 15, cc = c & 31, ob = rr * 64 + cc * 2; return st * 1024 + (ob ^ (((ob >> 9) & 1) << 5)); }
__host__ __device__ __forceinline__ void stage_rc(int b, int& R, int& C) { const int st = b / 1024, sb = b % 1024, swz = sb ^ (((sb >> 9) & 1) << 5); R = (st >> 1) * 16 + swz / 64; C = (st & 1) * 32 + (swz % 64) / 2; }
__host__ __device__ __forceinline__ int perm32(int rho) { const int n = rho >> 4, i = rho & 15; return 8 * (i >> 2) + 4 * n + (i & 3); }

struct Unit { int pm, pn, ui; long aoff, boff; };
struct Gemm { const bf16_t* A; const bf16_t* Bt; int lda, ldb, K; };

struct StaticOrder {
    int nM, nN, nwg, G, c, lda, ldb, asplit;
    __device__ void init(int M, int N, int lda_, int ldb_, int G_, int c_, int asplit_ = 1 << 20) { nM = M / BM; nN = N / BM; nwg = nM * nN; G = G_; c = c_; lda = lda_; ldb = ldb_; asplit = asplit_; }
    __device__ bool next(int i, Unit& u) const {
        const long L = (long)i * G + c; if (L >= nwg) return false;
        int wgid = (int)L; { const int q = nwg / NXCD, r = nwg % NXCD, xcd = wgid % NXCD, off = wgid / NXCD; wgid = (xcd < r ? xcd * (q + 1) : r * (q + 1) + (xcd - r) * q) + off; }
        const int nig = WGM * nN, gid = wgid / nig, fm = gid * WGM, gsz = (nM - fm) < WGM ? (nM - fm) : WGM;
        u.pm = fm + ((wgid % nig) % gsz); u.pn = (wgid % nig) / gsz;
        u.aoff = (long)u.pm * BM * lda + (u.pn >= asplit ? 128 : 0); u.boff = (long)u.pn * BM * ldb; u.ui = i; return true;
    }
};
struct MoeOrder {
    const PG8_LAS unsigned char* tile_e; int ntile, nN, G, vc, lda, ldb; long estride;
    __device__ bool next(int i, Unit& u) const {
        const long L = (long)i * G + vc; if (L >= (long)ntile * nN) return false;
        u.pm = (int)(L / nN); u.pn = (int)(L % nN);
        const int e = tile_e[u.pm];
        u.aoff = (long)u.pm * BM * lda; u.boff = (long)e * estride + (long)u.pn * BM * ldb; u.ui = i; return true;
    }
};

#ifndef NT_STORE
#define NT_STORE 1
#endif
#ifndef NT_RES
#define NT_RES 0
#endif
#ifndef NT_HEAD
#define NT_HEAD 0
#endif
#ifndef NT_PROJ
#define NT_PROJ 0
#endif
#ifndef NT_SWIGLU
#define NT_SWIGLU 0
#endif
#define EPI_STORE16(nt_, p_, w_) do { if (nt_) __builtin_nontemporal_store((w_), (u32x4*)(p_)); else *(u32x4*)(p_) = (w_); } while (0)
struct EpiStoreBf16 {
    static constexpr bool PERM = true;
    bf16_t* O; int ldc;
    __device__ __forceinline__ void operator()(const f32x4 (&acc)[2][2][4][2], const Unit& u, int wr, int wc, int fr, int fq) const {
        const int row0 = u.pm * BM + wr * 64 + fr; const int col0 = u.pn * BM + wc * 32 + 8 * fq;
#pragma unroll
        for (int ai = 0; ai < 2; ++ai)
#pragma unroll
            for (int m = 0; m < 4; ++m) { bf16_t* rowp = O + (size_t)(row0 + ai * HALF + m * 16) * ldc + col0;
#pragma unroll
                for (int bj = 0; bj < 2; ++bj) { const f32x4 v0 = acc[ai][bj][m][0], v1 = acc[ai][bj][m][1];
                    u32x4 w; w.x = pk2(v0[0], v0[1]); w.y = pk2(v0[2], v0[3]); w.z = pk2(v1[0], v1[1]); w.w = pk2(v1[2], v1[3]);
                    EPI_STORE16(NT_STORE, rowp + bj * HALF, w); } }
    }
};
#define LO2(v_) ((f32x2){(v_)[0], (v_)[1]})
#define HI2(v_) ((f32x2){(v_)[2], (v_)[3]})
__device__ __forceinline__ float sumsq16(const f32x4 a0, const f32x4 a1, const f32x4 b0, const f32x4 b1) {
    f32x2 q = LO2(a0) * LO2(a0); q = HI2(a0) * HI2(a0) + q; q = LO2(a1) * LO2(a1) + q; q = HI2(a1) * HI2(a1) + q;
    f32x2 p = LO2(b0) * LO2(b0); p = HI2(b0) * HI2(b0) + p; p = LO2(b1) * LO2(b1) + p; p = HI2(b1) * HI2(b1) + p;
    q = q + p; return q.x + q.y;
}
__device__ __forceinline__ u32x4 scale_pack8(const f32x4 v0, const f32x4 v1, const f32x2 rs2, const f32x4 g0, const f32x4 g1) {
    const f32x2 a = (LO2(v0) * rs2) * LO2(g0), b = (HI2(v0) * rs2) * HI2(g0), c = (LO2(v1) * rs2) * LO2(g1), d = (HI2(v1) * rs2) * HI2(g1);
    u32x4 w; w.x = pk2(a.x, a.y); w.y = pk2(b.x, b.y); w.z = pk2(c.x, c.y); w.w = pk2(d.x, d.y); return w;
}
#define DPP_ROR8(old_, src_, bank_) __builtin_amdgcn_update_dpp((int)(old_), (int)(src_), 0x128, 0xf, (bank_), false)
struct EpiStoreAdj {
    static constexpr bool PERM = true; static constexpr bool ADJ = true;
    bf16_t* O; int ldc;
    __device__ __forceinline__ void operator()(const f32x4 (&acc)[2][2][4][2], const Unit& u, int wr, int wc, int fr, int fq) const {
        const int half = fr >> 3, r8 = fr & 7;
        bf16_t* base = O + (size_t)(u.pm * BM + wr * 64 + r8) * ldc + u.pn * BM + wc * 64 + half * 32 + 8 * fq;
#pragma unroll
        for (int ai = 0; ai < 2; ++ai)
#pragma unroll
            for (int m = 0; m < 4; ++m) {
                u32x4 w0, w1;
                { const f32x4 v0 = acc[ai][0][m][0], v1 = acc[ai][0][m][1]; w0.x = pk2(v0[0], v0[1]); w0.y = pk2(v0[2], v0[3]); w0.z = pk2(v1[0], v1[1]); w0.w = pk2(v1[2], v1[3]); }
                { const f32x4 v0 = acc[ai][1][m][0], v1 = acc[ai][1][m][1]; w1.x = pk2(v0[0], v0[1]); w1.y = pk2(v0[2], v0[3]); w1.z = pk2(v1[0], v1[1]); w1.w = pk2(v1[2], v1[3]); }
                u32x4 dA, dB;
                dA.x = DPP_ROR8(w0.x, w1.x, 0xc); dA.y = DPP_ROR8(w0.y, w1.y, 0xc); dA.z = DPP_ROR8(w0.z, w1.z, 0xc); dA.w = DPP_ROR8(w0.w, w1.w, 0xc);
                dB.x = DPP_ROR8(w1.x, w0.x, 0x3); dB.y = DPP_ROR8(w1.y, w0.y, 0x3); dB.z = DPP_ROR8(w1.z, w0.z, 0x3); dB.w = DPP_ROR8(w1.w, w0.w, 0x3);
                bf16_t* p = base + (size_t)(ai * HALF + m * 16) * ldc;
                EPI_STORE16(NT_STORE, p, dA); EPI_STORE16(NT_STORE, p + (size_t)8 * ldc, dB); }
    }
};
struct EpiResXB {
    static constexpr bool PERM = true;
    const float* base; bf16_t* out; int ldc;
    __device__ __forceinline__ void operator()(const f32x4 (&acc)[2][2][4][2], const Unit& u, int wr, int wc, int fr, int fq) const {
        const int row0 = u.pm * BM + wr * 64 + fr; const int col0 = u.pn * BM + wc * 32 + 8 * fq;
#pragma unroll
        for (int ai = 0; ai < 2; ++ai)
#pragma unroll
            for (int mp = 0; mp < 2; ++mp) {
                f32x4 b[2][2][2];
#pragma unroll
                for (int mm = 0; mm < 2; ++mm) { const size_t off = (size_t)(row0 + ai * HALF + (2 * mp + mm) * 16) * ldc + col0;
#pragma unroll
                    for (int bj = 0; bj < 2; ++bj) { b[mm][bj][0] = *(const f32x4*)(base + off + bj * HALF); b[mm][bj][1] = *(const f32x4*)(base + off + bj * HALF + 4); } }
                asm volatile("" ::: "memory");
#pragma unroll
                for (int mm = 0; mm < 2; ++mm) { const size_t off = (size_t)(row0 + ai * HALF + (2 * mp + mm) * 16) * ldc + col0;
#pragma unroll
                    for (int bj = 0; bj < 2; ++bj) { const f32x4 v0 = b[mm][bj][0] + acc[ai][bj][2 * mp + mm][0], v1 = b[mm][bj][1] + acc[ai][bj][2 * mp + mm][1];
                        u32x4 w; w.x = pk2(v0[0], v0[1]); w.y = pk2(v0[2], v0[3]); w.z = pk2(v1[0], v1[1]); w.w = pk2(v1[2], v1[3]);
                        EPI_STORE16(NT_RES, out + off + bj * HALF, w); } }
                asm volatile("" ::: "memory");
            }
    }
};
struct EpiResBB {
    static constexpr bool PERM = true;
    bf16_t* io; int ldc;
    __device__ __forceinline__ void operator()(const f32x4 (&acc)[2][2][4][2], const Unit& u, int wr, int wc, int fr, int fq) const {
        const int row0 = u.pm * BM + wr * 64 + fr; const int col0 = u.pn * BM + wc * 32 + 8 * fq;
#pragma unroll
        for (int ai = 0; ai < 2; ++ai) {
            u32x4 b[4][2];
#pragma unroll
            for (int m = 0; m < 4; ++m) { const size_t off = (size_t)(row0 + ai * HALF + m * 16) * ldc + col0;
#pragma unroll
                for (int bj = 0; bj < 2; ++bj) b[m][bj] = *(const u32x4*)(io + off + bj * HALF); }
            asm volatile("" ::: "memory");
#pragma unroll
            for (int m = 0; m < 4; ++m) { const size_t off = (size_t)(row0 + ai * HALF + m * 16) * ldc + col0;
#pragma unroll
                for (int bj = 0; bj < 2; ++bj) { const u32x4 x = b[m][bj]; const f32x4 a0 = acc[ai][bj][m][0], a1 = acc[ai][bj][m][1];
                    u32x4 w; w.x = pk2(bf2f(x.x & 0xffffu) + a0[0], bf2f(x.x >> 16) + a0[1]); w.y = pk2(bf2f(x.y & 0xffffu) + a0[2], bf2f(x.y >> 16) + a0[3]);
                    w.z = pk2(bf2f(x.z & 0xffffu) + a1[0], bf2f(x.z >> 16) + a1[1]); w.w = pk2(bf2f(x.w & 0xffffu) + a1[2], bf2f(x.w >> 16) + a1[3]);
                    EPI_STORE16(NT_RES, io + off + bj * HALF, w); } }
            asm volatile("" ::: "memory");
        }
    }
};
struct EpiResXBA {
    static constexpr bool PERM = true; static constexpr bool ADJ = true;
    const float* base; bf16_t* out; int ldc;
    __device__ __forceinline__ void operator()(const f32x4 (&acc)[2][2][4][2], const Unit& u, int wr, int wc, int fr, int fq) const {
        const int half = fr >> 3, r8 = fr & 7;
        const size_t lo = (size_t)(u.pm * BM + wr * 64 + fr) * ldc + u.pn * BM + wc * 64 + 8 * fq;
        const size_t so = (size_t)(u.pm * BM + wr * 64 + r8) * ldc + u.pn * BM + wc * 64 + half * 32 + 8 * fq;
#pragma unroll
        for (int ai = 0; ai < 2; ++ai)
#pragma unroll
            for (int mp = 0; mp < 2; ++mp) {
                f32x4 b[2][2][2];
#pragma unroll
                for (int mm = 0; mm < 2; ++mm) { const size_t off = lo + (size_t)(ai * HALF + (2 * mp + mm) * 16) * ldc;
#pragma unroll
                    for (int bj = 0; bj < 2; ++bj) { b[mm][bj][0] = *(const f32x4*)(base + off + bj * 32); b[mm][bj][1] = *(const f32x4*)(base + off + bj * 32 + 4); } }
                asm volatile("" ::: "memory");
#pragma unroll
                for (int mm = 0; mm < 2; ++mm) { const int m = 2 * mp + mm; u32x4 w[2];
#pragma unroll
                    for (int bj = 0; bj < 2; ++bj) { const f32x4 v0 = b[mm][bj][0] + acc[ai][bj][m][0], v1 = b[mm][bj][1] + acc[ai][bj][m][1];
                        w[bj].x = pk2(v0[0], v0[1]); w[bj].y = pk2(v0[2], v0[3]); w[bj].z = pk2(v1[0], v1[1]); w[bj].w = pk2(v1[2], v1[3]); }
                    u32x4 dA, dB;
                    dA.x = DPP_ROR8(w[0].x, w[1].x, 0xc); dA.y = DPP_ROR8(w[0].y, w[1].y, 0xc); dA.z = DPP_ROR8(w[0].z, w[1].z, 0xc); dA.w = DPP_ROR8(w[0].w, w[1].w, 0xc);
                    dB.x = DPP_ROR8(w[1].x, w[0].x, 0x3); dB.y = DPP_ROR8(w[1].y, w[0].y, 0x3); dB.z = DPP_ROR8(w[1].z, w[0].z, 0x3); dB.w = DPP_ROR8(w[1].w, w[0].w, 0x3);
                    bf16_t* p = out + so + (size_t)(ai * HALF + m * 16) * ldc;
                    EPI_STORE16(NT_RES, p, dA); EPI_STORE16(NT_RES, p + (size_t)8 * ldc, dB); }
                asm volatile("" ::: "memory");
            }
    }
};
struct EpiResBBA {
    static constexpr bool PERM = true; static constexpr bool ADJ = true;
    bf16_t* io; int ldc;
    __device__ __forceinline__ void operator()(const f32x4 (&acc)[2][2][4][2], const Unit& u, int wr, int wc, int fr, int fq) const {
        const int half = fr >> 3, r8 = fr & 7;
        const size_t lo = (size_t)(u.pm * BM + wr * 64 + fr) * ldc + u.pn * BM + wc * 64 + 8 * fq;
        const size_t so = (size_t)(u.pm * BM + wr * 64 + r8) * ldc + u.pn * BM + wc * 64 + half * 32 + 8 * fq;
#pragma unroll
        for (int ai = 0; ai < 2; ++ai) {
            u32x4 b[4][2];
#pragma unroll
            for (int m = 0; m < 4; ++m) { const size_t off = lo + (size_t)(ai * HALF + m * 16) * ldc;
#pragma unroll
                for (int bj = 0; bj < 2; ++bj) b[m][bj] = *(const u32x4*)(io + off + bj * 32); }
            asm volatile("s_waitcnt vmcnt(0)" ::: "memory");
#pragma unroll
            for (int m = 0; m < 4; ++m) { u32x4 w[2];
#pragma unroll
                for (int bj = 0; bj < 2; ++bj) { const u32x4 x = b[m][bj]; const f32x4 a0 = acc[ai][bj][m][0], a1 = acc[ai][bj][m][1];
                    w[bj].x = pk2(bf2f(x.x & 0xffffu) + a0[0], bf2f(x.x >> 16) + a0[1]); w[bj].y = pk2(bf2f(x.y & 0xffffu) + a0[2], bf2f(x.y >> 16) + a0[3]);
                    w[bj].z = pk2(bf2f(x.z & 0xffffu) + a1[0], bf2f(x.z >> 16) + a1[1]); w[bj].w = pk2(bf2f(x.w & 0xffffu) + a1[2], bf2f(x.w >> 16) + a1[3]); }
                u32x4 dA, dB;
                dA.x = DPP_ROR8(w[0].x, w[1].x, 0xc); dA.y = DPP_ROR8(w[0].y, w[1].y, 0xc); dA.z = DPP_ROR8(w[0].z, w[1].z, 0xc); dA.w = DPP_ROR8(w[0].w, w[1].w, 0xc);
                dB.x = DPP_ROR8(w[1].x, w[0].x, 0x3); dB.y = DPP_ROR8(w[1].y, w[0].y, 0x3); dB.z = DPP_ROR8(w[1].z, w[0].z, 0x3); dB.w = DPP_ROR8(w[1].w, w[0].w, 0x3);
                bf16_t* p = io + so + (size_t)(ai * HALF + m * 16) * ldc;
                EPI_STORE16(NT_RES, p, dA); EPI_STORE16(NT_RES, p + (size_t)8 * ldc, dB); }
            asm volatile("" ::: "memory");
        }
    }
};
struct EpiHeadNorm {
    static constexpr bool PERM = true;
    bf16_t* O; int ldc; const float* qg; const float* kg; float qscale; PG8_LAS float* xch; float eps; int nq, nk;
    const float* rowrs;
    __device__ __forceinline__ void operator()(const f32x4 (&acc)[2][2][4][2], const Unit& u, int wr, int wc, int fr, int fq) const {
        const int row0 = u.pm * BM + wr * 64 + fr; const int col0 = u.pn * BM + wc * 32 + 8 * fq;
        if (u.pn >= nk) {
#pragma unroll
            for (int ai = 0; ai < 2; ++ai)
#pragma unroll
                for (int m = 0; m < 4; ++m) { bf16_t* rowp = O + (size_t)(row0 + ai * HALF + m * 16) * ldc + col0; const float r = rowrs ? rowrs[row0 + ai * HALF + m * 16] : 1.0f;
#pragma unroll
                    for (int bj = 0; bj < 2; ++bj) { const f32x4 v0 = acc[ai][bj][m][0], v1 = acc[ai][bj][m][1];
                        u32x4 w; w.x = pk2(v0[0] * r, v0[1] * r); w.y = pk2(v0[2] * r, v0[3] * r); w.z = pk2(v1[0] * r, v1[1] * r); w.w = pk2(v1[2] * r, v1[3] * r);
                        EPI_STORE16(NT_HEAD, rowp + bj * HALF, w); } }
            return;
        }
        const float* gp = (u.pn < nq ? qg : kg) + 32 * (wc & 1) + 8 * fq; const float sc = u.pn < nq ? qscale : 1.0f;
        const f32x4 g0 = *(const f32x4*)gp, g1 = *(const f32x4*)(gp + 4);
        float ss[2][4][2];
#pragma unroll
        for (int ai = 0; ai < 2; ++ai)
#pragma unroll
            for (int m = 0; m < 4; ++m) { const float r = rowrs ? rowrs[row0 + ai * HALF + m * 16] : 1.0f;
#pragma unroll
                for (int bj = 0; bj < 2; ++bj) { const f32x4 a = acc[ai][bj][m][0], b = acc[ai][bj][m][1];
                    float s = (a[0] * a[0] + a[1] * a[1]) + (a[2] * a[2] + a[3] * a[3]) + (b[0] * b[0] + b[1] * b[1]) + (b[2] * b[2] + b[3] * b[3]);
                    s += __shfl_xor(s, 16); s += __shfl_xor(s, 32);
                    s *= r * r;
                    ss[ai][m][bj] = s;
                    if (fq == 0) xch[((ai * HALF + wr * 64 + m * 16 + fr) * 2 + bj) * 4 + wc] = s; } }
        asm volatile("s_waitcnt lgkmcnt(0)" ::: "memory"); __builtin_amdgcn_s_barrier(); asm volatile("" ::: "memory");
#pragma unroll
        for (int ai = 0; ai < 2; ++ai)
#pragma unroll
            for (int m = 0; m < 4; ++m) { bf16_t* rowp = O + (size_t)(row0 + ai * HALF + m * 16) * ldc + col0; const float r = rowrs ? rowrs[row0 + ai * HALF + m * 16] : 1.0f;
#pragma unroll
                for (int bj = 0; bj < 2; ++bj) { const float tot = ss[ai][m][bj] + xch[((ai * HALF + wr * 64 + m * 16 + fr) * 2 + bj) * 4 + (wc ^ 1)];
                    const float rs = r * sc / sqrtf(tot * (1.0f / 64) + eps);
                    const f32x4 v0 = acc[ai][bj][m][0], v1 = acc[ai][bj][m][1];
                    u32x4 w; w.x = pk2(v0[0] * rs * g0[0], v0[1] * rs * g0[1]); w.y = pk2(v0[2] * rs * g0[2], v0[3] * rs * g0[3]);
                    w.z = pk2(v1[0] * rs * g1[0], v1[1] * rs * g1[1]); w.w = pk2(v1[2] * rs * g1[2], v1[3] * rs * g1[3]);
                    EPI_STORE16(NT_HEAD, rowp + bj * HALF, w); } }
        asm volatile("s_waitcnt lgkmcnt(0)" ::: "memory"); __builtin_amdgcn_s_barrier(); asm volatile("" ::: "memory");
    }
};
struct EpiHeadNormA {
    static constexpr bool PERM = true; static constexpr bool ADJ = true;
    bf16_t* O; int ldc; const float* qg; const float* kg; float qscale; float eps; int nq, nk;
    const float* rowrs;
    __device__ __forceinline__ void operator()(const f32x4 (&acc)[2][2][4][2], const Unit& u, int wr, int wc, int fr, int fq) const {
        const int half = fr >> 3, r8 = fr & 7; const int rowb = u.pm * BM + wr * 64;
        bf16_t* base = O + (size_t)(rowb + r8) * ldc + u.pn * BM + wc * 64 + half * 32 + 8 * fq;
        const bool plain = u.pn >= nk;
        const float* gp = (u.pn < nq ? qg : kg) + 8 * fq; const float sc = u.pn < nq ? qscale : 1.0f;
        f32x4 g00 = {1.f, 1.f, 1.f, 1.f}, g01 = g00, g10 = g00, g11 = g00;
        if (!plain) { g00 = *(const f32x4*)gp; g01 = *(const f32x4*)(gp + 4); g10 = *(const f32x4*)(gp + 32); g11 = *(const f32x4*)(gp + 36); }
#pragma unroll
        for (int ai = 0; ai < 2; ++ai)
#pragma unroll
            for (int m = 0; m < 4; ++m) {
                const float r = rowrs ? rowrs[rowb + ai * HALF + m * 16 + fr] : 1.0f;
                const f32x4 a0 = acc[ai][0][m][0], a1 = acc[ai][0][m][1], b0 = acc[ai][1][m][0], b1 = acc[ai][1][m][1];
                float s = sumsq16(a0, a1, b0, b1);
                s += __shfl_xor(s, 16); s += __shfl_xor(s, 32);
                float rs = r * sc * __builtin_amdgcn_rsqf(s * r * r * (1.0f / 64) + eps); rs = plain ? r : rs;
                const f32x2 rs2 = {rs, rs};
                const u32x4 w0 = scale_pack8(a0, a1, rs2, g00, g01), w1 = scale_pack8(b0, b1, rs2, g10, g11);
                u32x4 dA, dB;
                dA.x = DPP_ROR8(w0.x, w1.x, 0xc); dA.y = DPP_ROR8(w0.y, w1.y, 0xc); dA.z = DPP_ROR8(w0.z, w1.z, 0xc); dA.w = DPP_ROR8(w0.w, w1.w, 0xc);
                dB.x = DPP_ROR8(w1.x, w0.x, 0x3); dB.y = DPP_ROR8(w1.y, w0.y, 0x3); dB.z = DPP_ROR8(w1.z, w0.z, 0x3); dB.w = DPP_ROR8(w1.w, w0.w, 0x3);
                bf16_t* p = base + (size_t)(ai * HALF + m * 16) * ldc;
                EPI_STORE16(NT_HEAD, p, dA); EPI_STORE16(NT_HEAD, p + (size_t)8 * ldc, dB); }
    }
};
struct EpiProjNorm {
    static constexpr bool PERM = true;
    bf16_t* O; int ldc; const float* qa; const float* kva; const float* gq; float qscale; PG8_LAS float* xch; float eps;
    __device__ __forceinline__ void operator()(const f32x4 (&acc)[2][2][4][2], const Unit& u, int wr, int wc, int fr, int fq) const {
        const int row0 = u.pm * BM + wr * 64 + fr; const int col0 = u.pn * BM + wc * 32 + 8 * fq;
        if (u.pn >= 4) {
#pragma unroll
            for (int ai = 0; ai < 2; ++ai)
#pragma unroll
                for (int m = 0; m < 4; ++m) { bf16_t* rowp = O + (size_t)(row0 + ai * HALF + m * 16) * ldc + col0;
#pragma unroll
                    for (int bj = 0; bj < 2; ++bj) { const f32x4 v0 = acc[ai][bj][m][0], v1 = acc[ai][bj][m][1];
                        u32x4 w; w.x = pk2(v0[0], v0[1]); w.y = pk2(v0[2], v0[3]); w.z = pk2(v1[0], v1[1]); w.w = pk2(v1[2], v1[3]);
                        EPI_STORE16(NT_PROJ, rowp + bj * HALF, w); } }
            return;
        }
#pragma unroll
        for (int ai = 0; ai < 2; ++ai)
#pragma unroll
            for (int m = 0; m < 4; ++m)
#pragma unroll
                for (int bj = 0; bj < 2; ++bj) { const f32x4 a = acc[ai][bj][m][0], b = acc[ai][bj][m][1];
                    float s = (a[0] * a[0] + a[1] * a[1]) + (a[2] * a[2] + a[3] * a[3]) + (b[0] * b[0] + b[1] * b[1]) + (b[2] * b[2] + b[3] * b[3]);
                    s += __shfl_xor(s, 16); s += __shfl_xor(s, 32);
                    if (fq == 0) xch[((ai * HALF + wr * 64 + m * 16 + fr) * 2 + bj) * 4 + wc] = s; }
        asm volatile("s_waitcnt lgkmcnt(0)" ::: "memory"); __builtin_amdgcn_s_barrier(); asm volatile("" ::: "memory");
#pragma unroll
        for (int bj = 0; bj < 2; ++bj) {
            const int seg = 2 * u.pn + bj; const bool plain = seg >= 7;
            const float* gp = seg < 2 ? qa + 128 * seg + 32 * wc + 8 * fq : (seg == 2 ? kva + 32 * wc + 8 * fq : gq + 32 * (wc & 1) + 8 * fq);
            f32x4 g0 = *(const f32x4*)gp, g1 = *(const f32x4*)(gp + 4);
            if (plain) { g0 = (f32x4){1.f, 1.f, 1.f, 1.f}; g1 = g0; }
            const float sc = (seg >= 3) ? qscale : 1.0f, invn = seg < 2 ? (1.0f / 256) : (seg == 2 ? (1.0f / 128) : (1.0f / 64));
#pragma unroll
            for (int ai = 0; ai < 2; ++ai)
#pragma unroll
                for (int m = 0; m < 4; ++m) { const int r = ai * HALF + wr * 64 + m * 16 + fr;
                    const f32x4 pa = *(const PG8_LAS f32x4*)(xch + (r * 2 + bj) * 4), pb = *(const PG8_LAS f32x4*)(xch + (r * 2 + (bj ^ 1)) * 4);
                    const float pair = (wc & 2) ? (pa[2] + pa[3]) : (pa[0] + pa[1]), quad = (pa[0] + pa[1]) + (pa[2] + pa[3]), all = quad + ((pb[0] + pb[1]) + (pb[2] + pb[3]));
                    const float tot = seg < 2 ? all : (seg == 2 ? quad : pair);
                    float rs = sc / sqrtf(tot * invn + eps); rs = plain ? 1.0f : rs;
                    const f32x4 v0 = acc[ai][bj][m][0], v1 = acc[ai][bj][m][1];
                    u32x4 w; w.x = pk2(v0[0] * rs * g0[0], v0[1] * rs * g0[1]); w.y = pk2(v0[2] * rs * g0[2], v0[3] * rs * g0[3]);
                    w.z = pk2(v1[0] * rs * g1[0], v1[1] * rs * g1[1]); w.w = pk2(v1[2] * rs * g1[2], v1[3] * rs * g1[3]);
                    EPI_STORE16(NT_PROJ, O + (size_t)(row0 + ai * HALF + m * 16) * ldc + col0 + bj * HALF, w); }
        }
        asm volatile("s_waitcnt lgkmcnt(0)" ::: "memory"); __builtin_amdgcn_s_barrier(); asm volatile("" ::: "memory");
    }
};
struct EpiProjNormA {
    static constexpr bool PERM = true; static constexpr bool ADJ = true;
    bf16_t* O; int ldc; const float* qa; const float* kva; const float* gq; float qscale; PG8_LAS float* xch; float eps;
    __device__ __forceinline__ void operator()(const f32x4 (&acc)[2][2][4][2], const Unit& u, int wr, int wc, int fr, int fq) const {
        const int half = fr >> 3, r8 = fr & 7;
        bf16_t* base = O + (size_t)(u.pm * BM + wr * 64 + r8) * ldc + u.pn * BM + wc * 64 + half * 32 + 8 * fq;
        const int mode = u.pn == 0 ? 3 : ((u.pn == 1 && wc < 2) ? 2 : ((u.pn == 4 || (u.pn == 3 && wc >= 2)) ? 0 : 1));
        if (u.pn < 4) {
#pragma unroll
            for (int ai = 0; ai < 2; ++ai)
#pragma unroll
                for (int m = 0; m < 4; ++m) { const f32x4 a0 = acc[ai][0][m][0], a1 = acc[ai][0][m][1], b0 = acc[ai][1][m][0], b1 = acc[ai][1][m][1];
                    float s = sumsq16(a0, a1, b0, b1);
                    s += __shfl_xor(s, 16); s += __shfl_xor(s, 32);
                    if (fq == 0) xch[(ai * HALF + wr * 64 + m * 16 + fr) * 4 + wc] = s; }
            asm volatile("s_waitcnt lgkmcnt(0)" ::: "memory"); __builtin_amdgcn_s_barrier(); asm volatile("" ::: "memory");
        }
        const float* gp = mode == 3 ? qa + 64 * wc + 8 * fq : (mode == 2 ? kva + 64 * wc + 8 * fq : gq + 8 * fq);
        f32x4 g00 = {1.f, 1.f, 1.f, 1.f}, g01 = g00, g10 = g00, g11 = g00;
        if (mode != 0) { g00 = *(const f32x4*)gp; g01 = *(const f32x4*)(gp + 4); g10 = *(const f32x4*)(gp + 32); g11 = *(const f32x4*)(gp + 36); }
        const float sc = mode == 1 ? qscale : 1.0f, invn = mode == 3 ? (1.0f / 256) : (mode == 2 ? (1.0f / 128) : (1.0f / 64));
#pragma unroll
        for (int ai = 0; ai < 2; ++ai)
#pragma unroll
            for (int m = 0; m < 4; ++m) {
                float rs = 1.0f;
                if (u.pn < 4) { const f32x4 pa = *(const PG8_LAS f32x4*)(xch + (ai * HALF + wr * 64 + m * 16 + fr) * 4);
                    const float lo2 = pa[0] + pa[1], hi2 = pa[2] + pa[3];
                    const float own = wc == 0 ? pa[0] : (wc == 1 ? pa[1] : (wc == 2 ? pa[2] : pa[3]));
                    const float tot = mode == 3 ? lo2 + hi2 : (mode == 2 ? (wc < 2 ? lo2 : hi2) : own);
                    rs = mode == 0 ? 1.0f : sc * __builtin_amdgcn_rsqf(tot * invn + eps); }
                const f32x4 a0 = acc[ai][0][m][0], a1 = acc[ai][0][m][1], b0 = acc[ai][1][m][0], b1 = acc[ai][1][m][1];
                const f32x2 rs2 = {rs, rs};
                const u32x4 w0 = scale_pack8(a0, a1, rs2, g00, g01), w1 = scale_pack8(b0, b1, rs2, g10, g11);
                u32x4 dA, dB;
                dA.x = DPP_ROR8(w0.x, w1.x, 0xc); dA.y = DPP_ROR8(w0.y, w1.y, 0xc); dA.z = DPP_ROR8(w0.z, w1.z, 0xc); dA.w = DPP_ROR8(w0.w, w1.w, 0xc);
                dB.x = DPP_ROR8(w1.x, w0.x, 0x3); dB.y = DPP_ROR8(w1.y, w0.y, 0x3); dB.z = DPP_ROR8(w1.z, w0.z, 0x3); dB.w = DPP_ROR8(w1.w, w0.w, 0x3);
                bf16_t* p = base + (size_t)(ai * HALF + m * 16) * ldc;
                EPI_STORE16(NT_PROJ, p, dA); EPI_STORE16(NT_PROJ, p + (size_t)8 * ldc, dB); }
        if (u.pn < 4) { asm volatile("s_waitcnt lgkmcnt(0)" ::: "memory"); __builtin_amdgcn_s_barrier(); asm volatile("" ::: "memory"); }
    }
};
struct EpiKvNorm {
    static constexpr bool PERM = true;
    bf16_t* O; int ldc; const float* kn; PG8_LAS float* xch; float eps;
    __device__ __forceinline__ void operator()(const f32x4 (&acc)[2][2][4][2], const Unit& u, int wr, int wc, int fr, int fq) const {
        const int row0 = u.pm * BM + wr * 64 + fr; const int col0 = u.pn * BM + wc * 32 + 8 * fq;
        float ss[2][4][2];
#pragma unroll
        for (int ai = 0; ai < 2; ++ai)
#pragma unroll
            for (int m = 0; m < 4; ++m)
#pragma unroll
                for (int bj = 0; bj < 2; ++bj) { const f32x4 a = acc[ai][bj][m][0], b = acc[ai][bj][m][1];
                    float s = (a[0] * a[0] + a[1] * a[1]) + (a[2] * a[2] + a[3] * a[3]) + (b[0] * b[0] + b[1] * b[1]) + (b[2] * b[2] + b[3] * b[3]);
                    s += __shfl_xor(s, 16); s += __shfl_xor(s, 32);
                    ss[ai][m][bj] = s;
                    if (fq == 0) xch[((ai * HALF + wr * 64 + m * 16 + fr) * 2 + bj) * 4 + wc] = s; }
        asm volatile("s_waitcnt lgkmcnt(0)" ::: "memory"); __builtin_amdgcn_s_barrier(); asm volatile("" ::: "memory");
        { const bool nw = wc < 2; const float* gp = kn + 32 * (wc & 1) + 8 * fq; f32x4 g0 = *(const f32x4*)gp, g1 = *(const f32x4*)(gp + 4);
          if (!nw) { g0 = (f32x4){1.f, 1.f, 1.f, 1.f}; g1 = g0; }
#pragma unroll
          for (int ai = 0; ai < 2; ++ai)
#pragma unroll
              for (int m = 0; m < 4; ++m) { bf16_t* rowp = O + (size_t)(row0 + ai * HALF + m * 16) * ldc + col0;
#pragma unroll
                  for (int bj = 0; bj < 2; ++bj) { const float tot = ss[ai][m][bj] + xch[((ai * HALF + wr * 64 + m * 16 + fr) * 2 + bj) * 4 + (wc ^ 1)];
                      const float rs = nw ? 1.0f / sqrtf(tot * (1.0f / 64) + eps) : 1.0f;
                      const f32x4 v0 = acc[ai][bj][m][0], v1 = acc[ai][bj][m][1];
                      u32x4 w; w.x = pk2(v0[0] * rs * g0[0], v0[1] * rs * g0[1]); w.y = pk2(v0[2] * rs * g0[2], v0[3] * rs * g0[3]);
                      w.z = pk2(v1[0] * rs * g1[0], v1[1] * rs * g1[1]); w.w = pk2(v1[2] * rs * g1[2], v1[3] * rs * g1[3]);
                      EPI_STORE16(NT_HEAD, rowp + bj * HALF, w); } } }
        asm volatile("s_waitcnt lgkmcnt(0)" ::: "memory"); __builtin_amdgcn_s_barrier(); asm volatile("" ::: "memory");
    }
};
struct EpiSwiGLU {
    static constexpr bool PERM = true;
    bf16_t* O; int ldc; const PG8_LAS float* rowrs;
    __device__ __forceinline__ void operator()(const f32x4 (&acc)[2][2][4][2], const Unit& u, int wr, int wc, int fr, int fq) const {
        const int row0 = u.pm * BM + wr * 64 + fr; const int col0 = u.pn * HALF + wc * 32 + 8 * fq;
#pragma unroll
        for (int ai = 0; ai < 2; ++ai)
#pragma unroll
            for (int m = 0; m < 4; ++m) { bf16_t* rowp = O + (size_t)(row0 + ai * HALF + m * 16) * ldc + col0;
                const float rs = rowrs[u.ui * 256 + ai * HALF + wr * 64 + m * 16 + fr];
                const float kr_ = -rs * 1.4426950408889634f, rs2_ = rs * rs; const f32x2 kr2 = {kr_, kr_}, rq2 = {rs2_, rs2_}, one2 = {1.0f, 1.0f};
                float a[8];
#pragma unroll
                for (int n = 0; n < 2; ++n)
#pragma unroll
                    for (int j = 0; j < 2; ++j) { const f32x2 g = {acc[ai][0][m][n][2 * j], acc[ai][0][m][n][2 * j + 1]}, up = {acc[ai][1][m][n][2 * j], acc[ai][1][m][n][2 * j + 1]};
                        const f32x2 t = g * kr2; f32x2 d; d.x = __builtin_amdgcn_exp2f(t.x); d.y = __builtin_amdgcn_exp2f(t.y); d = d + one2;
                        f32x2 r; r.x = __builtin_amdgcn_rcpf(d.x); r.y = __builtin_amdgcn_rcpf(d.y);
                        const f32x2 o = ((g * up) * rq2) * r; a[n * 4 + 2 * j] = o.x; a[n * 4 + 2 * j + 1] = o.y; }
                u32x4 w; w.x = pk2(a[0], a[1]); w.y = pk2(a[2], a[3]); w.z = pk2(a[4], a[5]); w.w = pk2(a[6], a[7]);
                EPI_STORE16(NT_SWIGLU, rowp, w); }
    }
};

template <class E, class = void> struct epi_adj_t { static constexpr bool v = false; };
template <class E> struct epi_adj_t<E, decltype((void)E::ADJ)> { static constexpr bool v = E::ADJ; };
template <class E> __device__ __forceinline__ constexpr bool epi_adj() { return epi_adj_t<E>::v; }
template <class Epi, class Sched, bool ALIGN_EPI, bool GATHER = false>
__device__ __forceinline__ void gemm_phase(PG8_LAS unsigned char* lds, const Gemm g, const Sched& S, const Epi& E, const PG8_LAS int* rowtok = nullptr) {
    const int tid = threadIdx.x, wid = __builtin_amdgcn_readfirstlane(tid >> 6), lane = tid & 63, wr = wid >> 2, wc = wid & 3, fr = lane & 15, fq = lane >> 4;
    const int K = g.K, nt = K / BK;
    unsigned voffA[2], voffB[2]; int RA[2], CA[2];
#pragma unroll
    for (int i = 0; i < 2; ++i) { int R, C; stage_rc(tid * 16 + i * 8192, R, C); const int Rb = epi_adj<Epi>() ? (64 * (R >> 5) + perm32(R & 31)) : (Epi::PERM ? ((R & ~31) + perm32(R & 31)) : R);
        voffA[i] = (unsigned)(R * g.lda + C) * 2u; voffB[i] = (unsigned)(Rb * g.ldb + C) * 2u; RA[i] = R; CA[i] = C; }
    unsigned gcur[2][2], gnxt[2][2];
#define PG8_GOFF(dst, u_) do { _Pragma("unroll") for (int h_ = 0; h_ < 2; ++h_) _Pragma("unroll") for (int i_ = 0; i_ < 2; ++i_) \
        dst[h_][i_] = (unsigned)(rowtok[(u_) * 256 + h_ * HALF + RA[i_]] * g.lda + CA[i_]) * 2u; } while (0)
    const char* baseA = (const char*)g.A;

    const size_t kstep = (size_t)(BK * 2);
    const size_t hstepA = (size_t)HALF * g.lda * 2, hstepB = (size_t)(epi_adj<Epi>() ? 32 : HALF) * g.ldb * 2;
    const unsigned ldsw = (unsigned)wid * 1024u;
    const int aoff = lds_byte(wr * 64 + fr, fq * 8), boff = lds_byte(wc * 32 + fr, fq * 8);
#define PG8_SA(b, h) (((b) * 2 + (h)) * HTB)
#define PG8_SB(b, h) ((4 + (b) * 2 + (h)) * HTB)
#define PG8_STAGE(bufoff, gbase, voff) do { _Pragma("unroll") for (int _i = 0; _i < 2; ++_i) \
        __builtin_amdgcn_global_load_lds((const unsigned*)((const char*)(gbase) + (voff)[_i]), (PG8_LAS unsigned*)(lds + (bufoff) + ldsw + _i * 8192), 16, 0, 0); } while (0)
#define PG8_LDA(dst, b, h) do { _Pragma("unroll") for (int m = 0; m < 4; ++m) _Pragma("unroll") for (int k = 0; k < 2; ++k) dst[m][k] = *(const PG8_LAS bf16x8*)(lds + PG8_SA(b, h) + aoff + m * 2048 + k * 1024); } while (0)
#define PG8_LDB(dst, b, h) do { _Pragma("unroll") for (int n = 0; n < 2; ++n) _Pragma("unroll") for (int k = 0; k < 2; ++k) dst[n][k] = *(const PG8_LAS bf16x8*)(lds + PG8_SB(b, h) + boff + n * 2048 + k * 1024); } while (0)
#define PG8_MMA(ai, bj, At, Bt) do { __builtin_amdgcn_s_setprio(1); _Pragma("unroll") for (int m = 0; m < 4; ++m) _Pragma("unroll") for (int n = 0; n < 2; ++n) _Pragma("unroll") for (int k = 0; k < 2; ++k) \
        acc[ai][bj][m][n] = __builtin_amdgcn_mfma_f32_16x16x32_bf16(Bt[n][k], At[m][k], acc[ai][bj][m][n], 0, 0, 0); __builtin_amdgcn_s_setprio(0); } while (0)
#define PG8_WAIT_V(n) asm volatile("s_waitcnt vmcnt(" #n ")" ::: "memory")
#define PG8_WAIT_L(n) asm volatile("s_waitcnt lgkmcnt(" #n ")" ::: "memory")
#define PG8_BAR __builtin_amdgcn_s_barrier()
#define PG8_SCHED __builtin_amdgcn_sched_barrier(0)
    Unit cur, nxt; int ui = 0;
    if (!S.next(0, cur)) return;
    f32x4 acc[2][2][4][2];
#pragma unroll
    for (int a = 0; a < 2; ++a)
#pragma unroll
        for (int b = 0; b < 2; ++b)
#pragma unroll
            for (int m = 0; m < 4; ++m)
#pragma unroll
                for (int n = 0; n < 2; ++n) acc[a][b][m][n] = (f32x4){0.f, 0.f, 0.f, 0.f};
    bf16x8 At[4][2], B0[2][2], B1[2][2];
    const char* cA = (const char*)g.A + (size_t)cur.aoff * 2; const char* cB = (const char*)g.Bt + (size_t)cur.boff * 2;
    if constexpr (GATHER) { PG8_GOFF(gcur, 0); }
    PG8_STAGE(PG8_SB(0, 0), cB, voffB); PG8_STAGE(PG8_SB(0, 1), cB + hstepB, voffB);
    if constexpr (GATHER) { PG8_STAGE(PG8_SA(0, 0), baseA, gcur[0]); PG8_STAGE(PG8_SA(0, 1), baseA, gcur[1]); } else { PG8_STAGE(PG8_SA(0, 0), cA, voffA); PG8_STAGE(PG8_SA(0, 1), cA + hstepA, voffA); }
    if (wr == 1) PG8_BAR;
    PG8_WAIT_V(2); PG8_BAR;
    PG8_STAGE(PG8_SB(1, 0), cB + kstep, voffB);
    if constexpr (GATHER) { PG8_STAGE(PG8_SA(1, 0), baseA + kstep, gcur[0]); } else { PG8_STAGE(PG8_SA(1, 0), cA + kstep, voffA); }
    PG8_STAGE(PG8_SB(1, 1), cB + hstepB + kstep, voffB);
    PG8_WAIT_V(6); PG8_BAR;
    for (;;) {
        const bool has_next = S.next(ui + 1, nxt);
        const char* nA = has_next ? (const char*)g.A + (size_t)nxt.aoff * 2 : cA; const char* nB = has_next ? (const char*)g.Bt + (size_t)nxt.boff * 2 : cB;
        if constexpr (GATHER) { if (has_next) { PG8_GOFF(gnxt, ui + 1); } else { _Pragma("unroll") for (int h_ = 0; h_ < 2; ++h_) _Pragma("unroll") for (int i_ = 0; i_ < 2; ++i_) gnxt[h_][i_] = gcur[h_][i_]; } }
        for (int t = 0; t < nt; t += 2) {
            const bool last = (t == nt - 2);
            const char* a1 = cA + (size_t)(t + 1) * kstep;
            const char* a2 = last ? nA : cA + (size_t)(t + 2) * kstep; const char* b2 = last ? nB : cB + (size_t)(t + 2) * kstep;
            const char* a3 = a2 + kstep; const char* b3 = b2 + kstep;
            unsigned gs[2][2]; size_t k2o = 0;
            if constexpr (GATHER) { _Pragma("unroll") for (int h_ = 0; h_ < 2; ++h_) _Pragma("unroll") for (int i_ = 0; i_ < 2; ++i_) gs[h_][i_] = last ? gnxt[h_][i_] : gcur[h_][i_]; k2o = last ? 0 : (size_t)(t + 2) * kstep; }
            PG8_LDB(B0, 0, 0); PG8_LDB(B1, 0, 1); PG8_SCHED; PG8_LDA(At, 0, 0); if constexpr (GATHER) { PG8_STAGE(PG8_SA(1, 1), baseA + (size_t)(t + 1) * kstep, gcur[1]); } else { PG8_STAGE(PG8_SA(1, 1), a1 + hstepA, voffA); }
            PG8_WAIT_V(8); PG8_WAIT_L(0); PG8_BAR; PG8_MMA(0, 0, At, B0); PG8_MMA(0, 1, At, B1); PG8_BAR; PG8_SCHED;
            PG8_LDA(At, 0, 1); PG8_STAGE(PG8_SB(0, 0), b2, voffB); PG8_STAGE(PG8_SB(0, 1), b2 + hstepB, voffB); if constexpr (GATHER) { PG8_STAGE(PG8_SA(0, 0), baseA + k2o, gs[0]); } else { PG8_STAGE(PG8_SA(0, 0), a2, voffA); }
            PG8_WAIT_V(8); PG8_WAIT_L(0); PG8_BAR; PG8_MMA(1, 0, At, B0); PG8_MMA(1, 1, At, B1); PG8_BAR; PG8_SCHED;
            PG8_LDB(B0, 1, 0); PG8_LDB(B1, 1, 1); PG8_SCHED; PG8_LDA(At, 1, 0); if constexpr (GATHER) { PG8_STAGE(PG8_SA(0, 1), baseA + k2o, gs[1]); } else { PG8_STAGE(PG8_SA(0, 1), a2 + hstepA, voffA); }
            PG8_WAIT_V(8); PG8_WAIT_L(0); PG8_BAR; PG8_MMA(0, 0, At, B0); PG8_MMA(0, 1, At, B1); PG8_BAR; PG8_SCHED;
            PG8_LDA(At, 1, 1); PG8_STAGE(PG8_SB(1, 0), b3, voffB); PG8_STAGE(PG8_SB(1, 1), b3 + hstepB, voffB); if constexpr (GATHER) { PG8_STAGE(PG8_SA(1, 0), baseA + k2o + kstep, gs[0]); } else { PG8_STAGE(PG8_SA(1, 0), a3, voffA); }
            PG8_WAIT_V(8); PG8_WAIT_L(0); PG8_BAR; PG8_MMA(1, 0, At, B0); PG8_MMA(1, 1, At, B1); PG8_BAR; PG8_SCHED;
        }
        if constexpr (ALIGN_EPI) { if (wr == 0) PG8_BAR; }
        E(acc, cur, wr, wc, fr, fq);
        if (!has_next) break;
#pragma unroll
        for (int a = 0; a < 2; ++a)
#pragma unroll
            for (int b = 0; b < 2; ++b)
#pragma unroll
                for (int m = 0; m < 4; ++m)
#pragma unroll
                    for (int n = 0; n < 2; ++n) acc[a][b][m][n] = (f32x4){0.f, 0.f, 0.f, 0.f};
        cur = nxt; cA = nA; cB = nB; ++ui;
        if constexpr (GATHER) { _Pragma("unroll") for (int h_ = 0; h_ < 2; ++h_) _Pragma("unroll") for (int i_ = 0; i_ < 2; ++i_) gcur[h_][i_] = gnxt[h_][i_]; }
        if constexpr (ALIGN_EPI) { if (wr == 1) PG8_BAR; }
    }
    PG8_WAIT_V(0);
    if constexpr (!ALIGN_EPI) { if (wr == 0) PG8_BAR; }
    PG8_BAR;
#undef PG8_GOFF
#undef PG8_SA
#undef PG8_SB
#undef PG8_STAGE
#undef PG8_LDA
#undef PG8_LDB
#undef PG8_MMA
#undef PG8_WAIT_V
#undef PG8_WAIT_L
#undef PG8_BAR
#undef PG8_SCHED
}
}
namespace att {
#ifndef ATT_PRIO
#define ATT_PRIO 1
#endif
constexpr int STAGE_KEYS = 128;
#ifndef ATT_PROBE
#define ATT_PROBE 0
#endif
#ifndef ATT_SG_ON
#define ATT_SG_ON 1
#endif
#ifndef ATT_SG_TRANS
#define ATT_SG_TRANS 2
#endif
#ifndef ATT_SG_VALU
#define ATT_SG_VALU 3
#endif
#ifndef ATT_SG_DSR
#define ATT_SG_DSR 2
#endif
constexpr int KVB = 64, STG = 128;
template <int DQK> struct Lay { static constexpr int NQ = DQK / 16, KP = DQK * 2 + 16, KBYTES = STG * KP; };
constexpr int VBYTES = STG * 64 * 2;
constexpr int L_K = 0;
constexpr int L_V = 53248;
constexpr int L_WS = L_V + 2 * VBYTES;
constexpr int L_OST = L_WS + 8 * 64 * 4;
constexpr int L_BT = L_OST + 8 * 4096;
constexpr int L_END = L_BT + 8192;
static_assert(2 * Lay<96>::KBYTES <= L_V && L_END <= RING_BYTES, "attention LDS map");
typedef short v4i16_t __attribute__((ext_vector_type(4)));
typedef __attribute__((address_space(3))) const char* lds_cptr;

__device__ __forceinline__ int crow(int r, int hi) { return (r & 3) + 8 * (r >> 2) + 4 * hi; }
__device__ __forceinline__ int v_st(int k, int c) { return ((k >> 3) * 2 + (c >> 5)) * 512 + ((k & 7) * 32 + (c & 31)) * 2; }
__device__ __forceinline__ int v_rd_base(int lane) { return ((lane & 3) << 3) | (((lane >> 2) & 3) << 6) | (((lane >> 4) & 1) << 5) | (((lane >> 5) & 1) << 8); }
constexpr int v_rd_off(int d0, int ks, int half) { return d0 * 512 + ks * 2048 + half * 1024; }
__device__ __forceinline__ s16x4 vtr(lds_cptr p) { return __builtin_bit_cast(s16x4, __builtin_amdgcn_ds_read_tr16_b64_v4i16((__attribute__((address_space(3))) v4i16_t*)p)); }
#define ATT_PKV(L, H) (bf16x8){L[0], L[1], L[2], L[3], H[0], H[1], H[2], H[3]}
__device__ __forceinline__ void pv_sub(f32x16 (&o)[2], lds_cptr vb, const bf16x8 (&pa)[4]) {
#pragma unroll
    for (int d0 = 0; d0 < 2; ++d0)
#pragma unroll
        for (int ks = 0; ks < 4; ++ks) { const s16x4 l = vtr(vb + v_rd_off(d0, ks, 0)), h = vtr(vb + v_rd_off(d0, ks, 1));
            o[d0] = __builtin_amdgcn_mfma_f32_32x32x16_bf16(pa[ks], ATT_PKV(l, h), o[d0], 0, 0, 0); }
}

constexpr int U16_K = 0, U16_V = 53248, U16_VP = 144, U16_VB = 128 * U16_VP, U16_WS = U16_V + 2 * U16_VB, U16_OST = U16_WS + 2048;
static_assert(U16_OST + 32768 <= RING_BYTES, "16x16 unit LDS map");
template <int DQK>
__device__ __forceinline__ void attn_unit16(const bf16* Qp, const bf16* Qrp  , int ldq, const bf16* Kn, int ldk, const bf16* Kr, int ldkr, const bf16* Vp, int ldv, bf16* Op, int ldo,
                                            int st0, int st1, float negc, char* shm, const float* qrg  , const float* tabcs, int qpos0) {
    constexpr int NKS = DQK / 32, KP = DQK * 2 + 16, KBY = 128 * KP;
    static_assert(2 * KBY <= U16_V, "K ring");
    const int tid = threadIdx.x, lane = tid & 63, i16 = lane & 15, g = lane >> 4; const int wid = __builtin_amdgcn_readfirstlane(tid >> 6);
    char* K_lds = shm + U16_K; char* V_lds = shm + U16_V;
    float* wsf = (float*)(shm + U16_WS) + wid * 64;
    bf16x8 qr[2][NKS];
#pragma unroll
    for (int qb = 0; qb < 2; ++qb) { const size_t ro = (size_t)(wid * 32 + qb * 16 + i16) * ldq + g * 8;
#pragma unroll
        for (int ks = 0; ks < NKS; ++ks) qr[qb][ks] = (DQK == 96 && ks == 2) ? *reinterpret_cast<const bf16x8*>(Qrp + ro) : *reinterpret_cast<const bf16x8*>(Qp + ro + ks * 32); }
    if constexpr (DQK == 96) { if (qrg != nullptr) {
        float gq[8]; { const f32x4 a_ = *(const f32x4*)(qrg + 8 * g), b_ = *(const f32x4*)(qrg + 8 * g + 4); gq[0] = a_[0]; gq[1] = a_[1]; gq[2] = a_[2]; gq[3] = a_[3]; gq[4] = b_[0]; gq[5] = b_[1]; gq[6] = b_[2]; gq[7] = b_[3]; }
        const float sA_ = 0.10206207261596577f * LOG2E; const bool lo_ = g < 2;
#pragma unroll
        for (int qb = 0; qb < 2; ++qb) { const int pos = qpos0 + wid * 32 + qb * 16 + i16;
            const f32x4* tp = (const f32x4*)(tabcs + ((size_t)pos * 16 + 8 * (g & 1)) * 2); const f32x4 t0 = tp[0], t1 = tp[1], t2 = tp[2], t3 = tp[3];
            const float cs[8] = {t0[0], t0[2], t1[0], t1[2], t2[0], t2[2], t3[0], t3[2]}, sn[8] = {t0[1], t0[3], t1[1], t1[3], t2[1], t2[3], t3[1], t3[3]};
            const u32x4 raw = __builtin_bit_cast(u32x4, qr[qb][2]);
            float x[8] = {bf2f(raw.x & 0xffffu), bf2f(raw.x >> 16), bf2f(raw.y & 0xffffu), bf2f(raw.y >> 16), bf2f(raw.z & 0xffffu), bf2f(raw.z >> 16), bf2f(raw.w & 0xffffu), bf2f(raw.w >> 16)};
            float ss = 0.f;
#pragma unroll
            for (int e = 0; e < 8; ++e) ss += x[e] * x[e];
            ss += __shfl_xor(ss, 16); ss += __shfl_xor(ss, 32);
            const float rs = 1.0f / sqrtf(ss * (1.0f / 32) + EPS);
            float o8[8];
#pragma unroll
            for (int e = 0; e < 8; ++e) { const float y = x[e] * rs * gq[e]; const float yp = __shfl_xor(y, 32); o8[e] = (lo_ ? (y * cs[e] - yp * sn[e]) : (y * cs[e] + yp * sn[e])) * sA_; }
            u32x4 w; w.x = pk2(o8[0], o8[1]); w.y = pk2(o8[2], o8[3]); w.z = pk2(o8[4], o8[5]); w.w = pk2(o8[6], o8[7]);
            qr[qb][2] = __builtin_bit_cast(bf16x8, w); } } }
    const int srow = tid >> 3, sc = tid & 7;
    const bf16* kn_src = Kn + (size_t)srow * ldk + sc * 8;
    const bf16* v_src = Vp + (size_t)srow * ldv + sc * 8;
    const bf16* kr_src = (DQK == 96) ? (Kr + (size_t)(tid >> 2) * ldkr + (tid & 3) * 8) : nullptr;
    const int kn_dst = srow * KP + sc * 16, kr_dst = (tid >> 2) * KP + 128 + (tid & 3) * 16, v_dst = srow * U16_VP + sc * 16;
    const char* kfr = K_lds + i16 * KP + g * 16;
    const lds_cptr vfr = (lds_cptr)(V_lds) + (4 * g + (i16 >> 2)) * U16_VP + (i16 & 3) * 8;
    bf16x8 s_kn0, s_kn1, s_kr, s_v0, s_v1;
#define U_LOAD(t) do { const size_t k0_ = (size_t)(t) * 128; s_kn0 = *reinterpret_cast<const bf16x8*>(kn_src + k0_ * ldk); s_kn1 = *reinterpret_cast<const bf16x8*>(kn_src + (k0_ + 64) * ldk); \
        s_v0 = *reinterpret_cast<const bf16x8*>(v_src + k0_ * ldv); s_v1 = *reinterpret_cast<const bf16x8*>(v_src + (k0_ + 64) * ldv); \
        if (DQK == 96) { s_kr = *reinterpret_cast<const bf16x8*>(kr_src + k0_ * ldkr); } } while (0)
#define U_WRITE(b) do { *reinterpret_cast<bf16x8*>(K_lds + (b) * KBY + kn_dst) = s_kn0; *reinterpret_cast<bf16x8*>(K_lds + (b) * KBY + 64 * KP + kn_dst) = s_kn1; \
        *reinterpret_cast<bf16x8*>(V_lds + (b) * U16_VB + v_dst) = s_v0; *reinterpret_cast<bf16x8*>(V_lds + (b) * U16_VB + 64 * U16_VP + v_dst) = s_v1; \
        if (DQK == 96) { *reinterpret_cast<bf16x8*>(K_lds + (b) * KBY + kr_dst) = s_kr; } } while (0)
    f32x4 o[2][4];
#pragma unroll
    for (int qb = 0; qb < 2; ++qb)
#pragma unroll
        for (int d = 0; d < 4; ++d) o[qb][d] = (f32x4){0.f, 0.f, 0.f, 0.f};
    float lsum0 = 0.f, lsum1 = 0.f;
    U_LOAD(st0); U_WRITE(0); __syncthreads();
#if ATT_PRIO
    if (wid >= 4) __builtin_amdgcn_s_setprio(1);
#endif
    for (int t = st0; t < st1; ++t) {
        const int cur = (t - st0) & 1;
        { const int tn_ = (t + 1 < st1) ? t + 1 : t; U_LOAD(tn_); }
#pragma unroll
        for (int sub = 0; sub < 2; ++sub) {
            f32x4 s[2][4];
#pragma unroll
            for (int qb = 0; qb < 2; ++qb)
#pragma unroll
                for (int kb = 0; kb < 4; ++kb) s[qb][kb] = (f32x4){negc, negc, negc, negc};
            { const char* kb_ = kfr + cur * KBY + (sub * 64) * KP;
#pragma unroll
              for (int ks = 0; ks < NKS; ++ks)
#pragma unroll
                  for (int kb = 0; kb < 4; ++kb) { const bf16x8 kf = *reinterpret_cast<const bf16x8*>(kb_ + kb * 16 * KP + ks * 64);
                      s[0][kb] = __builtin_amdgcn_mfma_f32_16x16x32_bf16(kf, qr[0][ks], s[0][kb], 0, 0, 0);
                      s[1][kb] = __builtin_amdgcn_mfma_f32_16x16x32_bf16(kf, qr[1][ks], s[1][kb], 0, 0, 0); } }
#pragma unroll
            for (int qb = 0; qb < 2; ++qb)
#pragma unroll
                for (int kb = 0; kb < 4; ++kb) { s[qb][kb][0] = __builtin_amdgcn_exp2f(s[qb][kb][0]); s[qb][kb][1] = __builtin_amdgcn_exp2f(s[qb][kb][1]);
                    s[qb][kb][2] = __builtin_amdgcn_exp2f(s[qb][kb][2]); s[qb][kb][3] = __builtin_amdgcn_exp2f(s[qb][kb][3]); }
            { float a0 = 0.f, a1 = 0.f;
#pragma unroll
              for (int kb = 0; kb < 4; ++kb) { a0 += (s[0][kb][0] + s[0][kb][1]) + (s[0][kb][2] + s[0][kb][3]); a1 += (s[1][kb][0] + s[1][kb][1]) + (s[1][kb][2] + s[1][kb][3]); }
              lsum0 += a0; lsum1 += a1; }
            bf16x8 pa[2][2];
#pragma unroll
            for (int qb = 0; qb < 2; ++qb)
#pragma unroll
                for (int kp = 0; kp < 2; ++kp) { u32x4 w; w.x = pk2(s[qb][2 * kp][0], s[qb][2 * kp][1]); w.y = pk2(s[qb][2 * kp][2], s[qb][2 * kp][3]);
                    w.z = pk2(s[qb][2 * kp + 1][0], s[qb][2 * kp + 1][1]); w.w = pk2(s[qb][2 * kp + 1][2], s[qb][2 * kp + 1][3]); pa[qb][kp] = *reinterpret_cast<bf16x8*>(&w); }
            { const lds_cptr vb_ = vfr + cur * U16_VB + (sub * 64) * U16_VP;
#pragma unroll
              for (int kp = 0; kp < 2; ++kp)
#pragma unroll
                  for (int d = 0; d < 4; ++d) { const s16x4 l = vtr(vb_ + (2 * kp) * 16 * U16_VP + d * 32), h = vtr(vb_ + (2 * kp + 1) * 16 * U16_VP + d * 32);
                      const bf16x8 vf = ATT_PKV(l, h);
                      o[0][d] = __builtin_amdgcn_mfma_f32_16x16x32_bf16(pa[0][kp], vf, o[0][d], 0, 0, 0);
                      o[1][d] = __builtin_amdgcn_mfma_f32_16x16x32_bf16(pa[1][kp], vf, o[1][d], 0, 0, 0); } }
        }
        U_WRITE(cur ^ 1);
        __syncthreads();
    }
#if ATT_PRIO
    __builtin_amdgcn_s_setprio(0);
#endif
#undef U_LOAD
#undef U_WRITE
    lsum0 += __shfl_xor(lsum0, 16); lsum0 += __shfl_xor(lsum0, 32); lsum1 += __shfl_xor(lsum1, 16); lsum1 += __shfl_xor(lsum1, 32);
    if (g == 0) { wsf[i16] = lsum0; wsf[16 + i16] = lsum1; }
    LDS_WAIT();
    { bf16* stg = (bf16*)(shm + U16_OST) + wid * 2048;
#pragma unroll
      for (int qb = 0; qb < 2; ++qb)
#pragma unroll
          for (int r = 0; r < 4; ++r) { const int q = 16 * qb + 4 * g + r; const float rl = __builtin_amdgcn_rcpf(wsf[q]);
#pragma unroll
              for (int d = 0; d < 4; ++d) stg[q * 64 + 16 * d + i16] = (bf16)f2bf(o[qb][d][r] * rl); }
      LDS_WAIT();
      bf16* Ow = Op + (size_t)(wid * 32) * ldo;
#pragma unroll
      for (int i = 0; i < 4; ++i) { const int row = i * 8 + (lane >> 3), ch = lane & 7; const u32x4 v = *(const u32x4*)(stg + row * 64 + ch * 8); *(u32x4*)(Ow + (size_t)row * ldo + ch * 8) = v; } }
    __syncthreads();
}

constexpr int WBT_OFF = MISC_OFF + 64, WBT_LEN = 480, WBT_ZERO = 240;
static_assert(WBT_OFF + 16 * WBT_LEN * 4 <= LDS_BYTES, "window bias tables");
__device__ __forceinline__ void win_bias_tables(char* shm, const float* gtab, float negc) {
    float* T = (float*)(shm + WBT_OFF);
    for (int i = threadIdx.x; i < 16 * WBT_LEN; i += blockDim.x) { const int hs = i / WBT_LEN, j = i - hs * WBT_LEN, h = hs >> 2, sft = hs & 3;
        T[i] = gtab[h * 512 + (j + sft - WBT_ZERO + 256)] + negc; }
}
#ifndef ATT_MSUM_A
#define ATT_MSUM_A 1
#endif
#ifndef ATT_MSUM
#define ATT_MSUM 1
#endif
#ifndef ATT_NT
#define ATT_NT 1
#endif
template <int DQK, bool WIN = false>
__device__ __forceinline__ void attn_unit16w(const bf16* Qp, const bf16* Qrp, int ldq, const bf16* Kn, int ldk, const bf16* Kr, int ldkr, const bf16* Vp, int ldv, bf16* Op, int ldo, int st0, int st1, float negc, char* shm,
                                             const float* qrg, const float* tabcs, int qpos0, const float* btab = nullptr, const float* sinkp = nullptr) {
    constexpr int NKS = DQK / 32, KP = DQK * 2 + 16, KBY = 128 * KP, NQB = 4;
    const int tid = threadIdx.x, lane = tid & 63, i16 = lane & 15, g = lane >> 4; const int wid = __builtin_amdgcn_readfirstlane(tid >> 6);
    char* K_lds = shm + U16_K; char* V_lds = shm + U16_V;
    float* wsf = (float*)(shm + U16_WS) + wid * 64;
    const int wrow = WIN ? (wid >> 2) * 64 : wid * 64, hcol = WIN ? (wid & 3) * 64 : 0;
    static_assert(!WIN || DQK == 64, "window unit");
    const int qw = qpos0 + wrow;
    const float* wbt = (const float*)(shm + WBT_OFF) + (((wid & 3) * 4 + ((-i16) & 3)) * WBT_LEN) + (4 * g - (qw + i16) + WBT_ZERO - ((-i16) & 3));
    (void)btab;
    bf16x8 qr[NQB][NKS];
#pragma unroll
    for (int qb = 0; qb < NQB; ++qb) { const size_t ro = (size_t)(wrow + qb * 16 + i16) * ldq + hcol + g * 8;
#pragma unroll
        for (int ks = 0; ks < NKS; ++ks) { const bf16x8* qp_ = (DQK == 96 && ks == 2) ? reinterpret_cast<const bf16x8*>(Qrp + ro) : reinterpret_cast<const bf16x8*>(Qp + ro + ks * 32);
            qr[qb][ks] = ATT_NT ? __builtin_nontemporal_load(qp_) : *qp_; } }
    if constexpr (DQK == 96) { if (qrg != nullptr) {
        float gq[8]; { const f32x4 a_ = *(const f32x4*)(qrg + 8 * g), b_ = *(const f32x4*)(qrg + 8 * g + 4); gq[0] = a_[0]; gq[1] = a_[1]; gq[2] = a_[2]; gq[3] = a_[3]; gq[4] = b_[0]; gq[5] = b_[1]; gq[6] = b_[2]; gq[7] = b_[3]; }
        const float sA_ = 0.10206207261596577f * LOG2E; const bool lo_ = g < 2;
#pragma unroll
        for (int qb = 0; qb < NQB; ++qb) { const int pos = qpos0 + wid * 64 + qb * 16 + i16;
            const f32x4* tp = (const f32x4*)(tabcs + ((size_t)pos * 16 + 8 * (g & 1)) * 2); const f32x4 t0 = tp[0], t1 = tp[1], t2 = tp[2], t3 = tp[3];
            const float cs[8] = {t0[0], t0[2], t1[0], t1[2], t2[0], t2[2], t3[0], t3[2]}, sn[8] = {t0[1], t0[3], t1[1], t1[3], t2[1], t2[3], t3[1], t3[3]};
            const u32x4 raw = __builtin_bit_cast(u32x4, qr[qb][2]);
            float x[8] = {bf2f(raw.x & 0xffffu), bf2f(raw.x >> 16), bf2f(raw.y & 0xffffu), bf2f(raw.y >> 16), bf2f(raw.z & 0xffffu), bf2f(raw.z >> 16), bf2f(raw.w & 0xffffu), bf2f(raw.w >> 16)};
            float ss = 0.f;
#pragma unroll
            for (int e = 0; e < 8; ++e) ss += x[e] * x[e];
            ss += __shfl_xor(ss, 16); ss += __shfl_xor(ss, 32);
            const float rs = 1.0f / sqrtf(ss * (1.0f / 32) + EPS);
            float o8[8];
#pragma unroll
            for (int e = 0; e < 8; ++e) { const float y = x[e] * rs * gq[e]; const float yp = __shfl_xor(y, 32); o8[e] = (lo_ ? (y * cs[e] - yp * sn[e]) : (y * cs[e] + yp * sn[e])) * sA_; }
            u32x4 w; w.x = pk2(o8[0], o8[1]); w.y = pk2(o8[2], o8[3]); w.z = pk2(o8[4], o8[5]); w.w = pk2(o8[6], o8[7]);
            qr[qb][2] = __builtin_bit_cast(bf16x8, w); } } }
    if constexpr (DQK == 64 && !WIN) { if (tabcs != nullptr) {
        const bool lo_ = g < 2;
#pragma unroll
        for (int qb = 0; qb < NQB; ++qb) { const int s_ = qpos0 + wid * 64 + qb * 16 + i16;
#pragma unroll
            for (int ks = 0; ks < 2; ++ks) { const int pos = ks ? (s_ & 63) : (s_ >> 6);
                const f32x4* tp = (const f32x4*)(tabcs + ((size_t)pos * 16 + 8 * (g & 1)) * 2); const f32x4 t0 = tp[0], t1 = tp[1], t2 = tp[2], t3 = tp[3];
                const float cs[8] = {t0[0], t0[2], t1[0], t1[2], t2[0], t2[2], t3[0], t3[2]}, sn[8] = {t0[1], t0[3], t1[1], t1[3], t2[1], t2[3], t3[1], t3[3]};
                const u32x4 raw = __builtin_bit_cast(u32x4, qr[qb][ks]);
                const float x[8] = {bf2f(raw.x & 0xffffu), bf2f(raw.x >> 16), bf2f(raw.y & 0xffffu), bf2f(raw.y >> 16), bf2f(raw.z & 0xffffu), bf2f(raw.z >> 16), bf2f(raw.w & 0xffffu), bf2f(raw.w >> 16)};
                float o8[8];
#pragma unroll
                for (int e = 0; e < 8; ++e) { const float yp = __shfl_xor(x[e], 32); o8[e] = lo_ ? (x[e] * cs[e] - yp * sn[e]) : (x[e] * cs[e] + yp * sn[e]); }
                u32x4 w; w.x = pk2(o8[0], o8[1]); w.y = pk2(o8[2], o8[3]); w.z = pk2(o8[4], o8[5]); w.w = pk2(o8[6], o8[7]);
                qr[qb][ks] = __builtin_bit_cast(bf16x8, w); } } } }
    const int srow = tid >> 3, sc = tid & 7;
    const bf16* kn_src = Kn + (size_t)srow * ldk + sc * 8;
    const bf16* v_src = Vp + (size_t)srow * ldv + sc * 8;
    const bf16* kr_src = (DQK == 96) ? (Kr + (size_t)(tid >> 2) * ldkr + (tid & 3) * 8) : nullptr;
    const int kn_dst = srow * KP + sc * 16, kr_dst = (tid >> 2) * KP + 128 + (tid & 3) * 16, v_dst = srow * U16_VP + sc * 16;
    const char* kfr = K_lds + i16 * KP + g * 16;
    const lds_cptr vfr = (lds_cptr)(V_lds) + (4 * g + (i16 >> 2)) * U16_VP + (i16 & 3) * 8;
    bf16x8 s_kn0, s_kr, s_v0;
#define W_LOADA(t) do { const size_t k0_ = (size_t)(t) * 128; s_kn0 = *reinterpret_cast<const bf16x8*>(kn_src + k0_ * ldk); s_v0 = *reinterpret_cast<const bf16x8*>(v_src + k0_ * ldv); \
        if (DQK == 96) { s_kr = *reinterpret_cast<const bf16x8*>(kr_src + k0_ * ldkr); } } while (0)
#define W_WRITEA(b) do { *reinterpret_cast<bf16x8*>(K_lds + (b) * KBY + kn_dst) = s_kn0; *reinterpret_cast<bf16x8*>(V_lds + (b) * U16_VB + v_dst) = s_v0; \
        if (DQK == 96) { *reinterpret_cast<bf16x8*>(K_lds + (b) * KBY + kr_dst) = s_kr; } } while (0)
#define W_LOADB(t) do { const size_t k0_ = (size_t)(t) * 128 + 64; s_kn0 = *reinterpret_cast<const bf16x8*>(kn_src + k0_ * ldk); s_v0 = *reinterpret_cast<const bf16x8*>(v_src + k0_ * ldv); } while (0)
#define W_WRITEB(b) do { *reinterpret_cast<bf16x8*>(K_lds + (b) * KBY + 64 * KP + kn_dst) = s_kn0; *reinterpret_cast<bf16x8*>(V_lds + (b) * U16_VB + 64 * U16_VP + v_dst) = s_v0; } while (0)
    f32x4 o[NQB][4];
#pragma unroll
    for (int qb = 0; qb < NQB; ++qb)
#pragma unroll
        for (int d = 0; d < 4; ++d) o[qb][d] = (f32x4){0.f, 0.f, 0.f, 0.f};
    constexpr bool MSUM = ATT_MSUM && (DQK == 64 || ATT_MSUM_A);
    float lsum[NQB] = {0.f, 0.f, 0.f, 0.f};
    f32x4 ol[NQB];
#pragma unroll
    for (int qb = 0; qb < NQB; ++qb) ol[qb] = (f32x4){0.f, 0.f, 0.f, 0.f};
    const bf16x8 ones8 = {(short)0x3F80, (short)0x3F80, (short)0x3F80, (short)0x3F80, (short)0x3F80, (short)0x3F80, (short)0x3F80, (short)0x3F80};
    W_LOADA(st0); W_WRITEA(0); W_LOADB(st0); W_WRITEB(0); __syncthreads();
#if ATT_PRIO
    if (wid >= 4) __builtin_amdgcn_s_setprio(1);
#endif
    for (int t = st0; t < st1; ++t) {
        const int cur = (t - st0) & 1;
        const int tn_ = (t + 1 < st1) ? t + 1 : t; W_LOADA(tn_);
#pragma unroll
        for (int sub = 0; sub < 2; ++sub) {
            if (sub == 1) { W_WRITEA(cur ^ 1); W_LOADB(tn_); }
            const char* kb_ = kfr + cur * KBY + (sub * 64) * KP; const lds_cptr vb_ = vfr + cur * U16_VB + (sub * 64) * U16_VP;
#pragma unroll
            for (int kp = 0; kp < 2; ++kp) {
                const int k0 = t * 128 + sub * 64 + kp * 32;
                if (WIN && !((k0 + 31 >= qw - 128) && (k0 <= qw + 191))) continue;
                f32x4 s[NQB][2];
#pragma unroll
                for (int qb = 0; qb < NQB; ++qb)
#pragma unroll
                    for (int kl = 0; kl < 2; ++kl) { if constexpr (WIN) s[qb][kl] = *reinterpret_cast<const f32x4*>(wbt + k0 + 16 * kl - 16 * qb); else s[qb][kl] = (f32x4){negc, negc, negc, negc}; }
#pragma unroll
                for (int ks = 0; ks < NKS; ++ks)
#pragma unroll
                    for (int kl = 0; kl < 2; ++kl) { const bf16x8 kf = *reinterpret_cast<const bf16x8*>(kb_ + (2 * kp + kl) * 16 * KP + ks * 64);
#pragma unroll
                        for (int qb = 0; qb < NQB; ++qb) s[qb][kl] = __builtin_amdgcn_mfma_f32_16x16x32_bf16(kf, qr[qb][ks], s[qb][kl], 0, 0, 0); }
                bf16x8 pa[NQB];
#pragma unroll
                for (int qb = 0; qb < NQB; ++qb) {
#pragma unroll
                    for (int kl = 0; kl < 2; ++kl) { s[qb][kl][0] = __builtin_amdgcn_exp2f(s[qb][kl][0]); s[qb][kl][1] = __builtin_amdgcn_exp2f(s[qb][kl][1]);
                        s[qb][kl][2] = __builtin_amdgcn_exp2f(s[qb][kl][2]); s[qb][kl][3] = __builtin_amdgcn_exp2f(s[qb][kl][3]); }
                    if constexpr (!MSUM) lsum[qb] += ((s[qb][0][0] + s[qb][0][1]) + (s[qb][0][2] + s[qb][0][3])) + ((s[qb][1][0] + s[qb][1][1]) + (s[qb][1][2] + s[qb][1][3]));
                    u32x4 w; w.x = pk2(s[qb][0][0], s[qb][0][1]); w.y = pk2(s[qb][0][2], s[qb][0][3]); w.z = pk2(s[qb][1][0], s[qb][1][1]); w.w = pk2(s[qb][1][2], s[qb][1][3]);
                    pa[qb] = *reinterpret_cast<bf16x8*>(&w); }
#pragma unroll
                for (int d = 0; d < 4; ++d) { const s16x4 l = vtr(vb_ + (2 * kp) * 16 * U16_VP + d * 32), h = vtr(vb_ + (2 * kp + 1) * 16 * U16_VP + d * 32);
                    const bf16x8 vf = ATT_PKV(l, h);
#pragma unroll
                    for (int qb = 0; qb < NQB; ++qb) o[qb][d] = __builtin_amdgcn_mfma_f32_16x16x32_bf16(pa[qb], vf, o[qb][d], 0, 0, 0); }
                if constexpr (MSUM) {
#pragma unroll
                    for (int qb = 0; qb < NQB; ++qb) ol[qb] = __builtin_amdgcn_mfma_f32_16x16x32_bf16(pa[qb], ones8, ol[qb], 0, 0, 0); }
            }
        }
        W_WRITEB(cur ^ 1);
        __syncthreads();
    }
#if ATT_PRIO
    __builtin_amdgcn_s_setprio(0);
#endif
#undef W_LOADA
#undef W_WRITEA
#undef W_LOADB
#undef W_WRITEB
    if constexpr (!MSUM) {
#pragma unroll
        for (int qb = 0; qb < NQB; ++qb) { lsum[qb] += __shfl_xor(lsum[qb], 16); lsum[qb] += __shfl_xor(lsum[qb], 32); if constexpr (WIN) lsum[qb] += __builtin_amdgcn_exp2f(sinkp[wid & 3] + negc); }
        if (g == 0) {
#pragma unroll
            for (int qb = 0; qb < NQB; ++qb) wsf[16 * qb + i16] = lsum[qb];
        }
        LDS_WAIT();
    } else if constexpr (WIN) { const float sk_ = __builtin_amdgcn_exp2f(sinkp[wid & 3] + negc);
#pragma unroll
        for (int qb = 0; qb < NQB; ++qb) { ol[qb][0] += sk_; ol[qb][1] += sk_; ol[qb][2] += sk_; ol[qb][3] += sk_; } }
    { bf16* stg = (bf16*)(shm + U16_OST) + wid * 2048;
#pragma unroll
      for (int hb = 0; hb < 2; ++hb) {
#pragma unroll
          for (int qq = 0; qq < 2; ++qq)
#pragma unroll
              for (int r = 0; r < 4; ++r) { const int qb = 2 * hb + qq; const int ql = 16 * qq + 4 * g + r; const float rl = __builtin_amdgcn_rcpf(MSUM ? ol[qb][r] : wsf[32 * hb + ql]);
#pragma unroll
                  for (int d = 0; d < 4; ++d) stg[ql * 64 + 16 * d + i16] = (bf16)f2bf(o[qb][d][r] * rl); }
          LDS_WAIT();
          bf16* Ow = Op + (size_t)(wrow + 32 * hb) * ldo + hcol;
#pragma unroll
          for (int i = 0; i < 4; ++i) { const int row = i * 8 + (lane >> 3), ch = lane & 7; const u32x4 v = *(const u32x4*)(stg + row * 64 + ch * 8); if (ATT_NT) __builtin_nontemporal_store(v, (u32x4*)(Ow + (size_t)row * ldo + ch * 8)); else *(u32x4*)(Ow + (size_t)row * ldo + ch * 8) = v; }
          LDS_WAIT(); asm volatile("" ::: "memory");
      } }
    __syncthreads();
}

template <int DQK, bool WIN>
__device__ __forceinline__ void attn_unit(const bf16* Qp, int ldq, const bf16* Kn, int ldk, const bf16* Kr, int ldkr, const bf16* Vp, int ldv, bf16* Op, int ldo,
                                          int st0, int st1, float negc, int q0, const float* btab, const float* sinkp, char* shm, unsigned long long& tsync) {
    constexpr int NQ = Lay<DQK>::NQ, KP = Lay<DQK>::KP, KBYTES = Lay<DQK>::KBYTES;
    const int tid = threadIdx.x, lane = tid & 63, r32 = lane & 31, hi = lane >> 5; const int wid = __builtin_amdgcn_readfirstlane(tid >> 6);
    char* K_lds = shm + L_K; char* V_lds = shm + L_V;
    float* wsf = (float*)(shm + L_WS) + wid * 64;
    const int wrow = WIN ? (wid >> 2) * 32 : wid * 32, hcol = WIN ? (wid & 3) * 64 : 0;
    const float* bt = (const float*)(shm + L_BT) + (WIN ? (wid & 3) * 512 : 0);
    if constexpr (WIN) { _Pragma("unroll") for (int k_ = 0; k_ < 4; ++k_) ((float*)(shm + L_BT))[tid + 512 * k_] = btab[tid + 512 * k_]; }
    bf16x8 qr[NQ];
    { const bf16* Qw = Qp + (size_t)(wrow + r32) * ldq + hcol + hi * 8;
#pragma unroll
      for (int d0 = 0; d0 < NQ; ++d0) qr[d0] = *reinterpret_cast<const bf16x8*>(Qw + d0 * 16); }
    const int srow = tid >> 3, sc = tid & 7;
    const bf16* kn_src = Kn + (size_t)srow * ldk + sc * 8;
    const bf16* v_src = Vp + (size_t)srow * ldv + sc * 8;
    const bf16* kr_src = (DQK == 96) ? (Kr + (size_t)(tid >> 2) * ldkr + (tid & 3) * 8) : nullptr;
    const int kn_dst = srow * KP + sc * 16, kr_dst = (tid >> 2) * KP + 128 + (tid & 3) * 16, v_dst = v_st(srow, sc * 8);
    const lds_cptr vb0 = (lds_cptr)(V_lds) + v_rd_base(lane);
    bf16x8 s_kn0, s_kn1, s_kr, s_v0, s_v1;
#define ATT_LOAD(t) do { const size_t k0_ = (size_t)(t) * STG; s_kn0 = *reinterpret_cast<const bf16x8*>(kn_src + k0_ * ldk); s_kn1 = *reinterpret_cast<const bf16x8*>(kn_src + (k0_ + 64) * ldk); \
        s_v0 = *reinterpret_cast<const bf16x8*>(v_src + k0_ * ldv); s_v1 = *reinterpret_cast<const bf16x8*>(v_src + (k0_ + 64) * ldv); \
        if (DQK == 96) { s_kr = *reinterpret_cast<const bf16x8*>(kr_src + k0_ * ldkr); } } while (0)
#define ATT_WRITE(b) do { *reinterpret_cast<bf16x8*>(K_lds + (b) * KBYTES + kn_dst) = s_kn0; *reinterpret_cast<bf16x8*>(K_lds + (b) * KBYTES + 64 * KP + kn_dst) = s_kn1; \
        *reinterpret_cast<bf16x8*>(V_lds + (b) * VBYTES + v_dst) = s_v0; *reinterpret_cast<bf16x8*>(V_lds + (b) * VBYTES + 8192 + v_dst) = s_v1; \
        if (DQK == 96) { *reinterpret_cast<bf16x8*>(K_lds + (b) * KBYTES + kr_dst) = s_kr; } } while (0)
    f32x16 o[2]; o[0] = f32x16{}; o[1] = f32x16{};
    float lsum = 0.f;
    const int qw = q0 + wrow;
    ATT_LOAD(st0); ATT_WRITE(0); __syncthreads();
#if ATT_PRIO
    if (wid >= 4) __builtin_amdgcn_s_setprio(1);
#endif
    for (int t = st0; t < st1; ++t) {
        const int cur = (t - st0) & 1;
        { const int tn_ = (t + 1 < st1) ? t + 1 : t; ATT_LOAD(tn_); }
#pragma unroll
        for (int sub = 0; sub < 2; ++sub) {
            bool active = true;
            if constexpr (WIN) { const int k0 = t * STG + sub * KVB; active = (k0 + 63 >= qw - 128) && (k0 <= qw + 159); }
            if (active) {
                f32x16 p0, p1;
#pragma unroll
                for (int r = 0; r < 16; ++r) { p0[r] = negc; p1[r] = negc; }
                { const char* kb = K_lds + cur * KBYTES + (sub * 64 + r32) * KP + hi * 16;
#pragma unroll
                  for (int d0 = 0; d0 < NQ; ++d0) {
                      const bf16x8 b0 = *reinterpret_cast<const bf16x8*>(kb + d0 * 32);
                      const bf16x8 b1 = *reinterpret_cast<const bf16x8*>(kb + 32 * KP + d0 * 32);
                      p0 = __builtin_amdgcn_mfma_f32_32x32x16_bf16(b0, qr[d0], p0, 0, 0, 0);
                      p1 = __builtin_amdgcn_mfma_f32_32x32x16_bf16(b1, qr[d0], p1, 0, 0, 0); } }
                if constexpr (WIN) {
                    const int base = t * STG + sub * KVB - (qw + r32) + 256 + 4 * hi;
#pragma unroll
                    for (int r = 0; r < 16; ++r) { const int ix = base + (r & 3) + 8 * (r >> 2); p0[r] += bt[ix]; p1[r] += bt[ix + 32]; }
                }
#pragma unroll
                for (int r = 0; r < 16; ++r) { p0[r] = __builtin_amdgcn_exp2f(p0[r]); p1[r] = __builtin_amdgcn_exp2f(p1[r]); }
                { float ps = 0.f;
#pragma unroll
                  for (int r = 0; r < 16; ++r) ps += p0[r] + p1[r];
                  lsum += ps; }
                bf16x8 pa[4];
                { u32x4 w;
                  w.x = pk2(p0[0], p0[1]); w.y = pk2(p0[2], p0[3]); w.z = pk2(p0[4], p0[5]); w.w = pk2(p0[6], p0[7]); pa[0] = *reinterpret_cast<bf16x8*>(&w);
                  w.x = pk2(p0[8], p0[9]); w.y = pk2(p0[10], p0[11]); w.z = pk2(p0[12], p0[13]); w.w = pk2(p0[14], p0[15]); pa[1] = *reinterpret_cast<bf16x8*>(&w);
                  w.x = pk2(p1[0], p1[1]); w.y = pk2(p1[2], p1[3]); w.z = pk2(p1[4], p1[5]); w.w = pk2(p1[6], p1[7]); pa[2] = *reinterpret_cast<bf16x8*>(&w);
                  w.x = pk2(p1[8], p1[9]); w.y = pk2(p1[10], p1[11]); w.z = pk2(p1[12], p1[13]); w.w = pk2(p1[14], p1[15]); pa[3] = *reinterpret_cast<bf16x8*>(&w); }
                pv_sub(o, vb0 + cur * VBYTES + sub * 8192, pa);
            }
        }
        if constexpr (!WIN && ATT_SG_ON) {
#pragma unroll
            for (int i_ = 0; i_ < 4 * NQ + 16; ++i_) { __builtin_amdgcn_sched_group_barrier(0x008, 1, 0); __builtin_amdgcn_sched_group_barrier(0x400, ATT_SG_TRANS, 0);
                __builtin_amdgcn_sched_group_barrier(0x002, ATT_SG_VALU, 0); __builtin_amdgcn_sched_group_barrier(0x100, ATT_SG_DSR, 0); }
        }
#if ATT_PROBE
        const unsigned long long tp0_ = __builtin_amdgcn_s_memtime();
#endif
        ATT_WRITE(cur ^ 1);
        __syncthreads();
#if ATT_PROBE
        tsync += __builtin_amdgcn_s_memtime() - tp0_;
#endif
    }
#if ATT_PRIO
    __builtin_amdgcn_s_setprio(0);
#endif
#undef ATT_LOAD
#undef ATT_WRITE
    { auto rr = __builtin_amdgcn_permlane32_swap(__float_as_uint(lsum), __float_as_uint(lsum), false, false); lsum = __uint_as_float(rr[0]) + __uint_as_float(rr[1]); }
    if constexpr (WIN) lsum += __builtin_amdgcn_exp2f(sinkp[wid & 3] + negc);
    if (hi == 0) wsf[r32] = lsum;
    LDS_WAIT();
    float rli[16];
#pragma unroll
    for (int r = 0; r < 16; ++r) rli[r] = __builtin_amdgcn_rcpf(wsf[crow(r, hi)]);
    { bf16* stg = (bf16*)(shm + L_OST) + wid * 2048;
#pragma unroll
      for (int r = 0; r < 16; ++r) { const int orow = crow(r, hi);
#pragma unroll
          for (int d0 = 0; d0 < 2; ++d0) stg[orow * 64 + d0 * 32 + r32] = (bf16)f2bf(o[d0][r] * rli[r]); }
      LDS_WAIT();
      bf16* Ow = Op + (size_t)wrow * ldo + hcol;
#pragma unroll
      for (int i = 0; i < 4; ++i) { const int row = i * 8 + (lane >> 3), ch = lane & 7; const u32x4 v = *(const u32x4*)(stg + row * 64 + ch * 8); *(u32x4*)(Ow + (size_t)row * ldo + ch * 8) = v; } }
    __syncthreads();
}
#undef ATT_PKV
}
struct WaveId { int gw, ngw, lane, wave; };

#ifndef TR_NT
#define TR_NT 1
#endif
struct TrItem { const float* src; bf16* dst; const float* gain; int ldw, ldt; };
template <int MAP>
__device__ __forceinline__ TrItem tr_seg(int it, const float* W, int ldw, int N, bf16* WT, int ldt, int roff, int dk0, const float* gain = nullptr) {
    const int nblk = N / 32, kb = it / nblk, nb = it % nblk, n0 = 32 * nb;
    int drow0;
    if (MAP == 0) drow0 = roff + n0;
    else if (MAP == 1) {
        if (n0 < 384) drow0 = n0;
        else if (n0 < 416) drow0 = PC_KROPE + (n0 - 384);
        else drow0 = n0 - 416 + PC_BQ;
    } else if (MAP == 5) { const int hh = n0 / 128, d0 = n0 % 128; drow0 = roff + (d0 < 64 ? 64 * hh + d0 : 512 + 64 * hh + (d0 - 64)); }
    else if (MAP == 4) { const int hh = n0 / 96, d0 = n0 % 96; drow0 = d0 < 64 ? 64 * hh + d0 : 512 + 32 * hh; }
    else { drow0 = (n0 >> 7) * 256 + (n0 & 127) + (MAP == 3 ? 128 : 0); }
    TrItem t; t.src = W + (size_t)(64 * kb) * ldw + n0; t.dst = WT + (size_t)drow0 * ldt + dk0 + 64 * kb; t.ldw = ldw; t.ldt = ldt; t.gain = gain ? gain + 64 * kb : nullptr; return t;
}
__device__ __forceinline__ void tr_load(const TrItem& t, float (&v)[32], int lane) {
    const float* p = t.src + (size_t)(lane >> 5) * t.ldw + (lane & 31);
#pragma unroll
    for (int i = 0; i < 32; ++i) v[i] = TR_NT ? __builtin_nontemporal_load(p + (size_t)(2 * i) * t.ldw) : p[(size_t)(2 * i) * t.ldw];
}
template <bool GAIN = false>
__device__ __forceinline__ void tr_store(const TrItem& t, const float (&v)[32], LAS float* scr, int lane) {
#pragma unroll
    for (int i = 0; i < 32; ++i) scr[(2 * i + (lane >> 5)) * 33 + (lane & 31)] = v[i];
    LDS_WAIT(); asm volatile("" ::: "memory");
    const int c = lane & 7;
    f32x4 ga = {1.f, 1.f, 1.f, 1.f}, gb = ga;
    if constexpr (GAIN) { ga = *(const f32x4*)(t.gain + 8 * c); gb = *(const f32x4*)(t.gain + 8 * c + 4); }
#pragma unroll
    for (int j = 0; j < 4; ++j) { const int n = (lane >> 3) + 8 * j; const LAS float* s = scr + (8 * c) * 33 + n;
        u32x4 o; o.x = pk2(s[0 * 33] * ga[0], s[1 * 33] * ga[1]); o.y = pk2(s[2 * 33] * ga[2], s[3 * 33] * ga[3]); o.z = pk2(s[4 * 33] * gb[0], s[5 * 33] * gb[1]); o.w = pk2(s[6 * 33] * gb[2], s[7 * 33] * gb[3]);
        if (TR_NT) __builtin_nontemporal_store(o, (u32x4*)(t.dst + (size_t)n * t.ldt + 8 * c)); else *(u32x4*)(t.dst + (size_t)n * t.ldt + 8 * c) = o; }
    LDS_WAIT(); asm volatile("" ::: "memory");
}
__device__ __forceinline__ int ilog2u(unsigned v) { return 31 - __builtin_clz(v); }
__device__ __forceinline__ int t5_bucket_dev(int rel) {
    const int n = rel < 0 ? -rel : rel; int b = rel > 0 ? 16 : 0;
    if (n < 8) return b + n;
    int large = 2 + ilog2u((unsigned)(n * n)); if (large > 15) large = 15;
    return b + large;
}
__device__ __forceinline__ float gain_absmax(const float* g, int n, int lane) { float m = 0.f; for (int i = lane; i < n; i += 64) m = fmaxf(m, fabsf(g[i])); return wave_max(m); }


__device__ __forceinline__ void unpack8(const u32x4 v, float (&x)[8]) {
    x[0] = bf2f(v.x & 0xffffu); x[1] = bf2f(v.x >> 16); x[2] = bf2f(v.y & 0xffffu); x[3] = bf2f(v.y >> 16);
    x[4] = bf2f(v.z & 0xffffu); x[5] = bf2f(v.z >> 16); x[6] = bf2f(v.w & 0xffffu); x[7] = bf2f(v.w >> 16);
}
__device__ __forceinline__ u32x4 pack8(const float (&v)[8]) { u32x4 w; w.x = pk2(v[0], v[1]); w.y = pk2(v[2], v[3]); w.z = pk2(v[4], v[5]); w.w = pk2(v[6], v[7]); return w; }
template <bool ROPE>
__device__ __forceinline__ u32x4 norm_chunk(const u32x4 raw, const float (&g)[8], int nred, float invn, float scale, bool rope, bool lo, const f32x4 (&t)[4]) {
    float x[8]; unpack8(raw, x);
    float ss = 0.f;
#pragma unroll
    for (int e = 0; e < 8; ++e) ss += x[e] * x[e];
    ss += __shfl_xor(ss, 1); ss += __shfl_xor(ss, 2);
    { const float t4 = __shfl_xor(ss, 4); ss += (nred >= 3) ? t4 : 0.f; }
    { const float t8 = __shfl_xor(ss, 8); ss += (nred >= 4) ? t8 : 0.f; }
    { const float t16 = __shfl_xor(ss, 16); ss += (nred >= 5) ? t16 : 0.f; }
    const float rstd = 1.0f / sqrtf(ss * invn + EPS);
    float o[8];
#pragma unroll
    for (int e = 0; e < 8; ++e) { const float y = x[e] * rstd * g[e];
        if (ROPE) { const float yp = __shfl_xor(y, 2); const float c = t[e >> 1][(e & 1) * 2], s = t[e >> 1][(e & 1) * 2 + 1];
            const float r = lo ? (y * c - yp * s) : (y * c + yp * s); o[e] = (rope ? r : y) * scale; }
        else o[e] = y * scale; }
    return pack8(o);
}
__device__ __forceinline__ void load8f(const float* p, float (&g)[8]) { const f32x4 a = *(const f32x4*)p, b = *(const f32x4*)(p + 4); g[0] = a.x; g[1] = a.y; g[2] = a.z; g[3] = a.w; g[4] = b.x; g[5] = b.y; g[6] = b.z; g[7] = b.w; }

__device__ __forceinline__ void ph_rmsnorm(const float* X, const float* g, bf16* H, const WaveId& w) {
    f32x4 gv[4];
#pragma unroll
    for (int j = 0; j < 4; ++j) gv[j] = ((const f32x4*)g)[w.lane + 64 * j];
    int m = w.gw; if (m >= NT) return;
    f32x4 v[4];
#pragma unroll
    for (int j = 0; j < 4; ++j) v[j] = ((const f32x4*)(X + (size_t)m * DM) + w.lane)[64 * j];
    for (; m < NT; m += w.ngw) {
        const int mn = (m + w.ngw < NT) ? m + w.ngw : m; f32x4 nv[4];
#pragma unroll
        for (int j = 0; j < 4; ++j) nv[j] = ((const f32x4*)(X + (size_t)mn * DM) + w.lane)[64 * j];
        float ss = 0.f;
#pragma unroll
        for (int j = 0; j < 4; ++j) ss += (v[j].x * v[j].x + v[j].y * v[j].y) + (v[j].z * v[j].z + v[j].w * v[j].w);
        const float rstd = 1.0f / sqrtf(wave_sum(ss) * (1.0f / DM) + EPS);
        u32x2* o = (u32x2*)(H + (size_t)m * DM) + w.lane;
#pragma unroll
        for (int j = 0; j < 4; ++j) { u32x2 q; q.x = pk2(v[j].x * rstd * gv[j].x, v[j].y * rstd * gv[j].y); q.y = pk2(v[j].z * rstd * gv[j].z, v[j].w * rstd * gv[j].w); o[64 * j] = q; }
#pragma unroll
        for (int j = 0; j < 4; ++j) v[j] = nv[j];
    }
}

__device__ __forceinline__ void ph_prep1(const bf16* PROJ, bf16* OUT, const float* qa_g, const float* kva_g, const float* gq_g, const float* gk_g, const float* kr_g, const float* tabcs  , const WaveId& w) {
    const int lane = w.lane; const float sB = 0.125f * LOG2E;
    float g0[8], g1[8], g2[8];
    load8f(lane < 32 ? qa_g + 8 * lane : (lane < 48 ? kva_g + 8 * (lane - 32) : gq_g + 8 * (lane & 7)), g0);
    load8f(lane < 48 ? gq_g + 8 * (lane & 7) : gk_g + 8 * (lane & 7), g1);
    load8f(kr_g + 8 * (lane & 3), g2);
    const int nred0 = lane < 32 ? 5 : (lane < 48 ? 4 : 3); const float invn0 = lane < 32 ? (1.0f / 256) : (lane < 48 ? (1.0f / 128) : (1.0f / 64));
    const float sc0 = lane >= 48 ? sB : 1.0f, sc1 = lane < 48 ? sB : 1.0f;
    const bool rope0 = lane >= 48, lo = !(lane & 2), k2 = (lane >= 16 && lane < 20);
    const int fi = (lane & 1) * 8, blk = (lane >> 2) & 1;
#define P1_LOAD(R, mm) do { const bf16* row_ = PROJ + (size_t)(mm) * PROJ_LD; const int s_ = (mm) & (SEQ - 1); const int pax_ = blk ? (s_ & 63) : (s_ >> 6); \
        R##c0 = *(const u32x4*)(row_ + 8 * lane); R##c1 = *(const u32x4*)(row_ + 8 * (64 + lane)); R##c2 = *(const u32x4*)(row_ + 8 * (128 + (lane & 31))); \
        const f32x4* ta_ = (const f32x4*)(tabcs + ((size_t)(k2 ? s_ : pax_) * 16 + fi) * 2); const f32x4* tb_ = (const f32x4*)(tabcs + ((size_t)pax_ * 16 + fi) * 2); \
        _Pragma("unroll") for (int k_ = 0; k_ < 4; ++k_) { R##ta[k_] = ta_[k_]; R##tb[k_] = tb_[k_]; } } while (0)
    int m = w.gw; if (m >= NT) return;
    u32x4 Cc0, Cc1, Cc2; f32x4 Cta[4], Ctb[4];
    P1_LOAD(C, m);
    for (; m < NT; m += w.ngw) {
        const int mn = (m + w.ngw < NT) ? m + w.ngw : m;
        u32x4 Nc0, Nc1, Nc2; f32x4 Nta[4], Ntb[4];
        P1_LOAD(N, mn);
        bf16* row = OUT + (size_t)m * PROJ_LD;
        const u32x4 o0 = norm_chunk<true>(Cc0, g0, nred0, invn0, sc0, rope0, lo, Cta);
        const u32x4 o1 = norm_chunk<true>(Cc1, g1, 3, 1.0f / 64, sc1, true, lo, Ctb);
        const u32x4 o2 = norm_chunk<true>(Cc2, g2, 2, 1.0f / 32, 1.0f, true, lo, Cta);
        *(u32x4*)(row + 8 * lane) = o0; *(u32x4*)(row + 8 * (64 + lane)) = o1;
        if (k2) *(u32x4*)(row + 8 * (128 + lane)) = o2;
        Cc0 = Nc0; Cc1 = Nc1; Cc2 = Nc2;
#pragma unroll
        for (int k = 0; k < 4; ++k) { Cta[k] = Nta[k]; Ctb[k] = Ntb[k]; }
    }
#undef P1_LOAD
}
__device__ __forceinline__ void ph_kside(bf16* PROJ, const float* gk_g, const float* kr_g, const float* tabcs, const WaveId& w) {
    const int lane = w.lane, l = lane & 31, hf = lane >> 5;
    const bool isk = l < 16, act = l < 20;
    float g[8]; load8f(isk ? gk_g + 8 * (l & 7) : kr_g + 8 * (l & 3), g);
    const int col = isk ? PC_BK + 8 * l : PC_KROPE + 8 * (l & 3);
    const int nred = isk ? 3 : 2; const float invn = isk ? (1.0f / 64) : (1.0f / 32);
    const bool lo = !(l & 2); const int fi = (l & 1) * 8, blk = (l >> 2) & 1;
    const int step = 2 * w.ngw;
    for (int m0 = 2 * w.gw + hf; m0 < NT; m0 += 4 * step) {
        u32x4 c[4]; f32x4 t[4][4];
#pragma unroll
        for (int j = 0; j < 4; ++j) { const int m = (m0 + j * step < NT) ? m0 + j * step : m0; const int s_ = m & (SEQ - 1); const int pos = isk ? (blk ? (s_ & 63) : (s_ >> 6)) : s_;
            c[j] = *(const u32x4*)(PROJ + (size_t)m * PROJ_LD + col);
            const f32x4* tp = (const f32x4*)(tabcs + ((size_t)pos * 16 + fi) * 2);
#pragma unroll
            for (int k = 0; k < 4; ++k) t[j][k] = tp[k]; }
#pragma unroll
        for (int j = 0; j < 4; ++j) { const int m = m0 + j * step;
            const u32x4 o = norm_chunk<true>(c[j], g, nred, invn, 1.0f, true, lo, t[j]);
            if (act && m < NT) *(u32x4*)(PROJ + (size_t)m * PROJ_LD + col) = o; }
    }
}
__device__ __forceinline__ void ph_prep2(const bf16* UPO, bf16* OUT, const float* qn_g, const float* qr_g, const float* kn_g, const float* tabcs, const WaveId& w) {
    const int lane = w.lane; const float sA = 0.10206207261596577f * LOG2E;
    float ga[8], gb[8], gc[8];
    load8f(qn_g + 8 * (lane & 7), ga); load8f(qr_g + 8 * (lane & 3), gb); load8f(kn_g + 8 * (lane & 7), gc);
    const bool lo = !(lane & 2); const int fi = (lane & 1) * 8;
    const int ca = 12 * (lane >> 3) + (lane & 7), cb = 12 * ((lane >> 2) & 7) + 8 + (lane & 3), cc = 96 + 16 * (lane >> 3) + (lane & 7);
#define P2_LOAD(R, mm) do { const bf16* row_ = UPO + (size_t)(mm) * UP_LD; const int s_ = (mm) & (SEQ - 1); \
        R##c0 = *(const u32x4*)(row_ + 8 * ca); R##c1 = *(const u32x4*)(row_ + 8 * cb); R##c2 = *(const u32x4*)(row_ + 8 * cc); \
        const f32x4* ta_ = (const f32x4*)(tabcs + ((size_t)s_ * 16 + fi) * 2); \
        _Pragma("unroll") for (int k_ = 0; k_ < 4; ++k_) R##ta[k_] = ta_[k_]; } while (0)
    int m = w.gw; if (m >= NT) return;
    u32x4 Cc0, Cc1, Cc2; f32x4 Cta[4];
    P2_LOAD(C, m);
    for (; m < NT; m += w.ngw) {
        const int mn = (m + w.ngw < NT) ? m + w.ngw : m;
        u32x4 Nc0, Nc1, Nc2; f32x4 Nta[4];
        P2_LOAD(N, mn);
        bf16* row = OUT + (size_t)m * UP_LD;
        const u32x4 o0 = norm_chunk<false>(Cc0, ga, 3, 1.0f / 64, sA, false, lo, Cta);
        const u32x4 o1 = norm_chunk<true>(Cc1, gb, 2, 1.0f / 32, sA, true, lo, Cta);
        const u32x4 o2 = norm_chunk<false>(Cc2, gc, 3, 1.0f / 64, 1.0f, false, lo, Cta);
        *(u32x4*)(row + 8 * ca) = o0; if (lane < 32) *(u32x4*)(row + 8 * cb) = o1; *(u32x4*)(row + 8 * cc) = o2;
        Cc0 = Nc0; Cc1 = Nc1; Cc2 = Nc2;
#pragma unroll
        for (int k = 0; k < 4; ++k) Cta[k] = Nta[k];
    }
#undef P2_LOAD
}
__device__ __forceinline__ void ph_prepc(const bf16* PC, bf16* OUT, const float* q_g, const float* k_g, const WaveId& w) {
    const int lane = w.lane; const float sC = 0.125f * LOG2E;
    float gq[8], gk[8]; load8f(q_g + 8 * (lane & 7), gq); load8f(k_g + 8 * (lane & 7), gk);
    const f32x4 dummy[4] = {};
#define PC_LOAD(R, mm) do { const bf16* row_ = PC + (size_t)(mm) * PC_LD; \
        R##c0 = *(const u32x4*)(row_ + 8 * lane); R##c1 = *(const u32x4*)(row_ + 8 * (64 + lane)); R##c2 = *(const u32x4*)(row_ + 8 * (128 + (lane & 31))); } while (0)
    int m = w.gw; if (m >= NT) return;
    u32x4 Cc0, Cc1, Cc2;
    PC_LOAD(C, m);
    for (; m < NT; m += w.ngw) {
        const int mn = (m + w.ngw < NT) ? m + w.ngw : m;
        u32x4 Nc0, Nc1, Nc2;
        PC_LOAD(N, mn);
        bf16* row = OUT + (size_t)m * PC_LD;
        const u32x4 o0 = norm_chunk<false>(Cc0, gq, 3, 1.0f / 64, sC, false, false, dummy);
        const u32x4 o1 = norm_chunk<false>(Cc1, gq, 3, 1.0f / 64, sC, false, false, dummy);
        const u32x4 o2 = norm_chunk<false>(Cc2, gk, 3, 1.0f / 64, 1.0f, false, false, dummy);
        *(u32x4*)(row + 8 * lane) = o0; *(u32x4*)(row + 8 * (64 + lane)) = o1; if (lane < 32) *(u32x4*)(row + 8 * (128 + lane)) = o2;
        Cc0 = Nc0; Cc1 = Nc1; Cc2 = Nc2;
    }
#undef PC_LOAD
}

__device__ __forceinline__ void build_rtab(const float* g, const float* w_group, const float* w_router, bf16* tab, int idx  ) {
    const int lane = idx & 63, ct = (idx >> 6) & 1, kk = idx >> 7, c = lane & 15, k0 = 32 * kk + 8 * (lane >> 4);
    float hi[8], lo[8];
#pragma unroll
    for (int j = 0; j < 8; ++j) { const int k = k0 + j; const float wv = (ct == 0) ? w_router[k * 16 + c] : (c < 4 ? w_group[k * 4 + c] : 0.f); const float x = wv * g[k];
        const float h = bf2f(f2bf(x)); hi[j] = h; lo[j] = x - h; }
    *(u32x4*)(tab + ((size_t)((kk * 2 + ct) * 2 + 0) * 64 + lane) * 8) = pack8(hi);
    *(u32x4*)(tab + ((size_t)((kk * 2 + ct) * 2 + 1) * 64 + lane) * 8) = pack8(lo);
}
__device__ __forceinline__ void ph_router(const bf16* XR, float* rsv, const LAS unsigned char* rtab, LAS float* scr  ,
                                          const float* b_group, const float* b_router, int* eidx, float* wts, int* rank, int* list, unsigned* cnt,
                                          LAS int* tinfo  , const WaveId& w) {
    const int lane = w.lane, tok = lane & 15, ks = lane >> 4;
    float bg[4];
#pragma unroll
    for (int i = 0; i < 4; ++i) bg[i] = b_group[i];
    int it = 0;
    for (int gi = w.gw; gi < NT / 16; gi += w.ngw, ++it) {
        const int m0 = gi * 16;
        const bf16* arow = XR + (size_t)(m0 + tok) * DM + ks * 8;
        f32x4 acc0 = {0.f, 0.f, 0.f, 0.f}, acc1 = {0.f, 0.f, 0.f, 0.f}, gram = {0.f, 0.f, 0.f, 0.f};
        bf16x8 a[8];
#pragma unroll
        for (int i = 0; i < 8; ++i) a[i] = *(const bf16x8*)(arow + 32 * i);
#pragma unroll
        for (int bt = 0; bt < 4; ++bt) {
            bf16x8 na[8];
            if (bt < 3) {
#pragma unroll
                for (int i = 0; i < 8; ++i) na[i] = *(const bf16x8*)(arow + 32 * (8 * (bt + 1) + i));
            }
#pragma unroll
            for (int i = 0; i < 8; ++i) { const int kk = 8 * bt + i; const LAS unsigned char* tb = rtab + (size_t)kk * 4096 + lane * 16;
                const bf16x8 b0h = *(const LAS bf16x8*)(tb), b0l = *(const LAS bf16x8*)(tb + 1024), b1h = *(const LAS bf16x8*)(tb + 2048), b1l = *(const LAS bf16x8*)(tb + 3072);
                acc0 = __builtin_amdgcn_mfma_f32_16x16x32_bf16(a[i], b0h, acc0, 0, 0, 0); acc0 = __builtin_amdgcn_mfma_f32_16x16x32_bf16(a[i], b0l, acc0, 0, 0, 0);
                acc1 = __builtin_amdgcn_mfma_f32_16x16x32_bf16(a[i], b1h, acc1, 0, 0, 0); acc1 = __builtin_amdgcn_mfma_f32_16x16x32_bf16(a[i], b1l, acc1, 0, 0, 0);
                gram = __builtin_amdgcn_mfma_f32_16x16x32_bf16(a[i], a[i], gram, 0, 0, 0); }
            if (bt < 3) {
#pragma unroll
                for (int i = 0; i < 8; ++i) a[i] = na[i];
            }
        }
#pragma unroll
        for (int r = 0; r < 4; ++r) { scr[(4 * ks + r) * 36 + tok] = acc0[r]; scr[(4 * ks + r) * 36 + 16 + tok] = acc1[r]; }
        if ((tok >> 2) == ks) { const int r = tok & 3; const float d = r == 0 ? gram[0] : (r == 1 ? gram[1] : (r == 2 ? gram[2] : gram[3])); scr[tok * 36 + 32] = d; }
        LDS_WAIT(); asm volatile("" ::: "memory");
        const LAS float* my = scr + tok * 36;
        const float rstd = 1.0f / sqrtf(my[32] * (1.0f / DM) + EPS);
        const float g0 = my[16] * rstd + bg[0], g1 = my[17] * rstd + bg[1], g2 = my[18] * rstd + bg[2], g3 = my[19] * rstd + bg[3];
        int gsel = 0; float gm = g0; if (g1 > gm) { gm = g1; gsel = 1; } if (g2 > gm) { gm = g2; gsel = 2; } if (g3 > gm) { gm = g3; gsel = 3; }
        const float gp = 1.0f / (expf(g0 - gm) + expf(g1 - gm) + expf(g2 - gm) + expf(g3 - gm));
        const LAS float* ml = my + 4 * gsel;
        float e0 = ml[0] * rstd, e1 = ml[1] * rstd, e2 = ml[2] * rstd, e3 = ml[3] * rstd;
        { const f32x4 bv = *(const f32x4*)(b_router + 4 * gsel); e0 += bv.x; e1 += bv.y; e2 += bv.z; e3 += bv.w; }
        int i1 = 0; float m1 = e0; if (e1 > m1) { m1 = e1; i1 = 1; } if (e2 > m1) { m1 = e2; i1 = 2; } if (e3 > m1) { m1 = e3; i1 = 3; }
        int i2 = -1; float m2 = -3.0e38f;
        if (i1 != 0 && e0 > m2) { m2 = e0; i2 = 0; } if (i1 != 1 && e1 > m2) { m2 = e1; i2 = 1; } if (i1 != 2 && e2 > m2) { m2 = e2; i2 = 2; } if (i1 != 3 && e3 > m2) { m2 = e3; i2 = 3; }
        const float t2 = expf(m2 - m1); const float w1 = gp / (1.0f + t2), w2 = gp * t2 / (1.0f + t2);
        if (lane < 16) {
            const int m = m0 + lane, ea = gsel * 4 + i1, eb = gsel * 4 + i2;
            const int la = __hip_atomic_fetch_add(tinfo + ea, 1, __ATOMIC_RELAXED, __HIP_MEMORY_SCOPE_WORKGROUP);
            const int lb = __hip_atomic_fetch_add(tinfo + eb, 1, __ATOMIC_RELAXED, __HIP_MEMORY_SCOPE_WORKGROUP);
            eidx[2 * m] = ea; eidx[2 * m + 1] = eb; wts[2 * m] = w1; wts[2 * m + 1] = w2;
            LAS int* ti = tinfo + 32 + 4 * ((it * 8 + w.wave) * 16 + lane); ti[0] = m; ti[1] = ea | (eb << 8); ti[2] = la; ti[3] = lb;
            rsv[m] = rstd;
        }
        LDS_WAIT(); asm volatile("" ::: "memory");
        LDS_WAIT(); asm volatile("" ::: "memory");
    }
    __syncthreads();
    if (threadIdx.x < 16) tinfo[16 + threadIdx.x] = (int)__hip_atomic_fetch_add(cnt + 64 * threadIdx.x, (unsigned)tinfo[threadIdx.x], __ATOMIC_RELAXED, __HIP_MEMORY_SCOPE_AGENT);
    __syncthreads();
    { const int niter = (NT / 16 - (int)blockIdx.x * 8 + w.ngw - 1) / w.ngw;
      for (int k = threadIdx.x; k < niter * 128; k += 512) { const LAS int* ti = tinfo + 32 + 4 * k; const int mm = ti[0];
          if (mm >= 0) { const int ea = ti[1] & 255, eb = ti[1] >> 8; const int ra = tinfo[16 + ea] + ti[2], rb = tinfo[16 + eb] + ti[3];
              rank[2 * mm] = ra; rank[2 * mm + 1] = rb; list[(size_t)ea * NT + ra] = mm; list[(size_t)eb * NT + rb] = mm; } } }
}
__device__ __forceinline__ int moe_offsets(const unsigned* cnt, int (&off)[17]) {
    int a = 0;
#pragma unroll
    for (int e = 0; e < 16; ++e) { off[e] = a; a += ((int)cnt[64 * e] + 255) & ~255; }
    off[16] = a; return a >> 8;
}
template <bool FINAL>
__device__ __forceinline__ void ph_combine(bf16* XR, float* OUT, const bf16* Y, const int* eidx, const int* rank, const float* wts, const unsigned* cnt, float* RS, const WaveId& w) {
    const int lane = w.lane;
    int off[17]; moe_offsets(cnt, off);
#define CB_IDX(I, mm) do { I##e0 = eidx[2 * (mm)]; I##e1 = eidx[2 * (mm) + 1]; I##r0 = rank[2 * (mm)]; I##r1 = rank[2 * (mm) + 1]; I##w0 = wts[2 * (mm)]; I##w1 = wts[2 * (mm) + 1]; } while (0)
#define CB_ROWS(R, mm, I) do { int b0_ = 0, b1_ = 0; \
        _Pragma("unroll") for (int q_ = 0; q_ < 16; ++q_) { b0_ = (q_ == I##e0) ? off[q_] : b0_; b1_ = (q_ == I##e1) ? off[q_] : b1_; } \
        const int s0_ = b0_ + I##r0, s1_ = b1_ + I##r1; R##w0 = I##w0; R##w1 = I##w1; \
        const u32x4* xr_ = (const u32x4*)(XR + (size_t)(mm) * DM) + lane; const u32x4* y0_ = (const u32x4*)(Y + (size_t)s0_ * DM) + lane; const u32x4* y1_ = (const u32x4*)(Y + (size_t)s1_ * DM) + lane; \
        _Pragma("unroll") for (int j_ = 0; j_ < 2; ++j_) { R##x[j_] = xr_[64 * j_]; R##a[j_] = y0_[64 * j_]; R##b[j_] = y1_[64 * j_]; } } while (0)
    int m = w.gw; if (m >= NT) return;
    u32x4 Cx[2], Ca[2], Cb[2]; float Cw0, Cw1;
    int Pe0, Pe1, Pr0, Pr1; float Pw0, Pw1;
    { int Fe0, Fe1, Fr0, Fr1; float Fw0, Fw1; CB_IDX(F, m); const int m1_ = (m + w.ngw < NT) ? m + w.ngw : m; CB_IDX(P, m1_); CB_ROWS(C, m, F); }
    for (; m < NT; m += w.ngw) {
        const int mn = (m + w.ngw < NT) ? m + w.ngw : m, mnn = (m + 2 * w.ngw < NT) ? m + 2 * w.ngw : mn;
        u32x4 Nx[2], Na[2], Nb[2]; float Nw0, Nw1;
        CB_ROWS(N, mn, P);
        int Qe0, Qe1, Qr0, Qr1; float Qw0, Qw1; CB_IDX(Q, mnn);
        float v[2][8]; float ss = 0.f;
#pragma unroll
        for (int j = 0; j < 2; ++j) { float x[8], a[8], b[8]; unpack8(Cx[j], x); unpack8(Ca[j], a); unpack8(Cb[j], b);
#pragma unroll
            for (int e = 0; e < 8; ++e) { v[j][e] = x[e] + Cw0 * a[e] + Cw1 * b[e]; ss += v[j][e] * v[j][e]; } }
        if (FINAL) {
#pragma unroll
            for (int j = 0; j < 2; ++j) { f32x4* o = (f32x4*)(OUT + (size_t)m * DM + 8 * (lane + 64 * j)); o[0] = (f32x4){v[j][0], v[j][1], v[j][2], v[j][3]}; o[1] = (f32x4){v[j][4], v[j][5], v[j][6], v[j][7]}; }
        } else {
            const float rstd = 1.0f / sqrtf(wave_sum(ss) * (1.0f / DM) + EPS);
#pragma unroll
            for (int j = 0; j < 2; ++j) *((u32x4*)(XR + (size_t)m * DM) + lane + 64 * j) = pack8(v[j]);
            if (lane == 0) RS[m] = rstd;
        }
#pragma unroll
        for (int j = 0; j < 2; ++j) { Cx[j] = Nx[j]; Ca[j] = Na[j]; Cb[j] = Nb[j]; }
        Cw0 = Nw0; Cw1 = Nw1;
        Pe0 = Qe0; Pe1 = Qe1; Pr0 = Qr0; Pr1 = Qr1; Pw0 = Qw0; Pw1 = Qw1;
    }
#undef CB_IDX
#undef CB_ROWS
}

template <int DQK, bool WIN>
__device__ __forceinline__ void naive_attn_row(const bf16* qrow, const bf16* Kn, int ldk, const bf16* Kr, int ldkr, const bf16* Vp, int ldv, bf16* orow,
                                               int qpos, const float* btab, float sinkl2, LAS float* qf  , int lane) {
    for (int d = lane; d < DQK; d += 64) qf[d] = bf2f(qrow[d]);
    LDS_WAIT(); asm volatile("" ::: "memory");
    float m = -1.0e30f, l = 0.f, o = 0.f;
    const int kbeg = WIN ? qpos - 128 : 0, nch = WIN ? 5 : SEQ / 64;
    for (int ci = 0; ci < nch; ++ci) {
        const int key = kbeg + ci * 64 + lane; const bool valid = !WIN || (key >= 0 && key < SEQ && key - qpos <= 128);
        const int kc = valid ? key : 0;
        float s = 0.f;
        { const bf16* kp = Kn + (size_t)kc * ldk;
#pragma unroll
          for (int c = 0; c < 8; ++c) { const u32x4 kv = *(const u32x4*)(kp + c * 8); const LAS float* q = qf + c * 8;
              s += q[0] * bf2f(kv.x & 0xffffu) + q[1] * bf2f(kv.x >> 16) + q[2] * bf2f(kv.y & 0xffffu) + q[3] * bf2f(kv.y >> 16) + q[4] * bf2f(kv.z & 0xffffu) + q[5] * bf2f(kv.z >> 16) + q[6] * bf2f(kv.w & 0xffffu) + q[7] * bf2f(kv.w >> 16); }
          if (DQK == 96) { const bf16* rp = Kr + (size_t)kc * ldkr;
#pragma unroll
              for (int c = 0; c < 4; ++c) { const u32x4 kv = *(const u32x4*)(rp + c * 8); const LAS float* q = qf + 64 + c * 8;
                  s += q[0] * bf2f(kv.x & 0xffffu) + q[1] * bf2f(kv.x >> 16) + q[2] * bf2f(kv.y & 0xffffu) + q[3] * bf2f(kv.y >> 16) + q[4] * bf2f(kv.z & 0xffffu) + q[5] * bf2f(kv.z >> 16) + q[6] * bf2f(kv.w & 0xffffu) + q[7] * bf2f(kv.w >> 16); } } }
        if (WIN) s = valid ? s + btab[key - qpos + 256] : -INFINITY;
        const float mn = fmaxf(m, wave_max(s)); const float p = exp2f(s - mn), al = exp2f(m - mn);
        l = l * al + wave_sum(p); o *= al; m = mn;
        const int kb = kbeg + ci * 64;
        for (int j = 0; j < 64; ++j) { const float pj = __shfl(p, j); int kk = kb + j; if (WIN) kk = (kk < 0 || kk >= SEQ) ? 0 : kk; o += pj * bf2f(Vp[(size_t)kk * ldv + lane]); }
    }
    if (WIN) { const float mn = fmaxf(m, sinkl2); const float al = exp2f(m - mn); l = l * al + exp2f(sinkl2 - mn); o *= al; }
    orow[lane] = (bf16)f2bf(o / l);
    LDS_WAIT(); asm volatile("" ::: "memory");
}
constexpr int NPHASE = 19;
#ifndef CV_BATCH
#define CV_BATCH 1
#endif
#ifndef CV_DEPHASE
#define CV_DEPHASE 1
#endif
#ifndef CV_REP
#define CV_REP 1
#endif
#ifndef UP_KV_K128
#define UP_KV_K128 1
#endif
#ifndef MK_FUSE_PREP1
#define MK_FUSE_PREP1 1
#endif
#ifndef MK_FUSE_PREP2
#define MK_FUSE_PREP2 1
#endif
#ifndef MK_FUSE_PREPC
#define MK_FUSE_PREPC 1
#endif
#ifndef ATT_WIDE_C
#define ATT_WIDE_C 1
#endif
#ifndef ATT_WIDE_A
#define ATT_WIDE_A 1
#endif
#ifndef ATT_WIDE_B
#define ATT_WIDE_B 1
#endif
#ifndef ATT_MAP
#define ATT_MAP vcu
#endif
struct Args { const float* in[28]; float* out; unsigned char* ws; int ph_lo, ph_hi; };
enum { I_X = 0, I_MIXN, I_FFNN, I_WINAB, I_QAN, I_WQUP, I_KVAN, I_WKVUP, I_QNG, I_KNG, I_QRG, I_KRG, I_GQG, I_GKG, I_WOUTAB, I_WINC, I_WQG, I_WKG, I_SINK, I_WOUTC,
       I_RELB, I_WGRP, I_BGRP, I_WRTR, I_BRTR, I_WGATE, I_WUP, I_WDOWN };

__global__ void __launch_bounds__(512, 2) mk_fwd(Args args) {
    extern __shared__ __attribute__((aligned(16))) unsigned char lds[];
    LAS unsigned char* L = (LAS unsigned char*)lds;
    const int tid = threadIdx.x, lane = tid & 63, wave = __builtin_amdgcn_readfirstlane(tid >> 6);
    const int G = gridDim.x, bx = blockIdx.x;
    const int vcu = (G % 8 == 0) ? (bx % 8) * (G / 8) + bx / 8 : bx;
    WaveId W; W.gw = bx * 8 + wave; W.ngw = G * 8; W.lane = lane; W.wave = wave;
    const __attribute__((address_space(4))) Args* argp_ = (const __attribute__((address_space(4))) Args*)__builtin_amdgcn_kernarg_segment_ptr();
#define INP(i) ({ const __attribute__((address_space(4))) Args* a_ = argp_; asm volatile("" : "+s"(a_)); (const float*)a_->in[i]; })
    unsigned char* ws = args.ws;
    unsigned* ctl = (unsigned*)(ws + WS_CTL);
    float* tab = (float*)(ws + WS_TAB);
    int* r_eidx = (int*)(ws + WS_ROUTE); float* r_wts = (float*)(ws + WS_ROUTE + 512 * 1024); int* r_slot = (int*)(ws + WS_ROUTE + 1024 * 1024);
    bf16* WT_AB = (bf16*)(ws + WS_WAB); bf16* WT_UP = (bf16*)(ws + WS_WUP); bf16* WT_OAB = (bf16*)(ws + WS_WOAB); bf16* WT_C = (bf16*)(ws + WS_WC); bf16* WT_OC = (bf16*)(ws + WS_WOC);
    bf16* WT_GU = (bf16*)(ws + WS_WGU); bf16* WT_D = (bf16*)(ws + WS_WD);
    bf16* HB = (bf16*)(ws + WS_H); bf16* PROJ = (bf16*)(ws + WS_PROJ); bf16* UPO = (bf16*)(ws + WS_UPO); bf16* PROJC = (bf16*)(ws + WS_PROJC);
    bf16* ACT = (bf16*)(ws + WS_ACT); bf16* DUMMY = (bf16*)(ws + WS_END);
    bf16* XRB = (bf16*)(ws + WS_XR);
    bf16* RTAB = (bf16*)(ws + WS_RTAB);
    volatile LAS unsigned* MISC = (volatile LAS unsigned*)(L + MISC_OFF);
    if (tid < 16) MISC[tid] = 0u;
    __syncthreads();
    const int lo = args.ph_lo, hi = args.ph_hi;
    XcdBarrier bar; bar.bar = ctl + CW_BAR; bar.x = 0; bar.st = nullptr;
    if (hi - lo > 1) bar = xcd_barrier_post(ctl + CW_BAR, MISC + 8);
#define IN(k) (lo <= (k) && (k) < hi)
#define SEAM(k) do { if (IN(k) && IN((k) + 1)) xcd_barrier(bar); } while (0)
#ifndef MK_REP_MASK
#define MK_REP_MASK 0
#endif
#ifndef MK_REP_N
#define MK_REP_N 1
#endif
#define REPS(k) (((MK_REP_MASK >> (k)) & 1) ? MK_REP_N : 1)
#define PH_BEGIN(k) if (IN(k)) { for (int rep_ = 0; rep_ < REPS(k); ++rep_) { if (rep_) xcd_barrier(bar);
#define PH_END(k) } } SEAM(k);

    constexpr int I_E5 = 256, MOE_ONLY = 3 * 32 * I_E5, I_O5 = 16 * 32, I_C5 = 16 * 48, MOE_ITEMS = MOE_ONLY + 2 * I_O5 + I_C5;
#define CV_DECODE(T, r_) do { if ((r_) >= MOE_ONLY) { const int rr = (r_) - MOE_ONLY; \
                    if (rr < I_O5) T = tr_seg<0>(rr, INP(I_WOUTAB), 1024, 1024, WT_OAB, 1024, 0, 0); \
                    else if (rr < I_O5 + I_C5) T = tr_seg<0>(rr - I_O5, INP(I_WINC), 1536, 1536, WT_C, 1024, 0, 0, INP(I_MIXN) + DM); \
                    else T = tr_seg<0>(rr - I_O5 - I_C5, INP(I_WOUTC), 1024, 1024, WT_OC, 1024, 0, 0); break; } \
                const int le = (r_) / (3 * I_E5), qq = (r_) % (3 * I_E5); \
                if (qq < I_E5) T = tr_seg<2>(qq, INP(I_WGATE) + (size_t)le * 1024 * 512, 512, 512, WT_GU + (size_t)le * 1024 * 1024, 1024, 0, 0, INP(I_FFNN) + (le >> 4) * DM); \
                else if (qq < 2 * I_E5) T = tr_seg<3>(qq - I_E5, INP(I_WUP) + (size_t)le * 1024 * 512, 512, 512, WT_GU + (size_t)le * 1024 * 1024, 1024, 0, 0, INP(I_FFNN) + (le >> 4) * DM); \
                else T = tr_seg<0>(qq - 2 * I_E5, INP(I_WDOWN) + (size_t)le * 512 * 1024, 1024, 1024, WT_D + (size_t)le * 1024 * 512, 512, 0, 0); } while (0)
#define CV_RUN(base_, cnt_, wi_, nw_) do { LAS float* scr5 = (LAS float*)(L + wave * 16384); int k_ = (wi_); const int end_ = (cnt_), st_ = (nw_); \
        for (; k_ + st_ < end_; k_ += 2 * st_) { float va_[32], vb_[32]; const int ra_ = (base_) + k_, rb_ = ra_ + st_; \
            { TrItem ti_; CV_DECODE(ti_, ra_); tr_load(ti_, va_, lane); } { TrItem ti_; CV_DECODE(ti_, rb_); tr_load(ti_, vb_, lane); } \
            { TrItem ti_; CV_DECODE(ti_, ra_); if (ti_.gain != nullptr) tr_store<true>(ti_, va_, scr5, lane); else tr_store<false>(ti_, va_, scr5, lane); } \
            { TrItem ti_; CV_DECODE(ti_, rb_); if (ti_.gain != nullptr) tr_store<true>(ti_, vb_, scr5, lane); else tr_store<false>(ti_, vb_, scr5, lane); } } \
        if (k_ < end_) { float va_[32]; const int ra_ = (base_) + k_; TrItem ti_; CV_DECODE(ti_, ra_); tr_load(ti_, va_, lane); \
            if (ti_.gain != nullptr) tr_store<true>(ti_, va_, scr5, lane); else tr_store<false>(ti_, va_, scr5, lane); } } while (0)
#define CV_TAIL(units_, c_, base_, cnt_) do { const int rem_ = (units_) % G, S_ = rem_ ? G - rem_ : 0; \
        if (2 * S_ >= G) { if ((c_) >= rem_) { CV_RUN(base_, cnt_, ((c_) - rem_) * 8 + wave, S_ * 8); } } else { CV_RUN(base_, cnt_, (c_) * 8 + wave, G * 8); } } while (0)
#ifndef CV_T1
#define CV_T1 0
#endif
#ifndef CV_T1N
#define CV_T1N 4096
#endif
#ifndef CV_T8
#define CV_T8 1
#endif
    constexpr int CV1_BASE = 0, CV1_CNT = CV_T1 ? CV_T1N : 0, CV8_BASE = MOE_ONLY / 2, CV8_CNT = MOE_ONLY / 2;
    constexpr int CV5_BASE = CV1_CNT, CV5_CNT = (CV_T8 ? MOE_ONLY / 2 : MOE_ONLY) - CV1_CNT;
    constexpr int CV5D_BASE = MOE_ONLY, CV5D_CNT = MOE_ITEMS - MOE_ONLY;

    PH_BEGIN(0) {
        LAS float* scr = (LAS float*)(L + wave * 16384);
        constexpr int I_AB = 16 * 37, I_QU = 4 * 24, I_KU = 2 * 32, I_O = 16 * 32, I_C = 16 * 48, I_E = 256;
        constexpr int NIT = I_AB + I_QU + I_KU;
#define P0_DECODE(T, it_) do { int r = (it_); \
            if (r < I_AB) { T = tr_seg<1>(r, INP(I_WINAB), 1184, 1184, WT_AB, 1024, 0, 0); break; } r -= I_AB; \
            if (r < I_QU) { T = tr_seg<MK_FUSE_PREP2 ? 4 : 0>(r, INP(I_WQUP), 768, 768, WT_UP, UP_K, 0, 0); break; } r -= I_QU; \
            if (r < I_KU) { T = tr_seg<MK_FUSE_PREP2 ? 5 : 0>(r, INP(I_WKVUP), 1024, 1024, WT_UP, UP_K, 768, 128); break; } r -= I_KU; \
            if (r < I_O) { T = tr_seg<0>(r, INP(I_WOUTAB), 1024, 1024, WT_OAB, 1024, 0, 0); break; } r -= I_O; \
            if (r < I_C) { T = tr_seg<0>(r, INP(I_WINC), 1536, 1536, WT_C, 1024, 0, 0, INP(I_MIXN) + DM); break; } r -= I_C; \
            if (r < I_O) { T = tr_seg<0>(r, INP(I_WOUTC), 1024, 1024, WT_OC, 1024, 0, 0); break; } r -= I_O; \
            const int le = r / (3 * I_E), q = r % (3 * I_E);            \
            if (q < I_E) T = tr_seg<2>(q, INP(I_WGATE) + (size_t)le * 1024 * 512, 512, 512, WT_GU + (size_t)le * 1024 * 1024, 1024, 0, 0); \
            else if (q < 2 * I_E) T = tr_seg<3>(q - I_E, INP(I_WUP) + (size_t)le * 1024 * 512, 512, 512, WT_GU + (size_t)le * 1024 * 1024, 1024, 0, 0); \
            else T = tr_seg<0>(q - 2 * I_E, INP(I_WDOWN) + (size_t)le * 512 * 1024, 1024, 1024, WT_D + (size_t)le * 1024 * 512, 512, 0, 0); } while (0)
        if (W.gw < NIT) {
            TrItem cur; P0_DECODE(cur, W.gw); float v[32]; tr_load(cur, v, lane);
            for (int it = W.gw; it < NIT; it += W.ngw) {
                const int itn = (it + W.ngw < NIT) ? it + W.ngw : it; TrItem nxt; P0_DECODE(nxt, itn); float nv[32]; tr_load(nxt, nv, lane);
                if (cur.gain != nullptr) tr_store<true>(cur, v, scr, lane); else tr_store<false>(cur, v, scr, lane);
                cur = nxt;
#pragma unroll
                for (int i = 0; i < 32; ++i) v[i] = nv[i];
            }
        }
        { const int gt = W.gw * 64 + lane, ngt = W.ngw * 64; const u32x4 z = {0u, 0u, 0u, 0u};
          for (int i = gt; i < 96 * 128; i += ngt) *(u32x4*)(WT_AB + (size_t)(1184 + i / 128) * 1024 + (i % 128) * 8) = z;
          for (int i = gt; i < 1024 * 16; i += ngt) *(u32x4*)(WT_UP + (size_t)(768 + i / 16) * UP_K + (i % 16) * 8) = z;
          for (int i = gt; i < 4096 * 16; i += ngt) { const float ang = (float)(i >> 4) * powf(10000.0f, -(float)(i & 15) * (1.0f / 16.0f)); tab[TB_CS + 2 * i] = cosf(ang); tab[TB_CS + 2 * i + 1] = sinf(ang); }
          const float* relb = INP(I_RELB);
          for (int i = gt; i < 16 * 512; i += ngt) { const int h = i >> 9, rel = (i & 511) - 256; tab[TB_BIAS + i] = (rel >= -128 && rel <= 128) ? relb[t5_bucket_dev(rel) * 16 + h] * LOG2E : -1.0e30f; } }
        { const int gt = W.gw * 64 + lane, ngt = W.ngw * 64;
          for (int i = gt; i < 2 * 4096; i += ngt) { const int ly = i >> 12; build_rtab(INP(I_FFNN) + ly * DM, INP(I_WGRP) + (size_t)ly * 1024 * 4, INP(I_WRTR) + (size_t)ly * 1024 * 16, RTAB + (size_t)ly * 65536, i & 4095); } }
        if (W.gw == 0) {
            const float gqn = gain_absmax(INP(I_QNG), 64, lane), gkn = gain_absmax(INP(I_KNG), 64, lane), gqr = gain_absmax(INP(I_QRG), 32, lane), gkr = gain_absmax(INP(I_KRG), 32, lane);
            const float gbq = gain_absmax(INP(I_GQG), 64, lane), gbk = gain_absmax(INP(I_GKG), 64, lane), gcq = gain_absmax(INP(I_WQG), 64, lane), gck = gain_absmax(INP(I_WKG), 64, lane);
            float bm = 0.f; for (int i = lane; i < 512; i += 64) bm = fmaxf(bm, INP(I_RELB)[i]); bm = wave_max(bm);
            if (lane == 0) { tab[TB_CONST + 0] = -(0.10206207261596577f * LOG2E * (64.f * gqn * gkn + 32.f * gqr * gkr));
                             tab[TB_CONST + 1] = -(0.125f * LOG2E * 64.f * gbq * gbk);
                             tab[TB_CONST + 2] = -(0.125f * LOG2E * 64.f * gcq * gck + bm * LOG2E); }
            if (lane < 16) tab[TB_CONST + 16 + lane] = INP(I_SINK)[lane] * LOG2E;
        }
        ph_rmsnorm(INP(I_X), INP(I_MIXN), HB, W);
    }
    PH_END(0)
#ifdef MK_EXTRA_BAR
    if (IN(0) && IN(1)) { for (int xb_ = 0; xb_ < MK_EXTRA_BAR; ++xb_) xcd_barrier(bar); }
#endif


        PH_BEGIN(1) {
#if MK_GEMM
            pg8::Gemm g{HB, WT_AB, 1024, 1024, 1024}; pg8::StaticOrder S; S.init(NT, PROJ_LD, 1024, 1024, G, bx);
#if MK_FUSE_PREP1
            pg8::EpiProjNormA E{PROJ, PROJ_LD, INP(I_QAN), INP(I_KVAN), INP(I_GQG), 0.125f * LOG2E, (LAS float*)(L + MISC_OFF + 16384), EPS};
            pg8::gemm_phase<pg8::EpiProjNormA, pg8::StaticOrder, true>(L, g, S, E);
#if CV_T1
            CV_TAIL((NT / 256) * (PROJ_LD / 256), bx, CV1_BASE, CV1_CNT);
#endif
#else
            pg8::EpiStoreBf16 E{PROJ, PROJ_LD};
            pg8::gemm_phase<pg8::EpiStoreBf16, pg8::StaticOrder, true>(L, g, S, E);
#endif
#else
            naive_gemm<0>(HB, 1024, WT_AB, 1024, NT, PROJ_LD, 1024, PROJ, nullptr, nullptr, PROJ_LD, W);
#endif
        }
        PH_END(1)
#if !MK_FUSE_PREP1
        PH_BEGIN(2) ph_prep1(PROJ, rep_ ? DUMMY : PROJ, INP(I_QAN), INP(I_KVAN), INP(I_GQG), INP(I_GKG), INP(I_KRG), tab + TB_CS, W);
        PH_END(2)
#endif
        PH_BEGIN(3) {
#if MK_FUSE_PREP1
            if (!rep_) { const int kfirst = (G > 192 && G < 384) ? 384 - G : 0;
                if (bx >= kfirst) { WaveId Wk = W; Wk.gw = (bx - kfirst) * 8 + wave; Wk.ngw = (G - kfirst) * 8;
                    ph_kside(PROJ, INP(I_GKG), INP(I_KRG), tab + TB_CS, Wk); } }
#endif
#if MK_GEMM
            pg8::Gemm g{PROJ, WT_UP, PROJ_LD, UP_K, UP_K}; pg8::StaticOrder S; S.init(NT, UP_LD, PROJ_LD, UP_K, G, bx, 3);
#if MK_FUSE_PREP2
            { pg8::StaticOrder Sq; Sq.init(NT, 768, PROJ_LD, UP_K, G, bx);
              pg8::EpiHeadNormA Eq{UPO, UP_LD, INP(I_QNG), INP(I_QNG), 0.10206207261596577f * LOG2E, EPS, 2, 2, nullptr};
              pg8::gemm_phase<pg8::EpiHeadNormA, pg8::StaticOrder, true>(L, g, Sq, Eq); }
#if UP_KV_K128
            { int kk_ = 128; asm volatile("" : "+s"(kk_));
              pg8::Gemm gk{PROJ + 256, WT_UP + (size_t)768 * UP_K + 128, PROJ_LD, UP_K, kk_}; pg8::StaticOrder Sk; Sk.init(NT, 1024, PROJ_LD, UP_K, G, bx);
#else
            { pg8::Gemm gk{PROJ + 128, WT_UP + (size_t)768 * UP_K, PROJ_LD, UP_K, UP_K}; pg8::StaticOrder Sk; Sk.init(NT, 1024, PROJ_LD, UP_K, G, bx);
#endif
              pg8::EpiHeadNormA Ek{UPO + 768, UP_LD, INP(I_KNG), INP(I_KNG), 1.0f, EPS, 0, 2, nullptr};
              pg8::gemm_phase<pg8::EpiHeadNormA, pg8::StaticOrder, true>(L, gk, Sk, Ek); }
#else
            pg8::EpiStoreBf16 E{UPO, UP_LD};
            pg8::gemm_phase<pg8::EpiStoreBf16, pg8::StaticOrder, true>(L, g, S, E);
#endif
#else
            naive_gemm<0>(PROJ, PROJ_LD, WT_UP, UP_K, NT, UP_LD, UP_K, UPO, nullptr, nullptr, UP_LD, W);
#endif
        }
        PH_END(3)
#if !MK_FUSE_PREP2
        PH_BEGIN(4) ph_prep2(UPO, rep_ ? DUMMY : UPO, INP(I_QNG), INP(I_QRG), INP(I_KNG), tab + TB_CS, W);
        PH_END(4)
#endif
        PH_BEGIN(5) {
            const float negcA = tab[TB_CONST + 0], negcB = tab[TB_CONST + 1];
#if MK_ATTN
            unsigned long long tsync = 0ull;
#ifdef MK_CLKPROBE
            const unsigned long long cp0_ = __builtin_amdgcn_s_memtime();
#endif
            int pos_ = 0; const int grp_ = bx % 5; bool cvdone_ = false;
#define P5_CVALL() do { if (CV5_CNT > 0) { CV_RUN(CV5_BASE, CV5_CNT, W.gw, W.ngw); } CV_RUN(CV5D_BASE, CV5D_CNT, W.gw, W.ngw); __syncthreads(); } while (0)
#define P5_SLOT() do { if (pos_ == grp_) { P5_CVALL(); cvdone_ = true; } ++pos_; } while (0)
#if ATT_WIDE_A
            for (int u = ATT_MAP; u < 512; u += G) { const int b = u >> 6, h = (u >> 3) & 7, qb = u & 7; const size_t r0 = (size_t)b * SEQ, rq = r0 + qb * 512;
                P5_SLOT();
                att::attn_unit16w<96>(UPO + rq * UP_LD + (MK_FUSE_PREP2 ? 64 : 96) * h, UPO + rq * UP_LD + (MK_FUSE_PREP2 ? 512 + 32 * h : 96 * h + 64), UP_LD, UPO + r0 * UP_LD + 768 + (MK_FUSE_PREP2 ? 64 : 128) * h, UP_LD, PROJ + r0 * PROJ_LD + PC_KROPE, PROJ_LD,
                                      UPO + r0 * UP_LD + (MK_FUSE_PREP2 ? 1280 + 64 * h : 768 + 128 * h + 64), UP_LD, HB + rq * DM + 64 * h, DM, 0, SEQ / 128, negcA, (char*)lds, MK_FUSE_PREP2 ? INP(I_QRG) : nullptr, tab + TB_CS, qb * 512); }
#else
            for (int u = ATT_MAP; u < 1024; u += G) { const int b = u >> 7, h = (u >> 4) & 7, qb = u & 15; const size_t r0 = (size_t)b * SEQ, rq = r0 + qb * 256;
                P5_SLOT();
                att::attn_unit16<96>(UPO + rq * UP_LD + (MK_FUSE_PREP2 ? 64 : 96) * h, UPO + rq * UP_LD + (MK_FUSE_PREP2 ? 512 + 32 * h : 96 * h + 64), UP_LD, UPO + r0 * UP_LD + 768 + (MK_FUSE_PREP2 ? 64 : 128) * h, UP_LD, PROJ + r0 * PROJ_LD + PC_KROPE, PROJ_LD,
                                          UPO + r0 * UP_LD + (MK_FUSE_PREP2 ? 1280 + 64 * h : 768 + 128 * h + 64), UP_LD, HB + rq * DM + 64 * h, DM, 0, SEQ / 128, negcA, (char*)lds, MK_FUSE_PREP2 ? INP(I_QRG) : nullptr, tab + TB_CS, qb * 256); }
#endif
#if ATT_WIDE_B
            for (int u = ATT_MAP; u < 512; u += G) { const int b = u >> 6, h = (u >> 3) & 7, qb = u & 7; const size_t r0 = (size_t)b * SEQ, rq = r0 + qb * 512;
                P5_SLOT();
                att::attn_unit16w<64>(PROJ + rq * PROJ_LD + PC_BQ + 64 * h, nullptr, PROJ_LD, PROJ + r0 * PROJ_LD + PC_BK + 64 * (h >> 2), PROJ_LD, nullptr, 0,
                                  PROJ + r0 * PROJ_LD + PC_BV + 64 * (h >> 2), PROJ_LD, HB + rq * DM + 512 + 64 * h, DM, 0, SEQ / 128, negcB, (char*)lds, nullptr, MK_FUSE_PREP1 ? tab + TB_CS : nullptr, qb * 512); }
#else
            for (int u = ATT_MAP; u < 1024; u += G) { const int b = u >> 7, h = (u >> 4) & 7, qb = u & 15; const size_t r0 = (size_t)b * SEQ, rq = r0 + qb * 256;
                P5_SLOT();
                att::attn_unit16<64>(PROJ + rq * PROJ_LD + PC_BQ + 64 * h, nullptr, PROJ_LD, PROJ + r0 * PROJ_LD + PC_BK + 64 * (h >> 2), PROJ_LD, nullptr, 0,
                                          PROJ + r0 * PROJ_LD + PC_BV + 64 * (h >> 2), PROJ_LD, HB + rq * DM + 512 + 64 * h, DM, 0, SEQ / 128, negcB, (char*)lds, nullptr, nullptr, 0); }
#endif
            if (!cvdone_) { P5_CVALL(); }
#if ATT_PROBE
            { const unsigned long long ts0_ = __builtin_amdgcn_s_memtime(); while (__builtin_amdgcn_s_memtime() - ts0_ < tsync) __builtin_amdgcn_s_sleep(8); }
#endif
#ifdef MK_CLKPROBE
            { const unsigned long long cyc_ = __builtin_amdgcn_s_memtime() - cp0_; const unsigned long long r0_ = __builtin_amdgcn_s_memrealtime(); while (__builtin_amdgcn_s_memrealtime() - r0_ < cyc_ / 21ull) __builtin_amdgcn_s_sleep(8); }
#endif
#else
            LAS float* qf = (LAS float*)(L + wave * 512);
            for (long it = W.gw; it < (long)NT * 8; it += W.ngw) { const int m = (int)(it >> 3), h = (int)(it & 7); const size_t r0 = (size_t)(m / SEQ) * SEQ;
                naive_attn_row<96, false>(UPO + (size_t)m * UP_LD + 96 * h, UPO + r0 * UP_LD + 768 + (MK_FUSE_PREP2 ? 64 : 128) * h, UP_LD, PROJ + r0 * PROJ_LD + PC_KROPE, PROJ_LD,
                                          UPO + r0 * UP_LD + (MK_FUSE_PREP2 ? 1280 + 64 * h : 768 + 128 * h + 64), UP_LD, HB + (size_t)m * DM + 64 * h, 0, nullptr, 0.f, qf, lane); }
            for (long it = W.gw; it < (long)NT * 8; it += W.ngw) { const int m = (int)(it >> 3), h = (int)(it & 7); const size_t r0 = (size_t)(m / SEQ) * SEQ;
                naive_attn_row<64, false>(PROJ + (size_t)m * PROJ_LD + PC_BQ + 64 * h, PROJ + r0 * PROJ_LD + PC_BK + 64 * (h >> 2), PROJ_LD, nullptr, 0,
                                          PROJ + r0 * PROJ_LD + PC_BV + 64 * (h >> 2), PROJ_LD, HB + (size_t)m * DM + 512 + 64 * h, 0, nullptr, 0.f, qf, lane); }
            (void)negcA; (void)negcB;
#endif
        }
        PH_END(5)
        PH_BEGIN(6) {
#if MK_GEMM
            pg8::Gemm g{HB, WT_OAB, 1024, 1024, 1024}; pg8::StaticOrder S; S.init(NT, DM, 1024, 1024, G, bx); pg8::EpiResXBA E{INP(I_X), XRB, DM};
            pg8::gemm_phase<pg8::EpiResXBA, pg8::StaticOrder, true>(L, g, S, E);
#else

#endif
        }
        PH_END(6)

    { constexpr int LAYER_ = 0;
    constexpr int layer = LAYER_; constexpr int pb = 8 * layer;
    unsigned* cnt = ctl + CW_CNT + 1024 * layer;
    int* eidx = r_eidx + (size_t)layer * NT * 2; float* wts = r_wts + (size_t)layer * NT * 2; int* rank = r_slot + (size_t)layer * NT * 2;
    int* list = (int*)(ws + WS_LIST);
    bf16* YB = (bf16*)(ws + WS_Y);
    PH_BEGIN(7 + pb) {
        { const u32x4* src = (const u32x4*)(RTAB + (size_t)layer * 65536); LAS u32x4* dst = (LAS u32x4*)L;
          for (int i = tid; i < 8192; i += 512) dst[i] = src[i]; }
        LAS int* tinfo = (LAS int*)(L + MISC_OFF + 2048);
        { const int niter = (NT / 16 - bx * 8 + W.ngw - 1) / W.ngw;
          for (int i = tid; i < 32 + 4 * niter * 128; i += 512) tinfo[i] = (i < 32) ? 0 : -1; }
        __syncthreads();
        ph_router(XRB, (float*)(ws + WS_RS) + (size_t)layer * NT, L, (LAS float*)(L + MISC_OFF + 8192 + wave * 2304), INP(I_BGRP) + layer * 4, INP(I_BRTR) + layer * 16, eidx, wts, rank, list, cnt, tinfo, W);
    }
    PH_END(7 + pb)
    PH_BEGIN(8 + pb) {
        LAS unsigned char* tile_e = L + MISC_OFF + 1024; LAS int* rowtok = (LAS int*)(L + MISC_OFF + 2048); LAS float* rowrs = (LAS float*)(L + MISC_OFF + 16384);
        const float* rsv = (const float*)(ws + WS_RS) + (size_t)layer * NT;
        if (tid < 64) { int off[17]; const int ntile = moe_offsets(cnt, off);
            for (int t = lane; t < ntile; t += 64) { const int row = t * 256; int e = 0;
#pragma unroll
                for (int q = 1; q < 16; ++q) e = (row >= off[q]) ? q : e;
                tile_e[t] = (unsigned char)e; }
            if (lane == 0) MISC[4] = (unsigned)ntile; }
        __syncthreads();
        const int ntile = (int)MISC[4];
        { int off[17]; moe_offsets(cnt, off);
          for (int idx = tid; idx < 13 * 256; idx += 512) { const int ui = idx >> 8, r = idx & 255; const long Lu = (long)ui * G + vcu;
              if (Lu < (long)ntile * 4) { const int pm = (int)(Lu >> 2); const int e = tile_e[pm]; int base = 0, ce = 0;
#pragma unroll
                  for (int q = 0; q < 16; ++q) { base = (q == e) ? off[q] : base; ce = (q == e) ? (int)cnt[64 * q] : ce; }
                  const int lr = pm * 256 - base + r; const int tk = (lr < ce) ? list[(size_t)e * NT + lr] : 0; rowtok[idx] = tk; rowrs[idx] = (lr < ce) ? rsv[tk] : 0.f; } } }
        __syncthreads();
        pg8::Gemm g{XRB, WT_GU + (size_t)layer * 16 * 1024 * 1024, 1024, 1024, 1024};
        pg8::MoeOrder S{tile_e, ntile, 4, G, vcu, 1024, 1024, (long)1024 * 1024}; pg8::EpiSwiGLU E{ACT, DEXP, rowrs};
        pg8::gemm_phase<pg8::EpiSwiGLU, pg8::MoeOrder, true, true>(L, g, S, E, rowtok);
#if CV_T8
        if (layer == 0) { CV_TAIL(ntile * 4, vcu, CV8_BASE, CV8_CNT); }
#endif
    }
    PH_END(8 + pb)
    PH_BEGIN(9 + pb) {
        LAS unsigned char* tile_e = L + MISC_OFF + 1024;
        if (tid < 64) { int off[17]; const int ntile = moe_offsets(cnt, off);
            for (int t = lane; t < ntile; t += 64) { const int row = t * 256; int e = 0;
#pragma unroll
                for (int q = 1; q < 16; ++q) e = (row >= off[q]) ? q : e;
                tile_e[t] = (unsigned char)e; }
            if (lane == 0) MISC[4] = (unsigned)ntile; }
        __syncthreads();
        const int ntile = (int)MISC[4];
        pg8::Gemm g{ACT, WT_D + (size_t)layer * 16 * 1024 * 512, DEXP, DEXP, DEXP};
        pg8::MoeOrder S{tile_e, ntile, 4, G, vcu, DEXP, DEXP, (long)1024 * 512}; pg8::EpiStoreAdj E{YB, DM};
        pg8::gemm_phase<pg8::EpiStoreAdj, pg8::MoeOrder, true>(L, g, S, E);
    }
    PH_END(9 + pb)
    PH_BEGIN(10 + pb) {
        if (layer == 0) ph_combine<false>(XRB, nullptr, YB, eidx, rank, wts, cnt, (float*)(ws + WS_RS) + 2 * (size_t)NT, W);
        else ph_combine<true>(XRB, args.out, YB, eidx, rank, wts, cnt, nullptr, W);
    } } } if (layer == 0) SEAM(10);

    }

        PH_BEGIN(11) {
#if MK_GEMM
            pg8::Gemm g{XRB, WT_C, 1024, 1024, 1024}; pg8::StaticOrder S; S.init(NT, PC_LD, 1024, 1024, G, bx);
#if MK_FUSE_PREPC
            pg8::EpiHeadNormA E{PROJC, PC_LD, INP(I_WQG), INP(I_WKG), 0.125f * LOG2E, EPS, 4, 5, (const float*)(ws + WS_RS) + 2 * (size_t)NT};
            pg8::gemm_phase<pg8::EpiHeadNormA, pg8::StaticOrder, true>(L, g, S, E);
#else
            pg8::EpiStoreBf16 E{PROJC, PC_LD};
            pg8::gemm_phase<pg8::EpiStoreBf16, pg8::StaticOrder, true>(L, g, S, E);
#endif
#else
            naive_gemm<0>(HB, 1024, WT_C, 1024, NT, PC_LD, 1024, PROJC, nullptr, nullptr, PC_LD, W);
#endif
        }
        PH_END(11)
#if !MK_FUSE_PREPC
        PH_BEGIN(12) ph_prepc(PROJC, rep_ ? DUMMY : PROJC, INP(I_WQG), INP(I_WKG), W);
        PH_END(12)
#endif
        PH_BEGIN(13) {
            const float negcC = tab[TB_CONST + 2];
#if MK_ATTN
            unsigned long long tsync = 0ull;
#if ATT_WIDE_C
            int wkvh_ = -1;
            for (int u = ATT_MAP; u < 1024; u += G) { const int b = u >> 7, kvh = (u >> 5) & 3, qb = u & 31;
                if (kvh != wkvh_) { __syncthreads(); att::win_bias_tables((char*)lds, tab + TB_BIAS + 2048 * kvh, negcC); wkvh_ = kvh; __syncthreads(); } const size_t r0 = (size_t)b * SEQ, rq = r0 + qb * 128;
                const int q0 = qb * 128; const int lo = q0 >= 128 ? q0 - 128 : 0, hi_ = q0 + 256 < SEQ ? q0 + 256 : SEQ; const int kt0 = lo / 128, kt1 = (hi_ + 127) / 128;
                att::attn_unit16w<64, true>(PROJC + rq * PC_LD + 256 * kvh, nullptr, PC_LD, PROJC + r0 * PC_LD + 1024 + 64 * kvh, PC_LD, nullptr, 0,
                                            PROJC + r0 * PC_LD + 1280 + 64 * kvh, PC_LD, HB + rq * DM + 256 * kvh, DM, kt0, kt1, negcC, (char*)lds, nullptr, nullptr, q0, tab + TB_BIAS + 2048 * kvh, tab + TB_CONST + 16 + 4 * kvh); }
#else
            for (int u = ATT_MAP; u < 2048; u += G) { const int b = u >> 8, kvh = (u >> 6) & 3, qb = u & 63; const size_t r0 = (size_t)b * SEQ, rq = r0 + qb * 64;
                const int q0 = qb * 64; const int lo = q0 >= 128 ? q0 - 128 : 0, hi_ = q0 + 192 < SEQ ? q0 + 192 : SEQ; const int kt0 = lo / att::STAGE_KEYS, kt1 = (hi_ + att::STAGE_KEYS - 1) / att::STAGE_KEYS;
                att::attn_unit<64, true>(PROJC + rq * PC_LD + 256 * kvh, PC_LD, PROJC + r0 * PC_LD + 1024 + 64 * kvh, PC_LD, nullptr, 0,
                                         PROJC + r0 * PC_LD + 1280 + 64 * kvh, PC_LD, HB + rq * DM + 256 * kvh, DM, kt0, kt1, negcC, q0, tab + TB_BIAS + 2048 * kvh, tab + TB_CONST + 16 + 4 * kvh, (char*)lds, tsync); }
#endif
#else
            LAS float* qf = (LAS float*)(L + wave * 512);
            for (long it = W.gw; it < (long)NT * 16; it += W.ngw) { const int m = (int)(it >> 4), h = (int)(it & 15); const size_t r0 = (size_t)(m / SEQ) * SEQ;
                naive_attn_row<64, true>(PROJC + (size_t)m * PC_LD + 64 * h, PROJC + r0 * PC_LD + 1024 + 64 * (h >> 2), PC_LD, nullptr, 0,
                                         PROJC + r0 * PC_LD + 1280 + 64 * (h >> 2), PC_LD, HB + (size_t)m * DM + 64 * h, m & (SEQ - 1), tab + TB_BIAS + 512 * h, tab[TB_CONST + 16 + h], qf, lane); }
            (void)negcC;
#endif
        }
        PH_END(13)
        PH_BEGIN(14) {
#if MK_GEMM
            pg8::Gemm g{HB, WT_OC, 1024, 1024, 1024}; pg8::StaticOrder S; S.init(NT, DM, 1024, 1024, G, bx); pg8::EpiResBBA E{XRB, DM};
            pg8::gemm_phase<pg8::EpiResBBA, pg8::StaticOrder, true>(L, g, S, E);
#else

#endif
        }
        PH_END(14)

    { constexpr int LAYER_ = 1;
    constexpr int layer = LAYER_; constexpr int pb = 8 * layer;
    unsigned* cnt = ctl + CW_CNT + 1024 * layer;
    int* eidx = r_eidx + (size_t)layer * NT * 2; float* wts = r_wts + (size_t)layer * NT * 2; int* rank = r_slot + (size_t)layer * NT * 2;
    int* list = (int*)(ws + WS_LIST);
    bf16* YB = (bf16*)(ws + WS_Y);
    PH_BEGIN(7 + pb) {
        { const u32x4* src = (const u32x4*)(RTAB + (size_t)layer * 65536); LAS u32x4* dst = (LAS u32x4*)L;
          for (int i = tid; i < 8192; i += 512) dst[i] = src[i]; }
        LAS int* tinfo = (LAS int*)(L + MISC_OFF + 2048);
        { const int niter = (NT / 16 - bx * 8 + W.ngw - 1) / W.ngw;
          for (int i = tid; i < 32 + 4 * niter * 128; i += 512) tinfo[i] = (i < 32) ? 0 : -1; }
        __syncthreads();
        ph_router(XRB, (float*)(ws + WS_RS) + (size_t)layer * NT, L, (LAS float*)(L + MISC_OFF + 8192 + wave * 2304), INP(I_BGRP) + layer * 4, INP(I_BRTR) + layer * 16, eidx, wts, rank, list, cnt, tinfo, W);
    }
    PH_END(7 + pb)
    PH_BEGIN(8 + pb) {
        LAS unsigned char* tile_e = L + MISC_OFF + 1024; LAS int* rowtok = (LAS int*)(L + MISC_OFF + 2048); LAS float* rowrs = (LAS float*)(L + MISC_OFF + 16384);
        const float* rsv = (const float*)(ws + WS_RS) + (size_t)layer * NT;
        if (tid < 64) { int off[17]; const int ntile = moe_offsets(cnt, off);
            for (int t = lane; t < ntile; t += 64) { const int row = t * 256; int e = 0;
#pragma unroll
                for (int q = 1; q < 16; ++q) e = (row >= off[q]) ? q : e;
                tile_e[t] = (unsigned char)e; }
            if (lane == 0) MISC[4] = (unsigned)ntile; }
        __syncthreads();
        const int ntile = (int)MISC[4];
        { int off[17]; moe_offsets(cnt, off);
          for (int idx = tid; idx < 13 * 256; idx += 512) { const int ui = idx >> 8, r = idx & 255; const long Lu = (long)ui * G + vcu;
              if (Lu < (long)ntile * 4) { const int pm = (int)(Lu >> 2); const int e = tile_e[pm]; int base = 0, ce = 0;
#pragma unroll
                  for (int q = 0; q < 16; ++q) { base = (q == e) ? off[q] : base; ce = (q == e) ? (int)cnt[64 * q] : ce; }
                  const int lr = pm * 256 - base + r; const int tk = (lr < ce) ? list[(size_t)e * NT + lr] : 0; rowtok[idx] = tk; rowrs[idx] = (lr < ce) ? rsv[tk] : 0.f; } } }
        __syncthreads();
        pg8::Gemm g{XRB, WT_GU + (size_t)layer * 16 * 1024 * 1024, 1024, 1024, 1024};
        pg8::MoeOrder S{tile_e, ntile, 4, G, vcu, 1024, 1024, (long)1024 * 1024}; pg8::EpiSwiGLU E{ACT, DEXP, rowrs};
        pg8::gemm_phase<pg8::EpiSwiGLU, pg8::MoeOrder, true, true>(L, g, S, E, rowtok);
#if CV_T8
        if (layer == 0) { CV_TAIL(ntile * 4, vcu, CV8_BASE, CV8_CNT); }
#endif
    }
    PH_END(8 + pb)
    PH_BEGIN(9 + pb) {
        LAS unsigned char* tile_e = L + MISC_OFF + 1024;
        if (tid < 64) { int off[17]; const int ntile = moe_offsets(cnt, off);
            for (int t = lane; t < ntile; t += 64) { const int row = t * 256; int e = 0;
#pragma unroll
                for (int q = 1; q < 16; ++q) e = (row >= off[q]) ? q : e;
                tile_e[t] = (unsigned char)e; }
            if (lane == 0) MISC[4] = (unsigned)ntile; }
        __syncthreads();
        const int ntile = (int)MISC[4];
        pg8::Gemm g{ACT, WT_D + (size_t)layer * 16 * 1024 * 512, DEXP, DEXP, DEXP};
        pg8::MoeOrder S{tile_e, ntile, 4, G, vcu, DEXP, DEXP, (long)1024 * 512}; pg8::EpiStoreAdj E{YB, DM};
        pg8::gemm_phase<pg8::EpiStoreAdj, pg8::MoeOrder, true>(L, g, S, E);
    }
    PH_END(9 + pb)
    PH_BEGIN(10 + pb) {
        if (layer == 0) ph_combine<false>(XRB, nullptr, YB, eidx, rank, wts, cnt, (float*)(ws + WS_RS) + 2 * (size_t)NT, W);
        else ph_combine<true>(XRB, args.out, YB, eidx, rank, wts, cnt, nullptr, W);
    } } } if (layer == 0) SEAM(10);

    }
#undef IN
#undef INP
#undef SEAM
#undef PH_BEGIN
#undef PH_END
}

extern "C" void kernel_launch(void* const* d_in, const int* in_sizes, int n_in, void* d_out, int out_size, void* d_ws, size_t ws_size, hipStream_t stream) {
    static int grid = 0;
    if (grid == 0) {
        if (n_in != 28 || in_sizes[0] != NT * DM || out_size != NT * DM || ws_size < WS_END) {
            fprintf(stderr, "kernel_launch: shape mismatch: n_in %d in0 %d out %d ws %zu (need >= %zu); nothing launched\n", n_in, n_in > 0 ? in_sizes[0] : -1, out_size, ws_size, (size_t)WS_END); grid = -1; return; }
        int dev = 0, cus = 0, per_cu = 0;
        if (hipGetDevice(&dev) != hipSuccess || hipDeviceGetAttribute(&cus, hipDeviceAttributeMultiprocessorCount, dev) != hipSuccess) { fprintf(stderr, "kernel_launch: device query failed\n"); grid = -1; return; }
        if (hipFuncSetAttribute((const void*)mk_fwd, hipFuncAttributeMaxDynamicSharedMemorySize, LDS_BYTES) != hipSuccess) { fprintf(stderr, "kernel_launch: hipFuncSetAttribute failed\n"); grid = -1; return; }
        if (hipOccupancyMaxActiveBlocksPerMultiprocessor(&per_cu, (const void*)mk_fwd, 512, LDS_BYTES) != hipSuccess || per_cu < 1)
            fprintf(stderr, "kernel_launch: note: occupancy query reports %d workgroups per CU\n", per_cu);
        (void)hipGetLastError();
        grid = cus;
    }
    if (grid < 0) return;
    if (hipMemsetAsync((char*)d_ws + WS_CTL, 0, CTL_ZERO_BYTES, stream) != hipSuccess) { fprintf(stderr, "kernel_launch: memset failed\n"); return; }
    Args a{};
    for (int i = 0; i < 28; ++i) a.in[i] = (const float*)d_in[i];
    a.out = (float*)d_out; a.ws = (unsigned char*)d_ws;
#if MK_ONE_LAUNCH
    a.ph_lo = 0; a.ph_hi = NPHASE;
    hipLaunchKernelGGL(mk_fwd, dim3(grid), dim3(512), LDS_BYTES, stream, a);
#else
    for (int p = 0; p < NPHASE; ++p) { a.ph_lo = p; a.ph_hi = p + 1; hipLaunchKernelGGL(mk_fwd, dim3(grid), dim3(512), LDS_BYTES, stream, a); }
#endif
    const hipError_t le = hipPeekAtLastError();
    if (le != hipSuccess) fprintf(stderr, "kernel_launch: launch failed: %s\n", hipGetErrorName(le));
}
```
